# Optimizing an MI355X kernel written in HIP

```python
import jax, jax.numpy as jnp
from jax import lax
import numpy as np

D_MODEL = 1024
BATCH = 16
SEQ = 2048
DEPTH = 2

D_MIX = D_MODEL
HEAD_DIM = 64
NSA_WIDTH = D_MIX // 2
CONV_WIDTH = D_MIX - NSA_WIDTH
N_HEADS = NSA_WIDTH // HEAD_DIM
N_KV = 2
GROUP = N_HEADS // N_KV
N_CONV_GROUPS = CONV_WIDTH // HEAD_DIM
KV_W = N_KV * HEAD_DIM
N_BRANCH = 3
ROT_DIM = HEAD_DIM // 4
ROPE_THETA = 500000.0
CMP_LEN = 32
CMP_STRIDE = 16
CMP_HIDDEN = 128
SEL_BLOCK = 64
N_SEL = 8
WINDOW = 512
Q_BLOCK = 64
CONV_K = 3
D_FF = 2816
EPS = 1e-6
N_IN = NSA_WIDTH + 6 * KV_W + N_HEADS * N_BRANCH + 3 * CONV_WIDTH

kernel_name = "hymba_nsa_shortconv_convffn_adaln"


def rmsnorm(x, g):
    xf = x.astype(jnp.float32)
    r = lax.rsqrt(jnp.mean(xf * xf, axis=-1, keepdims=True) + EPS)
    return (xf * r).astype(x.dtype) * g


def causal_dwconv(x, w):
    k_taps = w.shape[0]
    s = x.shape[1]
    xp = jnp.pad(x, ((0, 0), (k_taps - 1, 0), (0, 0)))
    return sum(xp[:, k:k + s] * w[k] for k in range(k_taps))


def partial_rope(x, pos):
    half = ROT_DIM // 2
    freqs = ROPE_THETA ** (-jnp.arange(half, dtype=jnp.float32) / half)
    ang = pos.astype(jnp.float32)[..., None] * freqs
    cos = jnp.cos(ang)[:, :, None, :]
    sin = jnp.sin(ang)[:, :, None, :]
    xf = x.astype(jnp.float32)
    x1, x2, rest = xf[..., :half], xf[..., half:ROT_DIM], xf[..., ROT_DIM:]
    out = jnp.concatenate([x1 * cos - x2 * sin, x2 * cos + x1 * sin, rest], axis=-1)
    return out.astype(x.dtype)


def masked_softmax(s, mask):
    s = jnp.where(mask, s.astype(jnp.float32), -jnp.inf)
    m = jnp.max(s, axis=-1, keepdims=True)
    m = jnp.where(jnp.isfinite(m), m, 0.0)
    p = jnp.exp(s - m)
    return p / jnp.maximum(jnp.sum(p, axis=-1, keepdims=True), 1e-30)


def compress_blocks(tok, pe, w1, w2):
    b, hk, s, dh = tok.shape
    n_cmp = (s - CMP_LEN) // CMP_STRIDE + 1
    idx = jnp.arange(n_cmp)[:, None] * CMP_STRIDE + jnp.arange(CMP_LEN)[None, :]
    blk = tok[:, :, idx] + pe
    blk = blk.reshape(b, hk, n_cmp, CMP_LEN * dh)
    return jax.nn.silu(blk @ w1) @ w2


def nsa_attention(q, k_c, v_c, k_s, v_s, k_w, v_w, gates,
                  pe_k, w1_k, w2_k, pe_v, w1_v, w2_v):
    b, s = q.shape[0], q.shape[1]
    scale = HEAD_DIM ** -0.5
    qh = q.reshape(b, s, N_KV, GROUP, HEAD_DIM).transpose(0, 2, 3, 1, 4)
    gh = jax.nn.sigmoid(gates.astype(jnp.float32)).reshape(b, s, N_KV, GROUP, N_BRANCH)
    gh = gh.transpose(0, 2, 3, 1, 4)

    kc = compress_blocks(k_c, pe_k, w1_k, w2_k)
    vc = compress_blocks(v_c, pe_v, w1_v, w2_v)
    n_cmp = kc.shape[2]
    cmp_start = jnp.arange(n_cmp) * CMP_STRIDE
    cmp_end = cmp_start + CMP_LEN - 1
    n_slc = s // SEL_BLOCK
    n_sel = min(N_SEL, n_slc)
    slc_start = jnp.arange(n_slc) * SEL_BLOCK
    overlap = ((cmp_start[:, None] < slc_start[None, :] + SEL_BLOCK)
               & (cmp_start[:, None] + CMP_LEN > slc_start[None, :])).astype(jnp.float32)

    ks_blk = k_s.reshape(b, N_KV, n_slc, SEL_BLOCK, HEAD_DIM)
    vs_blk = v_s.reshape(b, N_KV, n_slc, SEL_BLOCK, HEAD_DIM)
    kw_pad = jnp.pad(k_w, ((0, 0), (0, 0), (WINDOW, 0), (0, 0)))
    vw_pad = jnp.pad(v_w, ((0, 0), (0, 0), (WINDOW, 0), (0, 0)))
    gather_blocks = jax.vmap(jax.vmap(lambda kb, ix: kb[ix]))
    j_blk = jnp.arange(n_slc)

    def query_block(qi):
        t0 = qi * Q_BLOCK
        pos = t0 + jnp.arange(Q_BLOCK)
        qb = lax.dynamic_slice_in_dim(qh, t0, Q_BLOCK, axis=3) * scale
        gb = lax.dynamic_slice_in_dim(gh, t0, Q_BLOCK, axis=3)

        s_c = jnp.einsum('bhgqd,bhkd->bhgqk', qb, kc)
        p_c = masked_softmax(s_c, cmp_end[None, :] <= pos[:, None])
        o_c = jnp.einsum('bhgqk,bhkd->bhgqd', p_c.astype(vc.dtype), vc)

        imp = jnp.einsum('bhgqk,kj->bhqj', p_c, overlap)
        blk_q = pos // SEL_BLOCK
        causal = j_blk[None, :] <= blk_q[:, None]
        forced = causal & ((j_blk[None, :] == 0) | (j_blk[None, :] == blk_q[:, None])
                           | (j_blk[None, :] == blk_q[:, None] - 1))
        imp = jnp.where(forced, jnp.inf, jnp.where(causal, imp, -jnp.inf))
        top_val, top_idx = lax.top_k(imp, n_sel)
        kg = gather_blocks(ks_blk, top_idx)
        vg = gather_blocks(vs_blk, top_idx)
        kg = kg.reshape(b, N_KV, Q_BLOCK, n_sel * SEL_BLOCK, HEAD_DIM)
        vg = vg.reshape(b, N_KV, Q_BLOCK, n_sel * SEL_BLOCK, HEAD_DIM)
        tok_pos = top_idx[..., None] * SEL_BLOCK + jnp.arange(SEL_BLOCK)
        m_s = (tok_pos <= pos[None, None, :, None, None]) & (top_val > -jnp.inf)[..., None]
        m_s = m_s.reshape(b, N_KV, 1, Q_BLOCK, n_sel * SEL_BLOCK)
        s_s = jnp.einsum('bhgqd,bhqmd->bhgqm', qb, kg)
        p_s = masked_softmax(s_s, m_s)
        o_s = jnp.einsum('bhgqm,bhqmd->bhgqd', p_s.astype(vg.dtype), vg)

        kwb = lax.dynamic_slice_in_dim(kw_pad, t0, Q_BLOCK + WINDOW, axis=2)
        vwb = lax.dynamic_slice_in_dim(vw_pad, t0, Q_BLOCK + WINDOW, axis=2)
        key_pos = t0 - WINDOW + jnp.arange(Q_BLOCK + WINDOW)
        diff = pos[:, None] - key_pos[None, :]
        m_w = (key_pos[None, :] >= 0) & (diff >= 0) & (diff < WINDOW)
        s_w = jnp.einsum('bhgqd,bhkd->bhgqk', qb, kwb)
        p_w = masked_softmax(s_w, m_w)
        o_w = jnp.einsum('bhgqk,bhkd->bhgqd', p_w.astype(vwb.dtype), vwb)

        o = gb[..., 0:1] * o_c + gb[..., 1:2] * o_s + gb[..., 2:3] * o_w
        return o.transpose(0, 3, 1, 2, 4).reshape(b, Q_BLOCK, NSA_WIDTH).astype(q.dtype)

    out = lax.map(query_block, jnp.arange(s // Q_BLOCK))
    return out.transpose(1, 0, 2, 3).reshape(b, s, NSA_WIDTH)


def setup_inputs(seed: int = 0) -> dict:
    key = jax.random.key(seed)
    ks = jax.random.split(key, 24)
    f32 = jnp.float32

    def nrm(k, shape, scale):
        return jax.random.normal(k, shape, f32) * scale

    x = nrm(ks[0], (BATCH, SEQ, D_MODEL), 1.0)
    c = nrm(ks[1], (BATCH, D_MODEL), 1.0)
    offs = jax.random.randint(ks[2], (BATCH, 1), 0, 4096, dtype=jnp.int32)
    positions = (offs + jnp.arange(SEQ, dtype=jnp.int32)[None, :]).astype(jnp.int32)
    return {
        "x": x,
        "c": c,
        "positions": positions,
        "w_mod": nrm(ks[3], (DEPTH, D_MODEL, 6 * D_MODEL), 0.5 * D_MODEL ** -0.5),
        "b_mod": nrm(ks[4], (DEPTH, 6 * D_MODEL), 0.02),
        "norm1_g": 1.0 + nrm(ks[5], (DEPTH, D_MODEL), 0.02),
        "w_in": nrm(ks[6], (DEPTH, D_MODEL, N_IN), D_MODEL ** -0.5),
        "cmp_pe_k": nrm(ks[7], (DEPTH, CMP_LEN, HEAD_DIM), 0.1),
        "cmp_w1_k": nrm(ks[8], (DEPTH, CMP_LEN * HEAD_DIM, CMP_HIDDEN), (CMP_LEN * HEAD_DIM) ** -0.5),
        "cmp_w2_k": nrm(ks[9], (DEPTH, CMP_HIDDEN, HEAD_DIM), CMP_HIDDEN ** -0.5),
        "cmp_pe_v": nrm(ks[10], (DEPTH, CMP_LEN, HEAD_DIM), 0.1),
        "cmp_w1_v": nrm(ks[11], (DEPTH, CMP_LEN * HEAD_DIM, CMP_HIDDEN), (CMP_LEN * HEAD_DIM) ** -0.5),
        "cmp_w2_v": nrm(ks[12], (DEPTH, CMP_HIDDEN, HEAD_DIM), CMP_HIDDEN ** -0.5),
        "conv_w": nrm(ks[13], (DEPTH, CONV_K, CONV_WIDTH), CONV_K ** -0.5),
        "grp_g_attn": 1.0 + nrm(ks[14], (DEPTH, NSA_WIDTH), 0.02),
        "grp_g_conv": 1.0 + nrm(ks[15], (DEPTH, CONV_WIDTH), 0.02),
        "w_out": nrm(ks[16], (DEPTH, D_MIX, D_MODEL), D_MIX ** -0.5),
        "norm2_g": 1.0 + nrm(ks[17], (DEPTH, D_MODEL), 0.02),
        "ffn_up": nrm(ks[18], (DEPTH, D_MODEL, 2 * D_FF), D_MODEL ** -0.5),
        "ffn_conv": nrm(ks[19], (DEPTH, CONV_K, 2 * D_FF), CONV_K ** -0.5),
        "ffn_down": nrm(ks[20], (DEPTH, D_FF, D_MODEL), D_FF ** -0.5),
        "final_g": 1.0 + nrm(ks[21], (D_MODEL,), 0.02),
    }


def reference(x, c, positions, w_mod, b_mod, norm1_g, w_in,
              cmp_pe_k, cmp_w1_k, cmp_w2_k, cmp_pe_v, cmp_w1_v, cmp_w2_v,
              conv_w, grp_g_attn, grp_g_conv, w_out, norm2_g,
              ffn_up, ffn_conv, ffn_down, final_g):
    b, s, _ = x.shape
    sizes = [NSA_WIDTH] + [KV_W] * 6 + [N_HEADS * N_BRANCH] + [CONV_WIDTH] * 3
    split_at = np.cumsum(sizes)[:-1].tolist()
    c_act = jax.nn.silu(c)

    def heads(t, n):
        return t.reshape(b, s, n, HEAD_DIM)

    def kv_layout(t):
        return t.transpose(0, 2, 1, 3)

    for l in range(DEPTH):
        mod = c_act @ w_mod[l] + b_mod[l]
        sh1, sc1, g1, sh2, sc2, g2 = [m[:, None, :] for m in jnp.split(mod, 6, axis=-1)]

        h = rmsnorm(x, norm1_g[l]) * (1.0 + sc1) + sh1
        proj = h @ w_in[l]
        q, kc, vc, ksel, vsel, kwin, vwin, gts, cb, cc, ch = jnp.split(proj, split_at, axis=-1)
        q = partial_rope(heads(q, N_HEADS), positions)
        kc = kv_layout(partial_rope(heads(kc, N_KV), positions))
        ksel = kv_layout(partial_rope(heads(ksel, N_KV), positions))
        kwin = kv_layout(partial_rope(heads(kwin, N_KV), positions))
        vc = kv_layout(heads(vc, N_KV))
        vsel = kv_layout(heads(vsel, N_KV))
        vwin = kv_layout(heads(vwin, N_KV))
        attn = nsa_attention(q, kc, vc, ksel, vsel, kwin, vwin, gts,
                             cmp_pe_k[l], cmp_w1_k[l], cmp_w2_k[l],
                             cmp_pe_v[l], cmp_w1_v[l], cmp_w2_v[l])
        conv = cb * causal_dwconv(cc * ch, conv_w[l])
        mix = jnp.concatenate([rmsnorm(attn, grp_g_attn[l]), rmsnorm(conv, grp_g_conv[l])], axis=-1)
        x = x + g1 * (mix @ w_out[l])

        h = rmsnorm(x, norm2_g[l]) * (1.0 + sc2) + sh2
        u = causal_dwconv(h @ ffn_up[l], ffn_conv[l])
        a, v = jnp.split(u, 2, axis=-1)
        x = x + g2 * ((jax.nn.silu(a) * v) @ ffn_down[l])

    return rmsnorm(x, final_g)
```

```cpp
#include <hip/hip_runtime.h>
#include <hip/hip_cooperative_groups.h>
#include <cstdio>
#include <cstdint>
namespace cg = cooperative_groups;

#define LAS __attribute__((address_space(3)))
typedef _Float16 f16;
typedef _Float16 f16x8 __attribute__((ext_vector_type(8)));
typedef _Float16 f16x4 __attribute__((ext_vector_type(4)));
typedef _Float16 f16x2 __attribute__((ext_vector_type(2)));
typedef float f32x4 __attribute__((ext_vector_type(4)));
typedef float f32x2 __attribute__((ext_vector_type(2)));
typedef unsigned u32x4 __attribute__((ext_vector_type(4)));
typedef unsigned u32x2 __attribute__((ext_vector_type(2)));

#ifndef PHMASK
#define PHMASK 0xFFFFFu
#endif
#define PH_EN(b) (((PHMASK) >> (b)) & 1u)
#ifndef MK_ONE_LAUNCH
#define MK_ONE_LAUNCH 0
#endif

constexpr int BATCH = 16, SEQ = 2048, DM = 1024, MTOK = BATCH * SEQ;
constexpr int NIN = 2840, NINP = 3072, DFF = 2816, NUP = 2 * DFF;
constexpr int NWAVES = 8, NTHREADS = 512;
constexpr int NPH = 30;

constexpr size_t MiB = 1u << 20;
constexpr size_t WS_CTL = 0;
constexpr size_t WS_MOD = 1 * MiB;
constexpr size_t WS_ROPE = 2 * MiB;
constexpr size_t WS_HALO = 8 * MiB;
constexpr size_t WS_W = 20 * MiB;
constexpr size_t W_IN_OFF = 0, W_OUT_OFF = 6 * MiB, W_UP_OFF = 8 * MiB, W_DOWN_OFF = 19 * MiB, W_LAYER = 25 * MiB;
constexpr size_t WS_H = 70 * MiB;
constexpr size_t WS_KCMP = 134 * MiB;
constexpr size_t WS_G = 135 * MiB;
constexpr size_t WS_SEL = 139 * MiB;
constexpr size_t WS_BIG = 140 * MiB;
constexpr size_t WS_U = WS_BIG;
constexpr size_t WS_PROJ = WS_BIG;
constexpr size_t WS_IMP = WS_BIG;
constexpr size_t WS_OC = WS_BIG + 32 * MiB;
constexpr size_t WS_ATT = WS_BIG + 96 * MiB;
constexpr size_t WS_MIX = WS_BIG + 128 * MiB;
constexpr size_t WS_Q = WS_BIG + 192 * MiB;
constexpr size_t WS_KV = WS_BIG + 224 * MiB;
constexpr size_t KV_STRIDE = 8 * MiB;
constexpr size_t WS_CB = WS_BIG + 272 * MiB;
constexpr size_t WS_P = WS_BIG + 304 * MiB;
constexpr size_t WS_SUM = WS_BIG + 336 * MiB;
constexpr size_t WS_END = 512 * MiB;

constexpr int RING_BYTES = 131072;
constexpr int LDS_BYTES = 147456;

namespace pg8 {
constexpr int BM = 256, BK = 64, HALF = 128, HTB = HALF * BK * 2, STAGE_BYTES = 8 * HTB, NXCD = 8, WGM = 8;
__host__ __device__ __forceinline__ int lds_byte(int r, int c) { const int st = (r >> 4) * 2 + (c >> 5), rr = r & 15, cc = c & 31, ob = rr * 64 + cc * 2; return st * 1024 + (ob ^ (((ob >> 9) & 1) << 5)); }
__host__ __device__ __forceinline__ void stage_rc(int b, int& R, int& C) { const int st = b / 1024, sb = b % 1024, swz = sb ^ (((sb >> 9) & 1) << 5); R = (st >> 1) * 16 + swz / 64; C = (st & 1) * 32 + (swz % 64) / 2; }
__host__ __device__ __forceinline__ int perm32(int rho) { const int n = rho >> 4, i = rho & 15; return 8 * (i >> 2) + 4 * n + (i & 3); }

struct Unit { int pm, pn; };
struct Gemm { const f16* A; const f16* Bt; int M, N, K, lda; };

struct StaticOrder {
    int nM, nN, nwg, G, c;
    __device__ void init(int M, int N, int G_, int c_) { nM = M / BM; nN = N / BM; nwg = nM * nN; G = G_; c = c_; }
    __device__ bool next(int i, Unit& u) const {
        const long L = (long)i * G + c; if (L >= nwg) return false;
        int wgid = (int)L; { const int q = nwg / NXCD, r = nwg % NXCD, xcd = wgid % NXCD, off = wgid / NXCD; wgid = (xcd < r ? xcd * (q + 1) : r * (q + 1) + (xcd - r) * q) + off; }
        const int nig = WGM * nN, gid = wgid / nig, fm = gid * WGM, gsz = (nM - fm) < WGM ? (nM - fm) : WGM;
        u.pm = fm + ((wgid % nig) % gsz); u.pn = (wgid % nig) / gsz; return true;
    }
};

__device__ __forceinline__ unsigned pk_f16(float lo, float hi) { f32x2 v = {lo, hi}; f16x2 h = __builtin_convertvector(v, f16x2); return __builtin_bit_cast(unsigned, h); }

struct EpiF16 {
    static constexpr bool PERM = true;
    f16* O; int ldc;
    __device__ __forceinline__ void operator()(const f32x4 (&acc)[2][2][4][2], const Unit& u, int wr, int wc, int fr, int fq) const {
        const int row0 = u.pm * BM + wr * 64 + fr; const int col0 = u.pn * BM + wc * 32 + 8 * fq;
#pragma unroll
        for (int ai = 0; ai < 2; ++ai)
#pragma unroll
            for (int m = 0; m < 4; ++m) { f16* rowp = O + (size_t)(row0 + ai * HALF + m * 16) * ldc + col0;
#pragma unroll
                for (int bj = 0; bj < 2; ++bj) { const f32x4 v0 = acc[ai][bj][m][0], v1 = acc[ai][bj][m][1];
                    u32x4 w; w.x = pk_f16(v0[0], v0[1]); w.y = pk_f16(v0[2], v0[3]); w.z = pk_f16(v1[0], v1[1]); w.w = pk_f16(v1[2], v1[3]);
                    *(u32x4*)(rowp + bj * HALF) = w; } }
    }
};
struct EpiResid {
    static constexpr bool PERM = false;
    const float* base; float* out; const float* gate;
    __device__ __forceinline__ void operator()(const f32x4 (&acc)[2][2][4][2], const Unit& u, int wr, int wc, int fr, int fq) const {
        const int col0 = u.pn * BM + wc * 32 + 4 * fq; const int b = (u.pm * BM) >> 11;
        f32x4 gv[2][2];
#pragma unroll
        for (int bj = 0; bj < 2; ++bj)
#pragma unroll
            for (int n = 0; n < 2; ++n) gv[bj][n] = *(const f32x4*)(gate + (size_t)b * 6144 + col0 + bj * HALF + n * 16);
#pragma unroll
        for (int ai = 0; ai < 2; ++ai)
#pragma unroll
            for (int m = 0; m < 4; ++m) { const size_t off = (size_t)(u.pm * BM + ai * HALF + wr * 64 + m * 16 + fr) * DM + col0;
#pragma unroll
                for (int bj = 0; bj < 2; ++bj)
#pragma unroll
                    for (int n = 0; n < 2; ++n) { const f32x4 bs = *(const f32x4*)(base + off + bj * HALF + n * 16);
                        *(f32x4*)(out + off + bj * HALF + n * 16) = bs + gv[bj][n] * acc[ai][bj][m][n]; }
                if (m & 1) asm volatile("" ::: "memory"); }
    }
};

template <class Epi, class Sched, bool ALIGN_EPI = false, bool SP2 = false>
__device__ __forceinline__ void gemm_phase(LAS unsigned char* lds, const Gemm g, const Sched& S, const Epi& E, const int tid) {
    const int wid = __builtin_amdgcn_readfirstlane(tid >> 6), lane = tid & 63, wr = wid >> 2, wc = wid & 3, fr = lane & 15, fq = lane >> 4;
    const int K = g.K, nt = K / BK, lda = g.lda;
    unsigned voffA[2], voffB[2];
#pragma unroll
    for (int i = 0; i < 2; ++i) { int R, C; stage_rc(tid * 16 + i * 8192, R, C); const int Rb = Epi::PERM ? ((R & ~31) + perm32(R & 31)) : R;
        voffA[i] = (unsigned)(R * lda + C) * 2u; voffB[i] = (unsigned)(Rb * K + C) * 2u; }
    const size_t kstep = (size_t)(BK * 2);
    const size_t hstepA = (size_t)HALF * lda * 2, hstepB = (size_t)HALF * K * 2;
    const size_t tstepA = 2 * hstepA, tstepB = 2 * hstepB;
    const unsigned ldsw = (unsigned)wid * 1024u;
    const int aoff = lds_byte(wr * 64 + fr, fq * 8), boff = lds_byte(wc * 32 + fr, fq * 8);
#define PG8_SA(b, h) (((b) * 2 + (h)) * HTB)
#define PG8_SB(b, h) ((4 + (b) * 2 + (h)) * HTB)
#define PG8_STAGE(bufoff, gbase, voff) do { _Pragma("unroll") for (int _i = 0; _i < 2; ++_i) \
        __builtin_amdgcn_global_load_lds((const unsigned*)((const char*)(gbase) + (voff)[_i]), (LAS unsigned*)(lds + (bufoff) + ldsw + _i * 8192), 16, 0, 0); } while (0)
#define PG8_LDA(dst, b, h) do { _Pragma("unroll") for (int m = 0; m < 4; ++m) _Pragma("unroll") for (int k = 0; k < 2; ++k) dst[m][k] = *(const LAS f16x8*)(lds + PG8_SA(b, h) + aoff + m * 2048 + k * 1024); } while (0)
#define PG8_LDB(dst, b, h) do { _Pragma("unroll") for (int n = 0; n < 2; ++n) _Pragma("unroll") for (int k = 0; k < 2; ++k) dst[n][k] = *(const LAS f16x8*)(lds + PG8_SB(b, h) + boff + n * 2048 + k * 1024); } while (0)
#define PG8_MMA(ai, bj, At, Bt) do { __builtin_amdgcn_s_setprio(1); _Pragma("unroll") for (int m = 0; m < 4; ++m) _Pragma("unroll") for (int n = 0; n < 2; ++n) _Pragma("unroll") for (int k = 0; k < 2; ++k) \
        acc[ai][bj][m][n] = __builtin_amdgcn_mfma_f32_16x16x32_f16(Bt[n][k], At[m][k], acc[ai][bj][m][n], 0, 0, 0); __builtin_amdgcn_s_setprio(0); } while (0)
#define PG8_WAIT_V(n) asm volatile("s_waitcnt vmcnt(" #n ")" ::: "memory")
#define PG8_WAIT_L(n) asm volatile("s_waitcnt lgkmcnt(" #n ")" ::: "memory")
#define PG8_BAR __builtin_amdgcn_s_barrier()
#define PG8_SCHED __builtin_amdgcn_sched_barrier(0)
    Unit cur, nxt; int ui = 0;
    if (!S.next(0, cur)) return;
    f32x4 acc[2][2][4][2];
#pragma unroll
    for (int a = 0; a < 2; ++a)
#pragma unroll
        for (int b = 0; b < 2; ++b)
#pragma unroll
            for (int m = 0; m < 4; ++m)
#pragma unroll
                for (int n = 0; n < 2; ++n) acc[a][b][m][n] = (f32x4){0.f, 0.f, 0.f, 0.f};
    f16x8 At[4][2], B0[2][2], B1[2][2];
    const char* cA = (const char*)g.A + (size_t)cur.pm * tstepA; const char* cB = (const char*)g.Bt + (size_t)cur.pn * tstepB;
    if constexpr (SP2) {
        PG8_STAGE(PG8_SB(0, 0), cB, voffB); PG8_STAGE(PG8_SB(0, 1), cB + hstepB, voffB); PG8_STAGE(PG8_SA(0, 0), cA, voffA); PG8_STAGE(PG8_SA(0, 1), cA + hstepA, voffA);
        if (wr == 1) PG8_BAR;
        PG8_WAIT_V(2); PG8_BAR;
        PG8_STAGE(PG8_SB(1, 0), cB + kstep, voffB); PG8_STAGE(PG8_SA(1, 0), cA + kstep, voffA); PG8_STAGE(PG8_SB(1, 1), cB + hstepB + kstep, voffB);
        PG8_WAIT_V(6); PG8_BAR;
    } else {
        PG8_STAGE(PG8_SB(0, 0), cB, voffB); PG8_STAGE(PG8_SA(0, 0), cA, voffA); PG8_STAGE(PG8_SB(0, 1), cB + hstepB, voffB); PG8_STAGE(PG8_SA(0, 1), cA + hstepA, voffA);
        if (wr == 1) PG8_BAR;
        PG8_WAIT_V(4); PG8_BAR;
        PG8_STAGE(PG8_SB(1, 0), cB + kstep, voffB); PG8_STAGE(PG8_SA(1, 0), cA + kstep, voffA); PG8_STAGE(PG8_SB(1, 1), cB + hstepB + kstep, voffB);
        PG8_WAIT_V(6); PG8_BAR;
    }
    for (;;) {
        const bool has_next = S.next(ui + 1, nxt);
        const char* nA = has_next ? (const char*)g.A + (size_t)nxt.pm * tstepA : cA; const char* nB = has_next ? (const char*)g.Bt + (size_t)nxt.pn * tstepB : cB;
        for (int t = 0; t < nt; t += 2) {
            const bool last = (t == nt - 2);
            const char* a1 = cA + (size_t)(t + 1) * kstep;
            const char* a2 = last ? nA : cA + (size_t)(t + 2) * kstep; const char* b2 = last ? nB : cB + (size_t)(t + 2) * kstep;
            const char* a3 = a2 + kstep; const char* b3 = b2 + kstep;
            if constexpr (SP2) {
            PG8_LDB(B0, 0, 0); PG8_LDB(B1, 0, 1); PG8_SCHED; PG8_LDA(At, 0, 0); PG8_STAGE(PG8_SA(1, 1), a1 + hstepA, voffA);
            PG8_WAIT_V(8); PG8_WAIT_L(0); PG8_BAR; PG8_MMA(0, 0, At, B0); PG8_MMA(0, 1, At, B1); PG8_BAR; PG8_SCHED;
            PG8_LDA(At, 0, 1); PG8_STAGE(PG8_SB(0, 0), b2, voffB); PG8_STAGE(PG8_SB(0, 1), b2 + hstepB, voffB); PG8_STAGE(PG8_SA(0, 0), a2, voffA);
            PG8_WAIT_V(8); PG8_WAIT_L(0); PG8_BAR; PG8_MMA(1, 0, At, B0); PG8_MMA(1, 1, At, B1); PG8_BAR; PG8_SCHED;
            PG8_LDB(B0, 1, 0); PG8_LDB(B1, 1, 1); PG8_SCHED; PG8_LDA(At, 1, 0); PG8_STAGE(PG8_SA(0, 1), a2 + hstepA, voffA);
            PG8_WAIT_V(8); PG8_WAIT_L(0); PG8_BAR; PG8_MMA(0, 0, At, B0); PG8_MMA(0, 1, At, B1); PG8_BAR; PG8_SCHED;
            PG8_LDA(At, 1, 1); PG8_STAGE(PG8_SB(1, 0), b3, voffB); PG8_STAGE(PG8_SB(1, 1), b3 + hstepB, voffB); PG8_STAGE(PG8_SA(1, 0), a3, voffA);
            PG8_WAIT_V(8); PG8_WAIT_L(0); PG8_BAR; PG8_MMA(1, 0, At, B0); PG8_MMA(1, 1, At, B1); PG8_BAR; PG8_SCHED;
            } else {
            PG8_LDB(B0, 0, 0); PG8_SCHED; PG8_LDA(At, 0, 0); PG8_STAGE(PG8_SA(1, 1), a1 + hstepA, voffA);
            PG8_WAIT_L(8); PG8_BAR; PG8_WAIT_L(0); PG8_MMA(0, 0, At, B0); PG8_BAR; PG8_SCHED;
            PG8_LDB(B1, 0, 1); PG8_STAGE(PG8_SB(0, 0), b2, voffB);
            PG8_BAR; PG8_WAIT_L(0); PG8_MMA(0, 1, At, B1); PG8_BAR;
            PG8_LDA(At, 0, 1); PG8_STAGE(PG8_SA(0, 0), a2, voffA);
            PG8_BAR; PG8_WAIT_L(0); PG8_MMA(1, 0, At, B0); PG8_BAR; PG8_SCHED;
            PG8_STAGE(PG8_SB(0, 1), b2 + hstepB, voffB);
            PG8_WAIT_V(6); PG8_BAR; PG8_MMA(1, 1, At, B1); PG8_BAR;
            PG8_LDB(B0, 1, 0); PG8_SCHED; PG8_LDA(At, 1, 0); PG8_STAGE(PG8_SA(0, 1), a2 + hstepA, voffA);
            PG8_WAIT_L(8); PG8_BAR; PG8_WAIT_L(0); PG8_MMA(0, 0, At, B0); PG8_BAR; PG8_SCHED;
            PG8_LDB(B1, 1, 1); PG8_STAGE(PG8_SB(1, 0), b3, voffB);
            PG8_BAR; PG8_WAIT_L(0); PG8_MMA(0, 1, At, B1); PG8_BAR;
            PG8_LDA(At, 1, 1); PG8_STAGE(PG8_SA(1, 0), a3, voffA);
            PG8_BAR; PG8_WAIT_L(0); PG8_MMA(1, 0, At, B0); PG8_BAR; PG8_SCHED;
            PG8_STAGE(PG8_SB(1, 1), b3 + hstepB, voffB);
            PG8_WAIT_V(6); PG8_BAR; PG8_MMA(1, 1, At, B1); PG8_BAR;
            }
        }
        if constexpr (ALIGN_EPI) { if (wr == 0) PG8_BAR; }
        E(acc, cur, wr, wc, fr, fq);
        if (!has_next) break;
#pragma unroll
        for (int a = 0; a < 2; ++a)
#pragma unroll
            for (int b = 0; b < 2; ++b)
#pragma unroll
                for (int m = 0; m < 4; ++m)
#pragma unroll
                    for (int n = 0; n < 2; ++n) acc[a][b][m][n] = (f32x4){0.f, 0.f, 0.f, 0.f};
        cur = nxt; cA = nA; cB = nB; ++ui;
        if constexpr (ALIGN_EPI) { if (wr == 1) PG8_BAR; }
    }
    PG8_WAIT_V(0);
    if constexpr (!ALIGN_EPI) { if (wr == 0) PG8_BAR; }
    PG8_BAR;
#undef PG8_SA
#undef PG8_SB
#undef PG8_STAGE
#undef PG8_LDA
#undef PG8_LDB
#undef PG8_MMA
#undef PG8_WAIT_V
#undef PG8_WAIT_L
#undef PG8_BAR
#undef PG8_SCHED
}
}

__device__ __forceinline__ float wave_sum(float v) {
#pragma unroll
    for (int o = 1; o < 64; o <<= 1) v += __shfl_xor(v, o);
    return v;
}
__device__ __forceinline__ float silu_f(float x) { return x / (1.0f + __expf(-x)); }
__device__ __forceinline__ float sigmoid_f(float x) { return 1.0f / (1.0f + __expf(-x)); }
__device__ __forceinline__ unsigned pk2h(float lo, float hi) { return pg8::pk_f16(lo, hi); }

struct Args {
    const float* x; const float* c; const int* pos; const float* w_mod; const float* b_mod; const float* norm1_g; const float* w_in;
    const float* pe_k; const float* w1_k; const float* w2_k; const float* pe_v; const float* w1_v; const float* w2_v;
    const float* conv_w; const float* g_attn; const float* g_conv; const float* w_out; const float* norm2_g;
    const float* ffn_up; const float* ffn_conv; const float* ffn_down; const float* final_g;
    float* out; unsigned char* ws; int ph_lo, ph_hi;
};

__device__ __forceinline__ void transpose_item(const float* W, int K, int Nsrc, int Ndst, f16* WT, LAS float* scr, int item, int lane) {
    const int nblk = Ndst / 32, kb = item / nblk, nb = item % nblk, k0 = 64 * kb, n0 = 32 * nb;
    const int sc = n0 + (lane & 31);
#pragma unroll 8
    for (int i = 0; i < 32; ++i) { const int kk = 2 * i + (lane >> 5); scr[kk * 33 + (lane & 31)] = (sc < Nsrc) ? W[(size_t)(k0 + kk) * Nsrc + sc] : 0.f; }
    asm volatile("s_waitcnt lgkmcnt(0)" ::: "memory");
    const int c = lane & 7;
#pragma unroll
    for (int j = 0; j < 4; ++j) { const int n = (lane >> 3) + 8 * j; const LAS float* s = scr + (8 * c) * 33 + n;
        u32x4 o; o.x = pk2h(s[0 * 33], s[1 * 33]); o.y = pk2h(s[2 * 33], s[3 * 33]); o.z = pk2h(s[4 * 33], s[5 * 33]); o.w = pk2h(s[6 * 33], s[7 * 33]);
        *(u32x4*)(WT + (size_t)(n0 + n) * K + k0 + 8 * c) = o; }
    asm volatile("s_waitcnt lgkmcnt(0)" ::: "memory");
}

__device__ __forceinline__ void sincos_d(double a, float& s, float& c) {
    const double k = rint(a * 0.63661977236758134308);
    double r = fma(-k, 1.57079632679489655800e+00, a); r = fma(-k, 6.12323399573676603587e-17, r);
    const double r2 = r * r;
    double sp = -1.0 / 1307674368000.0;
    sp = fma(sp, r2, 1.0 / 6227020800.0);
    sp = fma(sp, r2, -1.0 / 39916800.0);
    sp = fma(sp, r2, 1.0 / 362880.0);
    sp = fma(sp, r2, -1.0 / 5040.0);
    sp = fma(sp, r2, 1.0 / 120.0);
    sp = fma(sp, r2, -1.0 / 6.0);
    const double sn = fma(sp * r2, r, r);
    double cp = 1.0 / 20922789888000.0;
    cp = fma(cp, r2, -1.0 / 87178291200.0);
    cp = fma(cp, r2, 1.0 / 479001600.0);
    cp = fma(cp, r2, -1.0 / 3628800.0);
    cp = fma(cp, r2, 1.0 / 40320.0);
    cp = fma(cp, r2, -1.0 / 720.0);
    cp = fma(cp, r2, 1.0 / 24.0);
    cp = fma(cp, r2, -0.5);
    const double cs = fma(cp, r2, 1.0);
    const int q = ((int)k) & 3;
    const double ss = (q == 0) ? sn : (q == 1) ? cs : (q == 2) ? -sn : -cs;
    const double cc = (q == 0) ? cs : (q == 1) ? -sn : (q == 2) ? -cs : sn;
    s = (float)ss; c = (float)cc;
}

template <int ph>
__device__ __forceinline__ void run_phase(LAS unsigned char* lds) {
    {
        const Args* ap = (const Args*)__builtin_amdgcn_kernarg_segment_ptr();
        asm volatile("" : "+s"(ap));
        const Args& A = *ap;
        int tid = threadIdx.x; asm volatile("" : "+v"(tid));
        const int lane = tid & 63, wave = __builtin_amdgcn_readfirstlane(tid >> 6);
        int G = gridDim.x, bx = blockIdx.x; asm volatile("" : "+s"(G), "+s"(bx));
        const int gw = bx * NWAVES + wave, NGW = G * NWAVES;
        const int gt = bx * NTHREADS + tid, NGT = G * NTHREADS;
        unsigned char* ws = A.ws;
        float* MOD = (float*)(ws + WS_MOD);
        float* ROPE = (float*)(ws + WS_ROPE);
        f16* HALO = (f16*)(ws + WS_HALO);
        f16* Hb = (f16*)(ws + WS_H);
        f16* KCMP = (f16*)(ws + WS_KCMP);
        float* Gt = (float*)(ws + WS_G);
        unsigned* SEL = (unsigned*)(ws + WS_SEL);
        f16* U = (f16*)(ws + WS_U);
        f16* PROJ = (f16*)(ws + WS_PROJ);
        float* IMP = (float*)(ws + WS_IMP);
        float* OC = (float*)(ws + WS_OC);
        f16* ATT = (f16*)(ws + WS_ATT);
        f16* MIX = (f16*)(ws + WS_MIX);
        f16* Qb = (f16*)(ws + WS_Q);
        f16* KVb = (f16*)(ws + WS_KV);
        f16* CBb = (f16*)(ws + WS_CB);
        f16* Pb = (f16*)(ws + WS_P);
        float* SUMb = (float*)(ws + WS_SUM);
        constexpr int l = (ph >= 1 && ph < 29) ? (ph - 1) / 14 : 0;
        constexpr int k = (ph >= 1 && ph < 29) ? (ph - 1) % 14 : (ph == 0 ? 100 : 101);
        unsigned char* wl = ws + WS_W + (size_t)l * W_LAYER;
        f16* Win_t = (f16*)(wl + W_IN_OFF); f16* Wout_t = (f16*)(wl + W_OUT_OFF); f16* Wup_t = (f16*)(wl + W_UP_OFF); f16* Wdown_t = (f16*)(wl + W_DOWN_OFF);
        const float* modl = MOD + (size_t)l * 16 * 6144;

        if (PH_EN(14) && k == 100) {
            {
                LAS float* scr = (LAS float*)(lds + wave * 16384);
                constexpr int I_IN = 16 * (NINP / 32), I_OUT = 16 * 32, I_UP = 16 * (NUP / 32), I_DN = (DFF / 64) * 32, I_L = I_IN + I_OUT + I_UP + I_DN;
                for (int it = gw; it < 2 * I_L; it += NGW) {
                    const int ll = it / I_L; int r = it % I_L;
                    unsigned char* wll = ws + WS_W + (size_t)ll * W_LAYER;
                    if (r < I_IN) { transpose_item(A.w_in + (size_t)ll * DM * NIN, DM, NIN, NINP, (f16*)(wll + W_IN_OFF), scr, r, lane); continue; } r -= I_IN;
                    if (r < I_OUT) { transpose_item(A.w_out + (size_t)ll * DM * DM, DM, DM, DM, (f16*)(wll + W_OUT_OFF), scr, r, lane); continue; } r -= I_OUT;
                    if (r < I_UP) { transpose_item(A.ffn_up + (size_t)ll * DM * NUP, DM, NUP, NUP, (f16*)(wll + W_UP_OFF), scr, r, lane); continue; } r -= I_UP;
                    transpose_item(A.ffn_down + (size_t)ll * DFF * DM, DFF, DM, DM, (f16*)(wll + W_DOWN_OFF), scr, r, lane);
                }
            }
            __syncthreads();
            for (int it = gt; it < MTOK * 8; it += NGT) {
                const int m = it >> 3, i = it & 7;
                const double fr = (i == 0) ? 1.0 : (i == 1) ? 0.19392274474868576 : (i == 2) ? 0.03760603093086393 : (i == 3) ? 0.007292664737217109 :
                                  (i == 4) ? 0.001414213562373095 : (i == 5) ? 0.0002742481756762073 : (i == 6) ? 5.318295896944988e-05 : 1.031338537721246e-05;
                float s, c; sincos_d((double)A.pos[m] * fr, s, c);
                ROPE[(size_t)m * 16 + i] = c; ROPE[(size_t)m * 16 + 8 + i] = s;
            }
            {
                LAS float* ca = (LAS float*)lds;
                LAS float* red = (LAS float*)(lds + 65536);
                bool staged = false;
                for (int it = bx; it < 2 * 96; it += G) {
                    if (!staged) { for (int i = tid; i < 16 * 1024; i += NTHREADS) ca[i] = silu_f(A.c[i]); staged = true; }
                    __syncthreads();
                    const int ll = it / 96, n0 = (it % 96) * 64;
                    const float* wm = A.w_mod + (size_t)ll * DM * 6144 + n0 + lane;
                    float acc[16];
#pragma unroll
                    for (int b = 0; b < 16; ++b) acc[b] = 0.f;
                    for (int kk = wave * 128; kk < wave * 128 + 128; kk += 8) {
                        float w[8];
#pragma unroll
                        for (int u = 0; u < 8; ++u) w[u] = wm[(size_t)(kk + u) * 6144];
#pragma unroll
                        for (int u = 0; u < 8; ++u)
#pragma unroll
                            for (int b = 0; b < 16; ++b) acc[b] = fmaf(ca[b * 1024 + kk + u], w[u], acc[b]);
                    }
#pragma unroll
                    for (int b = 0; b < 16; ++b) red[(wave * 16 + b) * 64 + lane] = acc[b];
                    __syncthreads();
                    for (int o = tid; o < 1024; o += NTHREADS) { const int b = o >> 6, n = o & 63; float s = 0.f;
#pragma unroll
                        for (int w8 = 0; w8 < 8; ++w8) s += red[(w8 * 16 + b) * 64 + n];
                        MOD[((size_t)ll * 16 + b) * 6144 + n0 + n] = s + A.b_mod[(size_t)ll * 6144 + n0 + n]; }
                    __syncthreads();
                }
            }
        } else if (PH_EN(0) && (k == 0 || k == 9)) {
            const float* xin = (k == 0 && l == 0) ? A.x : A.out;
            const float* gain = (k == 0 ? A.norm1_g : A.norm2_g) + (size_t)l * DM;
            const float* shp = modl + (k == 0 ? 0 : 3) * 1024; const float* scp = modl + (k == 0 ? 1 : 4) * 1024;
            for (int m = gw; m < MTOK; m += NGW) {
                const int b = m >> 11;
                const f32x4* xr = (const f32x4*)(xin + (size_t)m * DM) + lane;
                f32x4 v[4]; float s = 0.f;
#pragma unroll
                for (int j = 0; j < 4; ++j) { v[j] = xr[64 * j]; s += (v[j].x * v[j].x + v[j].y * v[j].y) + (v[j].z * v[j].z + v[j].w * v[j].w); }
                const float r = 1.0f / sqrtf(wave_sum(s) * (1.0f / DM) + 1e-6f);
#pragma unroll
                for (int j = 0; j < 4; ++j) { const int col = 4 * lane + 256 * j;
                    const f32x4 g4 = *(const f32x4*)(gain + col), sc4 = *(const f32x4*)(scp + (size_t)b * 6144 + col), sh4 = *(const f32x4*)(shp + (size_t)b * 6144 + col);
                    const f32x4 o = (v[j] * r) * g4 * (sc4 + 1.0f) + sh4;
                    u32x2 w; w.x = pk2h(o.x, o.y); w.y = pk2h(o.z, o.w);
                    *(u32x2*)(Hb + (size_t)m * DM + col) = w; }
            }
        } else if (PH_EN(1) && (k == 1 || k == 10)) {
            pg8::Gemm g; pg8::EpiF16 E;
            if (k == 1) { g = pg8::Gemm{Hb, Win_t, MTOK, NINP, DM, DM}; E = pg8::EpiF16{PROJ, NINP}; }
            else { g = pg8::Gemm{Hb, Wup_t, MTOK, NUP, DM, DM}; E = pg8::EpiF16{U, NUP}; }
            pg8::StaticOrder S; S.init(g.M, g.N, G, bx);
            pg8::gemm_phase<pg8::EpiF16, pg8::StaticOrder, true, true>(lds, g, S, E, tid);
        } else if (PH_EN(8) && (k == 8 || k == 13)) {
            pg8::Gemm g; pg8::EpiResid E;
            if (k == 8) { g = pg8::Gemm{MIX, Wout_t, MTOK, DM, DM, DM}; E = pg8::EpiResid{(l == 0) ? A.x : A.out, A.out, modl + 2 * 1024}; }
            else { g = pg8::Gemm{U, Wdown_t, MTOK, DM, DFF, NUP}; E = pg8::EpiResid{A.out, A.out, modl + 5 * 1024}; }
            pg8::StaticOrder S; S.init(g.M, g.N, G, bx);
            pg8::gemm_phase<pg8::EpiResid, pg8::StaticOrder, true, true>(lds, g, S, E, tid);
        } else if (PH_EN(2) && k == 2) {
            for (int idx = gt; idx < MTOK * NIN; idx += NGT) {
                const int m = idx / NIN, col = idx - m * NIN;
                const f16* pr = PROJ + (size_t)m * NINP;
                if (col < 1280) {
                    bool rope; int d;
                    if (col < 512) { d = col & 63; rope = d < 16; }
                    else { const int kvi = (col - 512) >> 7; d = (col - 512) & 63; rope = ((kvi & 1) == 0) && d < 16; }
                    float o;
                    if (rope) { const int i = d & 7, base = col - d; const float x1 = (float)pr[base + i], x2 = (float)pr[base + 8 + i];
                        const float cs = ROPE[(size_t)m * 16 + i], sn = ROPE[(size_t)m * 16 + 8 + i];
                        o = (d < 8) ? (x1 * cs - x2 * sn) : (x2 * cs + x1 * sn); }
                    else o = (float)pr[col];
                    if (col < 512) Qb[(size_t)m * 512 + col] = (f16)o;
                    else { const int kvi = (col - 512) >> 7, cc = (col - 512) & 127; KVb[(size_t)kvi * (KV_STRIDE / 2) + (size_t)m * 128 + cc] = (f16)o; }
                } else if (col < 1304) { Gt[(size_t)m * 32 + (col - 1280)] = sigmoid_f((float)pr[col]); }
                else if (col < 1816) { CBb[(size_t)m * 512 + (col - 1304)] = pr[col]; }
                else if (col < 2328) { Pb[(size_t)m * 512 + (col - 1816)] = (f16)((float)pr[col] * (float)pr[col + 512]); }
            }
        } else if (PH_EN(3) && k == 3) {
            LAS float* tokl = (LAS float*)lds;
            LAS float* pel = (LAS float*)(lds + 36864);
            LAS float* red = (LAS float*)(lds + 36864 + 8192);
            LAS float* hid = (LAS float*)(lds + 36864 + 8192 + 18432);
            for (int it = bx; it < 2 * 16 * 2 * 16; it += G) {
                const int jg = it & 15, hk = (it >> 4) & 1, b = (it >> 5) & 15, kv = it >> 9;
                const f16* src = KVb + (size_t)kv * (KV_STRIDE / 2);
                const float* pe = (kv ? A.pe_v : A.pe_k) + (size_t)l * 32 * 64;
                const float* w1 = (kv ? A.w1_v : A.w1_k) + (size_t)l * 2048 * 128;
                const float* w2 = (kv ? A.w2_v : A.w2_k) + (size_t)l * 128 * 64;
                __syncthreads();
                for (int i = tid; i < 144 * 64; i += NTHREADS) { const int tt = 128 * jg + (i >> 6); tokl[i] = (tt < SEQ) ? (float)src[((size_t)(b * SEQ + tt)) * 128 + hk * 64 + (i & 63)] : 0.f; }
                for (int i = tid; i < 32 * 64; i += NTHREADS) pel[i] = pe[i];
                __syncthreads();
                const int n = tid & 127, part = tid >> 7;
                float acc[9];
#pragma unroll
                for (int j = 0; j < 9; ++j) acc[j] = 0.f;
                for (int ld = part * 512; ld < part * 512 + 512; ++ld) {
                    const float w = w1[(size_t)ld * 128 + n];
#pragma unroll
                    for (int j = 0; j < 8; ++j) acc[j] = fmaf(tokl[j * 16 * 64 + ld], w, acc[j]);
                    acc[8] = fmaf(pel[ld], w, acc[8]);
                }
#pragma unroll
                for (int j = 0; j < 9; ++j) red[(part * 9 + j) * 128 + n] = acc[j];
                __syncthreads();
                for (int o = tid; o < 1024; o += NTHREADS) { const int j = o >> 7, nn = o & 127;
                    float s = 0.f;
#pragma unroll
                    for (int p = 0; p < 4; ++p) s += red[(p * 9 + j) * 128 + nn] + red[(p * 9 + 8) * 128 + nn];
                    hid[j * 128 + nn] = silu_f(s); }
                __syncthreads();
                { const int j = tid >> 6, d = tid & 63, jj = 8 * jg + j; float s = 0.f;
                    for (int nn = 0; nn < 128; ++nn) s = fmaf(hid[j * 128 + nn], w2[nn * 64 + d], s);
                    if (jj < 127) KCMP[((((size_t)kv * 16 + b) * 2 + hk) * 128 + jj) * 64 + d] = (f16)s; }
            }
        } else if (PH_EN(4) && k == 4) {
            for (int it = gw; it < 16 * 32 * 8; it += NGW) {
                const int h = it & 7, qb = (it >> 3) & 31, b = it >> 8, hk = h >> 2;
                const int t = 64 * qb + lane, m = b * SEQ + t;
                float q[64];
                { const f16x8* qp = (const f16x8*)(Qb + (size_t)m * 512 + h * 64);
#pragma unroll
                    for (int c8 = 0; c8 < 8; ++c8) { const f16x8 v = qp[c8];
#pragma unroll
                        for (int e = 0; e < 8; ++e) q[c8 * 8 + e] = (float)v[e] * 0.125f; } }
                const int tmax = 64 * qb + 63;
                const int nvw = (tmax >= 31) ? min(127, (tmax - 31) / 16 + 1) : 0;
                const f16* kc = KCMP + (((size_t)0 * 16 + b) * 2 + hk) * 128 * 64;
                const f16* vc = KCMP + (((size_t)1 * 16 + b) * 2 + hk) * 128 * 64;
                float mx = -INFINITY;
                for (int kk = 0; kk < nvw; ++kk) {
                    const f16x8* kp = (const f16x8*)(kc + kk * 64); float s = 0.f;
#pragma unroll
                    for (int c8 = 0; c8 < 8; ++c8) { const f16x8 v = kp[c8];
#pragma unroll
                        for (int e = 0; e < 8; ++e) s = fmaf(q[c8 * 8 + e], (float)v[e], s); }
                    if (16 * kk + 31 <= t) mx = fmaxf(mx, s);
                }
                float sum = 0.f, eprev = 0.f; float oc[64];
#pragma unroll
                for (int d = 0; d < 64; ++d) oc[d] = 0.f;
                float* impp = IMP + ((size_t)m * 8 + h) * 32;
                for (int kb = 0; kb < 32; ++kb) {
                    float eb = eprev;
                    for (int u = 0; u < 4; ++u) {
                        const int kk = 4 * kb + u; float e = 0.f;
                        if (kk < nvw) {
                            const f16x8* kp = (const f16x8*)(kc + kk * 64); float s = 0.f;
#pragma unroll
                            for (int c8 = 0; c8 < 8; ++c8) { const f16x8 v = kp[c8];
#pragma unroll
                                for (int ee = 0; ee < 8; ++ee) s = fmaf(q[c8 * 8 + ee], (float)v[ee], s); }
                            e = (16 * kk + 31 <= t) ? __expf(s - mx) : 0.f;
                            sum += e;
                            const f16x8* vp = (const f16x8*)(vc + kk * 64);
#pragma unroll
                            for (int c8 = 0; c8 < 8; ++c8) { const f16x8 v = vp[c8];
#pragma unroll
                                for (int ee = 0; ee < 8; ++ee) oc[c8 * 8 + ee] = fmaf(e, (float)v[ee], oc[c8 * 8 + ee]); }
                        }
                        eb += e; eprev = e;
                    }
                    impp[kb] = eb;
                }
                SUMb[(size_t)m * 8 + h] = sum;
                const float inv = Gt[(size_t)m * 32 + h * 3 + 0] / fmaxf(sum, 1e-30f);
                float* ocp = OC + (size_t)m * 512 + h * 64;
#pragma unroll
                for (int d = 0; d < 64; d += 4) *(f32x4*)(ocp + d) = (f32x4){oc[d] * inv, oc[d + 1] * inv, oc[d + 2] * inv, oc[d + 3] * inv};
            }
        } else if (PH_EN(5) && k == 5) {
            for (int it = gt; it < MTOK * 2; it += NGT) {
                const int m = it >> 1, hk = it & 1, t = m & (SEQ - 1), bq = t >> 6;
                float inv[4];
#pragma unroll
                for (int g4 = 0; g4 < 4; ++g4) inv[g4] = 1.0f / fmaxf(SUMb[(size_t)m * 8 + hk * 4 + g4], 1e-30f);
                const float* ip = IMP + ((size_t)m * 8 + hk * 4) * 32;
                unsigned mask = 0u;
                for (int r = 0; r < 8; ++r) {
                    int best = -1; float bv = -INFINITY;
                    for (int j = 0; j <= bq; ++j) {
                        if ((mask >> j) & 1u) continue;
                        float v;
                        if (j == 0 || j == bq || j == bq - 1) v = INFINITY;
                        else v = (ip[j] * inv[0] + ip[32 + j] * inv[1]) + (ip[64 + j] * inv[2] + ip[96 + j] * inv[3]);
                        if (v > bv) { bv = v; best = j; }
                    }
                    if (best >= 0) mask |= 1u << best;
                }
                SEL[it] = mask;
            }
        } else if (PH_EN(6) && k == 6) {
            for (int it = gw; it < 16 * 32 * 8; it += NGW) {
                const int h = it & 7, qb = (it >> 3) & 31, b = it >> 8, hk = h >> 2;
                const int t = 64 * qb + lane, m = b * SEQ + t;
                float q[64];
                { const f16x8* qp = (const f16x8*)(Qb + (size_t)m * 512 + h * 64);
#pragma unroll
                    for (int c8 = 0; c8 < 8; ++c8) { const f16x8 v = qp[c8];
#pragma unroll
                        for (int e = 0; e < 8; ++e) q[c8 * 8 + e] = (float)v[e] * 0.125f; } }
                const unsigned mask = SEL[(size_t)m * 2 + hk];
                float* ocp = OC + (size_t)m * 512 + h * 64;
                for (int br = 0; br < 2; ++br) {
                    const f16* Kp = KVb + (size_t)(2 + 2 * br) * (KV_STRIDE / 2) + (size_t)b * SEQ * 128 + hk * 64;
                    const f16* Vp = KVb + (size_t)(3 + 2 * br) * (KV_STRIDE / 2) + (size_t)b * SEQ * 128 + hk * 64;
                    float mr = -INFINITY, lsum = 0.f; float o[64];
#pragma unroll
                    for (int d = 0; d < 64; ++d) o[d] = 0.f;
                    const int jlo = (br == 0) ? 0 : max(0, qb - 8);
                    for (int j = jlo; j <= qb; ++j) {
                        const bool selj = (br == 0) ? (((mask >> j) & 1u) != 0u) : true;
                        if (__ballot(selj) == 0ull) continue;
                        for (int i = 0; i < 64; ++i) {
                            const int p = 64 * j + i;
                            const bool valid = selj && (p <= t) && (br == 0 || (t - p) < 512);
                            if (__ballot(valid) == 0ull) continue;
                            const f16x8* kp = (const f16x8*)(Kp + (size_t)p * 128); float s = 0.f;
#pragma unroll
                            for (int c8 = 0; c8 < 8; ++c8) { const f16x8 v = kp[c8];
#pragma unroll
                                for (int e = 0; e < 8; ++e) s = fmaf(q[c8 * 8 + e], (float)v[e], s); }
                            if (valid) {
                                const float mn = fmaxf(mr, s), a = __expf(mr - mn), pz = __expf(s - mn);
                                lsum = lsum * a + pz; mr = mn;
                                const f16x8* vp = (const f16x8*)(Vp + (size_t)p * 128);
#pragma unroll
                                for (int c8 = 0; c8 < 8; ++c8) { const f16x8 v = vp[c8];
#pragma unroll
                                    for (int e = 0; e < 8; ++e) o[c8 * 8 + e] = fmaf(pz, (float)v[e], o[c8 * 8 + e] * a); }
                            }
                        }
                    }
                    const float gg = Gt[(size_t)m * 32 + h * 3 + 1 + br] / fmaxf(lsum, 1e-30f);
                    if (br == 0) {
#pragma unroll
                        for (int d = 0; d < 64; d += 4) { f32x4 r4 = *(f32x4*)(ocp + d); r4.x = fmaf(gg, o[d], r4.x); r4.y = fmaf(gg, o[d + 1], r4.y); r4.z = fmaf(gg, o[d + 2], r4.z); r4.w = fmaf(gg, o[d + 3], r4.w); *(f32x4*)(ocp + d) = r4; }
                    } else {
                        f16* ap = ATT + (size_t)m * 512 + h * 64;
#pragma unroll
                        for (int d = 0; d < 64; d += 8) { const f32x4 r0 = *(const f32x4*)(ocp + d), r1 = *(const f32x4*)(ocp + d + 4);
                            u32x4 w; w.x = pk2h(fmaf(gg, o[d], r0.x), fmaf(gg, o[d + 1], r0.y)); w.y = pk2h(fmaf(gg, o[d + 2], r0.z), fmaf(gg, o[d + 3], r0.w));
                            w.z = pk2h(fmaf(gg, o[d + 4], r1.x), fmaf(gg, o[d + 5], r1.y)); w.w = pk2h(fmaf(gg, o[d + 6], r1.z), fmaf(gg, o[d + 7], r1.w));
                            *(u32x4*)(ap + d) = w; }
                    }
                }
            }
        } else if (PH_EN(7) && k == 7) {
            const float* ga = A.g_attn + (size_t)l * 512; const float* gc = A.g_conv + (size_t)l * 512; const float* cw = A.conv_w + (size_t)l * 3 * 512;
            for (int m = gw; m < MTOK; m += NGW) {
                const int t = m & (SEQ - 1); const int c0 = 8 * lane;
                { const f16x8 v = *(const f16x8*)(ATT + (size_t)m * 512 + c0); float f[8]; float s = 0.f;
#pragma unroll
                    for (int e = 0; e < 8; ++e) { f[e] = (float)v[e]; s += f[e] * f[e]; }
                    const float r = 1.0f / sqrtf(wave_sum(s) * (1.0f / 512.0f) + 1e-6f);
                    u32x4 w; w.x = pk2h(f[0] * r * ga[c0 + 0], f[1] * r * ga[c0 + 1]); w.y = pk2h(f[2] * r * ga[c0 + 2], f[3] * r * ga[c0 + 3]);
                    w.z = pk2h(f[4] * r * ga[c0 + 4], f[5] * r * ga[c0 + 5]); w.w = pk2h(f[6] * r * ga[c0 + 6], f[7] * r * ga[c0 + 7]);
                    *(u32x4*)(MIX + (size_t)m * DM + c0) = w; }
                { const f16x8 p0 = *(const f16x8*)(Pb + (size_t)m * 512 + c0);
                    f16x8 p1 = (f16x8)(f16)0.f, p2 = (f16x8)(f16)0.f;
                    if (t >= 1) p1 = *(const f16x8*)(Pb + (size_t)(m - 1) * 512 + c0);
                    if (t >= 2) p2 = *(const f16x8*)(Pb + (size_t)(m - 2) * 512 + c0);
                    const f16x8 cb = *(const f16x8*)(CBb + (size_t)m * 512 + c0);
                    float f[8]; float s = 0.f;
#pragma unroll
                    for (int e = 0; e < 8; ++e) { const float y = cw[c0 + e] * (float)p2[e] + cw[512 + c0 + e] * (float)p1[e] + cw[1024 + c0 + e] * (float)p0[e];
                        f[e] = (float)cb[e] * y; s += f[e] * f[e]; }
                    const float r = 1.0f / sqrtf(wave_sum(s) * (1.0f / 512.0f) + 1e-6f);
                    u32x4 w; w.x = pk2h(f[0] * r * gc[c0 + 0], f[1] * r * gc[c0 + 1]); w.y = pk2h(f[2] * r * gc[c0 + 2], f[3] * r * gc[c0 + 3]);
                    w.z = pk2h(f[4] * r * gc[c0 + 4], f[5] * r * gc[c0 + 5]); w.w = pk2h(f[6] * r * gc[c0 + 6], f[7] * r * gc[c0 + 7]);
                    *(u32x4*)(MIX + (size_t)m * DM + 512 + c0) = w; }
            }
        } else if (PH_EN(11) && k == 11) {
            for (int it = gt; it < 512 * 2 * (NUP / 8); it += NGT) {
                const int ch = it % (NUP / 8), rr = (it / (NUP / 8)) & 1, gI = it / (2 * (NUP / 8));
                *(u32x4*)(HALO + ((size_t)gI * 2 + rr) * NUP + ch * 8) = *(const u32x4*)(U + (size_t)(64 * gI + 62 + rr) * NUP + ch * 8);
            }
        } else if (PH_EN(12) && k == 12) {
            const float* fc = A.ffn_conv + (size_t)l * 3 * NUP;
            for (int it = gw; it < 512 * 6; it += NGW) {
                const int gI = it / 6, chunk = it % 6, c8 = chunk * 64 + lane;
                if (c8 < DFF / 8) {
                    const int c = 8 * c8;
                    float wa[3][8], wv[3][8];
#pragma unroll
                    for (int kk = 0; kk < 3; ++kk)
#pragma unroll
                        for (int e = 0; e < 8; ++e) { wa[kk][e] = fc[(size_t)kk * NUP + c + e]; wv[kk][e] = fc[(size_t)kk * NUP + DFF + c + e]; }
                    f16x8 a1 = (f16x8)(f16)0.f, a2 = a1, v1 = a1, v2 = a1;
                    if ((gI & 31) != 0) { const f16* hp = HALO + (size_t)(gI - 1) * 2 * NUP;
                        a2 = *(const f16x8*)(hp + c); v2 = *(const f16x8*)(hp + DFF + c); a1 = *(const f16x8*)(hp + NUP + c); v1 = *(const f16x8*)(hp + NUP + DFF + c); }
                    for (int r = 0; r < 64; ++r) {
                        f16* up = U + (size_t)(64 * gI + r) * NUP;
                        const f16x8 a0 = *(const f16x8*)(up + c), v0 = *(const f16x8*)(up + DFF + c);
                        float o[8];
#pragma unroll
                        for (int e = 0; e < 8; ++e) { const float ya = wa[0][e] * (float)a2[e] + wa[1][e] * (float)a1[e] + wa[2][e] * (float)a0[e];
                            const float yv = wv[0][e] * (float)v2[e] + wv[1][e] * (float)v1[e] + wv[2][e] * (float)v0[e];
                            o[e] = silu_f(ya) * yv; }
                        u32x4 w; w.x = pk2h(o[0], o[1]); w.y = pk2h(o[2], o[3]); w.z = pk2h(o[4], o[5]); w.w = pk2h(o[6], o[7]);
                        *(u32x4*)(up + c) = w;
                        a2 = a1; a1 = a0; v2 = v1; v1 = v0;
                    }
                }
            }
        } else if (PH_EN(15) && k == 101) {
            for (int m = gw; m < MTOK; m += NGW) {
                f32x4* xr = (f32x4*)(A.out + (size_t)m * DM) + lane;
                f32x4 v[4]; float s = 0.f;
#pragma unroll
                for (int j = 0; j < 4; ++j) { v[j] = xr[64 * j]; s += (v[j].x * v[j].x + v[j].y * v[j].y) + (v[j].z * v[j].z + v[j].w * v[j].w); }
                const float r = 1.0f / sqrtf(wave_sum(s) * (1.0f / DM) + 1e-6f);
#pragma unroll
                for (int j = 0; j < 4; ++j) { const f32x4 g4 = *(const f32x4*)(A.final_g + 4 * lane + 256 * j); xr[64 * j] = (v[j] * r) * g4; }
            }
        }
    }
}

__global__ void __launch_bounds__(NTHREADS, 2) fwd_kernel(Args A0) {
    extern __shared__ __attribute__((aligned(16))) unsigned char lds_raw[];
    LAS unsigned char* lds = (LAS unsigned char*)lds_raw;
    cg::grid_group grid = cg::this_grid();
    const int ph_lo = A0.ph_lo, ph_hi = A0.ph_hi;
#define STEP(P) if (ph_lo <= (P) && (P) < ph_hi) { run_phase<(P)>(lds); if ((P) + 1 < ph_hi) grid.sync(); }
    STEP(0) STEP(1) STEP(2) STEP(3) STEP(4) STEP(5) STEP(6) STEP(7) STEP(8) STEP(9)
    STEP(10) STEP(11) STEP(12) STEP(13) STEP(14) STEP(15) STEP(16) STEP(17) STEP(18) STEP(19)
    STEP(20) STEP(21) STEP(22) STEP(23) STEP(24) STEP(25) STEP(26) STEP(27) STEP(28) STEP(29)
#undef STEP
}

extern "C" void kernel_launch(void* const* d_in, const int* in_sizes, int n_in, void* d_out, int out_size, void* d_ws, size_t ws_size, hipStream_t stream) {
    static int grid = 0;
    if (grid == 0) {
        if (n_in != 22 || out_size != MTOK * DM || ws_size < WS_END) { fprintf(stderr, "kernel_launch: unexpected shapes (n_in %d out %d ws %zu)\n", n_in, out_size, ws_size); grid = -1; return; }
        int dev = 0, cus = 0, per_cu = 0;
        hipGetDevice(&dev);
        hipDeviceGetAttribute(&cus, hipDeviceAttributeMultiprocessorCount, dev);
        hipFuncSetAttribute((const void*)fwd_kernel, hipFuncAttributeMaxDynamicSharedMemorySize, LDS_BYTES);
        hipOccupancyMaxActiveBlocksPerMultiprocessor(&per_cu, (const void*)fwd_kernel, NTHREADS, LDS_BYTES);
        (void)hipGetLastError();
        if (per_cu < 1) per_cu = 1;
        grid = cus * per_cu;
    }
    if (grid < 0) return;
    Args a{};
    a.x = (const float*)d_in[0]; a.c = (const float*)d_in[1]; a.pos = (const int*)d_in[2]; a.w_mod = (const float*)d_in[3]; a.b_mod = (const float*)d_in[4];
    a.norm1_g = (const float*)d_in[5]; a.w_in = (const float*)d_in[6]; a.pe_k = (const float*)d_in[7]; a.w1_k = (const float*)d_in[8]; a.w2_k = (const float*)d_in[9];
    a.pe_v = (const float*)d_in[10]; a.w1_v = (const float*)d_in[11]; a.w2_v = (const float*)d_in[12]; a.conv_w = (const float*)d_in[13]; a.g_attn = (const float*)d_in[14];
    a.g_conv = (const float*)d_in[15]; a.w_out = (const float*)d_in[16]; a.norm2_g = (const float*)d_in[17]; a.ffn_up = (const float*)d_in[18]; a.ffn_conv = (const float*)d_in[19];
    a.ffn_down = (const float*)d_in[20]; a.final_g = (const float*)d_in[21];
    a.out = (float*)d_out; a.ws = (unsigned char*)d_ws;
#if MK_ONE_LAUNCH
    a.ph_lo = 0; a.ph_hi = NPH;
    void* args[] = {&a};
    hipError_t e = hipLaunchCooperativeKernel((const void*)fwd_kernel, dim3(grid), dim3(NTHREADS), args, LDS_BYTES, stream);
    if (e != hipSuccess) fprintf(stderr, "cooperative launch failed: %s (grid %d)\n", hipGetErrorString(e), grid);
#else
    for (int ph = 0; ph < NPH; ++ph) {
        a.ph_lo = ph; a.ph_hi = ph + 1;
        hipLaunchKernelGGL(fwd_kernel, dim3(grid), dim3(NTHREADS), LDS_BYTES, stream, a);
    }
#endif
}
```

```cpp
#include <hip/hip_runtime.h>
#include <hip/hip_cooperative_groups.h>
#include <cstdio>
#include <cstdint>
namespace cg = cooperative_groups;

#define LAS __attribute__((address_space(3)))
typedef _Float16 f16;
typedef _Float16 f16x8 __attribute__((ext_vector_type(8)));
typedef _Float16 f16x4 __attribute__((ext_vector_type(4)));
typedef _Float16 f16x2 __attribute__((ext_vector_type(2)));
typedef float f32x4 __attribute__((ext_vector_type(4)));
typedef float f32x2 __attribute__((ext_vector_type(2)));
typedef unsigned u32x4 __attribute__((ext_vector_type(4)));
typedef unsigned u32x2 __attribute__((ext_vector_type(2)));

#ifndef PHMASK
#define PHMASK 0xFFFFFu
#endif
#define PH_EN(b) (((PHMASK) >> (b)) & 1u)
#ifndef MK_ONE_LAUNCH
#define MK_ONE_LAUNCH 1
#endif

constexpr int BATCH = 16, SEQ = 2048, DM = 1024, MTOK = BATCH * SEQ;
constexpr int NIN = 2840, NINP = 3072, DFF = 2816, NUP = 2 * DFF;
constexpr int NWAVES = 8, NTHREADS = 512;
constexpr int NPH = 30;

constexpr size_t MiB = 1u << 20;
constexpr size_t WS_CTL = 0;
constexpr size_t WS_MOD = 1 * MiB;
constexpr size_t WS_ROPE = 2 * MiB;
constexpr size_t WS_HALO = 8 * MiB;
constexpr size_t WS_W = 20 * MiB;
constexpr size_t W_IN_OFF = 0, W_OUT_OFF = 6 * MiB, W_UP_OFF = 8 * MiB, W_DOWN_OFF = 19 * MiB, W_LAYER = 25 * MiB;
constexpr size_t WS_H = 70 * MiB;
constexpr size_t WS_KCMP = 134 * MiB;
constexpr size_t WS_G = 135 * MiB;
constexpr size_t WS_SEL = 139 * MiB;
constexpr size_t WS_BIG = 140 * MiB;
constexpr size_t WS_U = WS_BIG;
constexpr size_t WS_PROJ = WS_BIG;
constexpr size_t WS_IMP = WS_BIG;
constexpr size_t WS_OC = WS_BIG + 32 * MiB;
constexpr size_t WS_ATT = WS_BIG + 96 * MiB;
constexpr size_t WS_MIX = WS_BIG + 128 * MiB;
constexpr size_t WS_Q = WS_BIG + 192 * MiB;
constexpr size_t WS_KV = WS_BIG + 224 * MiB;
constexpr size_t KV_STRIDE = 8 * MiB;
constexpr size_t WS_CB = WS_BIG + 272 * MiB;
constexpr size_t WS_P = WS_BIG + 304 * MiB;
constexpr size_t WS_SUM = WS_BIG + 336 * MiB;
constexpr size_t WS_END = 512 * MiB;

constexpr int RING_BYTES = 131072;
constexpr int LDS_BYTES = 147456;

namespace pg8 {
constexpr int BM = 256, BK = 64, HALF = 128, HTB = HALF * BK * 2, STAGE_BYTES = 8 * HTB, NXCD = 8, WGM = 8;
__host__ __device__ __forceinline__ int lds_byte(int r, int c) { const int st = (r >> 4) * 2 + (c >> 5), rr = r & 15, cc = c & 31, ob = rr * 64 + cc * 2; return st * 1024 + (ob ^ (((ob >> 9) & 1) << 5)); }
__host__ __device__ __forceinline__ void stage_rc(int b, int& R, int& C) { const int st = b / 1024, sb = b % 1024, swz = sb ^ (((sb >> 9) & 1) << 5); R = (st >> 1) * 16 + swz / 64; C = (st & 1) * 32 + (swz % 64) / 2; }
__host__ __device__ __forceinline__ int perm32(int rho) { const int n = rho >> 4, i = rho & 15; return 8 * (i >> 2) + 4 * n + (i & 3); }

struct Unit { int pm, pn; };
struct Gemm { const f16* A; const f16* Bt; int M, N, K, lda; };

struct StaticOrder {
    int nM, nN, nwg, G, c;
    __device__ void init(int M, int N, int G_, int c_) { nM = M / BM; nN = N / BM; nwg = nM * nN; G = G_; c = c_; }
    __device__ bool next(int i, Unit& u) const {
        const long L = (long)i * G + c; if (L >= nwg) return false;
        int wgid = (int)L; { const int q = nwg / NXCD, r = nwg % NXCD, xcd = wgid % NXCD, off = wgid / NXCD; wgid = (xcd < r ? xcd * (q + 1) : r * (q + 1) + (xcd - r) * q) + off; }
        const int nig = WGM * nN, gid = wgid / nig, fm = gid * WGM, gsz = (nM - fm) < WGM ? (nM - fm) : WGM;
        u.pm = fm + ((wgid % nig) % gsz); u.pn = (wgid % nig) / gsz; return true;
    }
};

__device__ __forceinline__ unsigned pk_f16(float lo, float hi) { f32x2 v = {lo, hi}; f16x2 h = __builtin_convertvector(v, f16x2); return __builtin_bit_cast(unsigned, h); }

struct EpiF16 {
    static constexpr bool PERM = true;
    f16* O; int ldc;
    __device__ __forceinline__ void operator()(const f32x4 (&acc)[2][2][4][2], const Unit& u, int wr, int wc, int fr, int fq) const {
        const int row0 = u.pm * BM + wr * 64 + fr; const int col0 = u.pn * BM + wc * 32 + 8 * fq;
#pragma unroll
        for (int ai = 0; ai < 2; ++ai)
#pragma unroll
            for (int m = 0; m < 4; ++m) { f16* rowp = O + (size_t)(row0 + ai * HALF + m * 16) * ldc + col0;
#pragma unroll
                for (int bj = 0; bj < 2; ++bj) { const f32x4 v0 = acc[ai][bj][m][0], v1 = acc[ai][bj][m][1];
                    u32x4 w; w.x = pk_f16(v0[0], v0[1]); w.y = pk_f16(v0[2], v0[3]); w.z = pk_f16(v1[0], v1[1]); w.w = pk_f16(v1[2], v1[3]);
                    *(u32x4*)(rowp + bj * HALF) = w; } }
    }
};
struct EpiResid {
    static constexpr bool PERM = false;
    const float* base; float* out; const float* gate;
    __device__ __forceinline__ void operator()(const f32x4 (&acc)[2][2][4][2], const Unit& u, int wr, int wc, int fr, int fq) const {
        const int col0 = u.pn * BM + wc * 32 + 4 * fq; const int b = (u.pm * BM) >> 11;
        f32x4 gv[2][2];
#pragma unroll
        for (int bj = 0; bj < 2; ++bj)
#pragma unroll
            for (int n = 0; n < 2; ++n) gv[bj][n] = *(const f32x4*)(gate + (size_t)b * 6144 + col0 + bj * HALF + n * 16);
#pragma unroll
        for (int ai = 0; ai < 2; ++ai)
#pragma unroll
            for (int m = 0; m < 4; ++m) { const size_t off = (size_t)(u.pm * BM + ai * HALF + wr * 64 + m * 16 + fr) * DM + col0;
#pragma unroll
                for (int bj = 0; bj < 2; ++bj)
#pragma unroll
                    for (int n = 0; n < 2; ++n) { const f32x4 bs = *(const f32x4*)(base + off + bj * HALF + n * 16);
                        *(f32x4*)(out + off + bj * HALF + n * 16) = bs + gv[bj][n] * acc[ai][bj][m][n]; }
                if (m & 1) asm volatile("" ::: "memory"); }
    }
};

template <class Epi, class Sched, bool ALIGN_EPI = false, bool SP2 = false>
__device__ __forceinline__ void gemm_phase(LAS unsigned char* lds, const Gemm g, const Sched& S, const Epi& E, const int tid) {
    const int wid = __builtin_amdgcn_readfirstlane(tid >> 6), lane = tid & 63, wr = wid >> 2, wc = wid & 3, fr = lane & 15, fq = lane >> 4;
    const int K = g.K, nt = K / BK, lda = g.lda;
    unsigned voffA[2], voffB[2];
#pragma unroll
    for (int i = 0; i < 2; ++i) { int R, C; stage_rc(tid * 16 + i * 8192, R, C); const int Rb = Epi::PERM ? ((R & ~31) + perm32(R & 31)) : R;
        voffA[i] = (unsigned)(R * lda + C) * 2u; voffB[i] = (unsigned)(Rb * K + C) * 2u; }
    const size_t kstep = (size_t)(BK * 2);
    const size_t hstepA = (size_t)HALF * lda * 2, hstepB = (size_t)HALF * K * 2;
    const size_t tstepA = 2 * hstepA, tstepB = 2 * hstepB;
    const unsigned ldsw = (unsigned)wid * 1024u;
    const int aoff = lds_byte(wr * 64 + fr, fq * 8), boff = lds_byte(wc * 32 + fr, fq * 8);
#define PG8_SA(b, h) (((b) * 2 + (h)) * HTB)
#define PG8_SB(b, h) ((4 + (b) * 2 + (h)) * HTB)
#define PG8_STAGE(bufoff, gbase, voff) do { _Pragma("unroll") for (int _i = 0; _i < 2; ++_i) \
        __builtin_amdgcn_global_load_lds((const unsigned*)((const char*)(gbase) + (voff)[_i]), (LAS unsigned*)(lds + (bufoff) + ldsw + _i * 8192), 16, 0, 0); } while (0)
#define PG8_LDA(dst, b, h) do { _Pragma("unroll") for (int m = 0; m < 4; ++m) _Pragma("unroll") for (int k = 0; k < 2; ++k) dst[m][k] = *(const LAS f16x8*)(lds + PG8_SA(b, h) + aoff + m * 2048 + k * 1024); } while (0)
#define PG8_LDB(dst, b, h) do { _Pragma("unroll") for (int n = 0; n < 2; ++n) _Pragma("unroll") for (int k = 0; k < 2; ++k) dst[n][k] = *(const LAS f16x8*)(lds + PG8_SB(b, h) + boff + n * 2048 + k * 1024); } while (0)
#define PG8_MMA(ai, bj, At, Bt) do { __builtin_amdgcn_s_setprio(1); _Pragma("unroll") for (int m = 0; m < 4; ++m) _Pragma("unroll") for (int n = 0; n < 2; ++n) _Pragma("unroll") for (int k = 0; k < 2; ++k) \
        acc[ai][bj][m][n] = __builtin_amdgcn_mfma_f32_16x16x32_f16(Bt[n][k], At[m][k], acc[ai][bj][m][n], 0, 0, 0); __builtin_amdgcn_s_setprio(0); } while (0)
#define PG8_WAIT_V(n) asm volatile("s_waitcnt vmcnt(" #n ")" ::: "memory")
#define PG8_WAIT_L(n) asm volatile("s_waitcnt lgkmcnt(" #n ")" ::: "memory")
#define PG8_BAR __builtin_amdgcn_s_barrier()
#define PG8_SCHED __builtin_amdgcn_sched_barrier(0)
    Unit cur, nxt; int ui = 0;
    if (!S.next(0, cur)) return;
    f32x4 acc[2][2][4][2];
#pragma unroll
    for (int a = 0; a < 2; ++a)
#pragma unroll
        for (int b = 0; b < 2; ++b)
#pragma unroll
            for (int m = 0; m < 4; ++m)
#pragma unroll
                for (int n = 0; n < 2; ++n) acc[a][b][m][n] = (f32x4){0.f, 0.f, 0.f, 0.f};
    f16x8 At[4][2], B0[2][2], B1[2][2];
    const char* cA = (const char*)g.A + (size_t)cur.pm * tstepA; const char* cB = (const char*)g.Bt + (size_t)cur.pn * tstepB;
    if constexpr (SP2) {
        PG8_STAGE(PG8_SB(0, 0), cB, voffB); PG8_STAGE(PG8_SB(0, 1), cB + hstepB, voffB); PG8_STAGE(PG8_SA(0, 0), cA, voffA); PG8_STAGE(PG8_SA(0, 1), cA + hstepA, voffA);
        if (wr == 1) PG8_BAR;
        PG8_WAIT_V(2); PG8_BAR;
        PG8_STAGE(PG8_SB(1, 0), cB + kstep, voffB); PG8_STAGE(PG8_SA(1, 0), cA + kstep, voffA); PG8_STAGE(PG8_SB(1, 1), cB + hstepB + kstep, voffB);
        PG8_WAIT_V(6); PG8_BAR;
    } else {
        PG8_STAGE(PG8_SB(0, 0), cB, voffB); PG8_STAGE(PG8_SA(0, 0), cA, voffA); PG8_STAGE(PG8_SB(0, 1), cB + hstepB, voffB); PG8_STAGE(PG8_SA(0, 1), cA + hstepA, voffA);
        if (wr == 1) PG8_BAR;
        PG8_WAIT_V(4); PG8_BAR;
        PG8_STAGE(PG8_SB(1, 0), cB + kstep, voffB); PG8_STAGE(PG8_SA(1, 0), cA + kstep, voffA); PG8_STAGE(PG8_SB(1, 1), cB + hstepB + kstep, voffB);
        PG8_WAIT_V(6); PG8_BAR;
    }
    for (;;) {
        const bool has_next = S.next(ui + 1, nxt);
        const char* nA = has_next ? (const char*)g.A + (size_t)nxt.pm * tstepA : cA; const char* nB = has_next ? (const char*)g.Bt + (size_t)nxt.pn * tstepB : cB;
        for (int t = 0; t < nt; t += 2) {
            const bool last = (t == nt - 2);
            const char* a1 = cA + (size_t)(t + 1) * kstep;
            const char* a2 = last ? nA : cA + (size_t)(t + 2) * kstep; const char* b2 = last ? nB : cB + (size_t)(t + 2) * kstep;
            const char* a3 = a2 + kstep; const char* b3 = b2 + kstep;
            if constexpr (SP2) {
            PG8_LDB(B0, 0, 0); PG8_LDB(B1, 0, 1); PG8_SCHED; PG8_LDA(At, 0, 0); PG8_STAGE(PG8_SA(1, 1), a1 + hstepA, voffA);
            PG8_WAIT_V(8); PG8_WAIT_L(0); PG8_BAR; PG8_MMA(0, 0, At, B0); PG8_MMA(0, 1, At, B1); PG8_BAR; PG8_SCHED;
            PG8_LDA(At, 0, 1); PG8_STAGE(PG8_SB(0, 0), b2, voffB); PG8_STAGE(PG8_SB(0, 1), b2 + hstepB, voffB); PG8_STAGE(PG8_SA(0, 0), a2, voffA);
            PG8_WAIT_V(8); PG8_WAIT_L(0); PG8_BAR; PG8_MMA(1, 0, At, B0); PG8_MMA(1, 1, At, B1); PG8_BAR; PG8_SCHED;
            PG8_LDB(B0, 1, 0); PG8_LDB(B1, 1, 1); PG8_SCHED; PG8_LDA(At, 1, 0); PG8_STAGE(PG8_SA(0, 1), a2 + hstepA, voffA);
            PG8_WAIT_V(8); PG8_WAIT_L(0); PG8_BAR; PG8_MMA(0, 0, At, B0); PG8_MMA(0, 1, At, B1); PG8_BAR; PG8_SCHED;
            PG8_LDA(At, 1, 1); PG8_STAGE(PG8_SB(1, 0), b3, voffB); PG8_STAGE(PG8_SB(1, 1), b3 + hstepB, voffB); PG8_STAGE(PG8_SA(1, 0), a3, voffA);
            PG8_WAIT_V(8); PG8_WAIT_L(0); PG8_BAR; PG8_MMA(1, 0, At, B0); PG8_MMA(1, 1, At, B1); PG8_BAR; PG8_SCHED;
            } else {
            PG8_LDB(B0, 0, 0); PG8_SCHED; PG8_LDA(At, 0, 0); PG8_STAGE(PG8_SA(1, 1), a1 + hstepA, voffA);
            PG8_WAIT_L(8); PG8_BAR; PG8_WAIT_L(0); PG8_MMA(0, 0, At, B0); PG8_BAR; PG8_SCHED;
            PG8_LDB(B1, 0, 1); PG8_STAGE(PG8_SB(0, 0), b2, voffB);
            PG8_BAR; PG8_WAIT_L(0); PG8_MMA(0, 1, At, B1); PG8_BAR;
            PG8_LDA(At, 0, 1); PG8_STAGE(PG8_SA(0, 0), a2, voffA);
            PG8_BAR; PG8_WAIT_L(0); PG8_MMA(1, 0, At, B0); PG8_BAR; PG8_SCHED;
            PG8_STAGE(PG8_SB(0, 1), b2 + hstepB, voffB);
            PG8_WAIT_V(6); PG8_BAR; PG8_MMA(1, 1, At, B1); PG8_BAR;
            PG8_LDB(B0, 1, 0); PG8_SCHED; PG8_LDA(At, 1, 0); PG8_STAGE(PG8_SA(0, 1), a2 + hstepA, voffA);
            PG8_WAIT_L(8); PG8_BAR; PG8_WAIT_L(0); PG8_MMA(0, 0, At, B0); PG8_BAR; PG8_SCHED;
            PG8_LDB(B1, 1, 1); PG8_STAGE(PG8_SB(1, 0), b3, voffB);
            PG8_BAR; PG8_WAIT_L(0); PG8_MMA(0, 1, At, B1); PG8_BAR;
            PG8_LDA(At, 1, 1); PG8_STAGE(PG8_SA(1, 0), a3, voffA);
            PG8_BAR; PG8_WAIT_L(0); PG8_MMA(1, 0, At, B0); PG8_BAR; PG8_SCHED;
            PG8_STAGE(PG8_SB(1, 1), b3 + hstepB, voffB);
            PG8_WAIT_V(6); PG8_BAR; PG8_MMA(1, 1, At, B1); PG8_BAR;
            }
        }
        if constexpr (ALIGN_EPI) { if (wr == 0) PG8_BAR; }
        E(acc, cur, wr, wc, fr, fq);
        if (!has_next) break;
#pragma unroll
        for (int a = 0; a < 2; ++a)
#pragma unroll
            for (int b = 0; b < 2; ++b)
#pragma unroll
                for (int m = 0; m < 4; ++m)
#pragma unroll
                    for (int n = 0; n < 2; ++n) acc[a][b][m][n] = (f32x4){0.f, 0.f, 0.f, 0.f};
        cur = nxt; cA = nA; cB = nB; ++ui;
        if constexpr (ALIGN_EPI) { if (wr == 1) PG8_BAR; }
    }
    PG8_WAIT_V(0);
    if constexpr (!ALIGN_EPI) { if (wr == 0) PG8_BAR; }
    PG8_BAR;
#undef PG8_SA
#undef PG8_SB
#undef PG8_STAGE
#undef PG8_LDA
#undef PG8_LDB
#undef PG8_MMA
#undef PG8_WAIT_V
#undef PG8_WAIT_L
#undef PG8_BAR
#undef PG8_SCHED
}
}

__device__ __forceinline__ float wave_sum(float v) {
#pragma unroll
    for (int o = 1; o < 64; o <<= 1) v += __shfl_xor(v, o);
    return v;
}
__device__ __forceinline__ float silu_f(float x) { return x / (1.0f + __expf(-x)); }
__device__ __forceinline__ float sigmoid_f(float x) { return 1.0f / (1.0f + __expf(-x)); }
__device__ __forceinline__ unsigned pk2h(float lo, float hi) { return pg8::pk_f16(lo, hi); }

struct Args {
    const float* x; const float* c; const int* pos; const float* w_mod; const float* b_mod; const float* norm1_g; const float* w_in;
    const float* pe_k; const float* w1_k; const float* w2_k; const float* pe_v; const float* w1_v; const float* w2_v;
    const float* conv_w; const float* g_attn; const float* g_conv; const float* w_out; const float* norm2_g;
    const float* ffn_up; const float* ffn_conv; const float* ffn_down; const float* final_g;
    float* out; unsigned char* ws; int ph_lo, ph_hi;
};

__device__ __forceinline__ void transpose_item(const float* W, int K, int Nsrc, int Ndst, f16* WT, LAS float* scr, int item, int lane) {
    const int nblk = Ndst / 32, kb = item / nblk, nb = item % nblk, k0 = 64 * kb, n0 = 32 * nb;
    const int sc = n0 + (lane & 31);
#pragma unroll 8
    for (int i = 0; i < 32; ++i) { const int kk = 2 * i + (lane >> 5); scr[kk * 33 + (lane & 31)] = (sc < Nsrc) ? W[(size_t)(k0 + kk) * Nsrc + sc] : 0.f; }
    asm volatile("s_waitcnt lgkmcnt(0)" ::: "memory");
    const int c = lane & 7;
#pragma unroll
    for (int j = 0; j < 4; ++j) { const int n = (lane >> 3) + 8 * j; const LAS float* s = scr + (8 * c) * 33 + n;
        u32x4 o; o.x = pk2h(s[0 * 33], s[1 * 33]); o.y = pk2h(s[2 * 33], s[3 * 33]); o.z = pk2h(s[4 * 33], s[5 * 33]); o.w = pk2h(s[6 * 33], s[7 * 33]);
        *(u32x4*)(WT + (size_t)(n0 + n) * K + k0 + 8 * c) = o; }
    asm volatile("s_waitcnt lgkmcnt(0)" ::: "memory");
}

__device__ __forceinline__ void sincos_d(double a, float& s, float& c) {
    const double k = rint(a * 0.63661977236758134308);
    double r = fma(-k, 1.57079632679489655800e+00, a); r = fma(-k, 6.12323399573676603587e-17, r);
    const double r2 = r * r;
    double sp = -1.0 / 1307674368000.0;
    sp = fma(sp, r2, 1.0 / 6227020800.0);
    sp = fma(sp, r2, -1.0 / 39916800.0);
    sp = fma(sp, r2, 1.0 / 362880.0);
    sp = fma(sp, r2, -1.0 / 5040.0);
    sp = fma(sp, r2, 1.0 / 120.0);
    sp = fma(sp, r2, -1.0 / 6.0);
    const double sn = fma(sp * r2, r, r);
    double cp = 1.0 / 20922789888000.0;
    cp = fma(cp, r2, -1.0 / 87178291200.0);
    cp = fma(cp, r2, 1.0 / 479001600.0);
    cp = fma(cp, r2, -1.0 / 3628800.0);
    cp = fma(cp, r2, 1.0 / 40320.0);
    cp = fma(cp, r2, -1.0 / 720.0);
    cp = fma(cp, r2, 1.0 / 24.0);
    cp = fma(cp, r2, -0.5);
    const double cs = fma(cp, r2, 1.0);
    const int q = ((int)k) & 3;
    const double ss = (q == 0) ? sn : (q == 1) ? cs : (q == 2) ? -sn : -cs;
    const double cc = (q == 0) ? cs : (q == 1) ? -sn : (q == 2) ? -cs : sn;
    s = (float)ss; c = (float)cc;
}

template <int ph>
__device__ __forceinline__ void run_phase(LAS unsigned char* lds) {
    {
        const Args* ap = (const Args*)__builtin_amdgcn_kernarg_segment_ptr();
        asm volatile("" : "+s"(ap));
        const Args& A = *ap;
        int tid = threadIdx.x; asm volatile("" : "+v"(tid));
        const int lane = tid & 63, wave = __builtin_amdgcn_readfirstlane(tid >> 6);
        int G = gridDim.x, bx = blockIdx.x; asm volatile("" : "+s"(G), "+s"(bx));
        const int gw = bx * NWAVES + wave, NGW = G * NWAVES;
        const int gt = bx * NTHREADS + tid, NGT = G * NTHREADS;
        unsigned char* ws = A.ws;
        float* MOD = (float*)(ws + WS_MOD);
        float* ROPE = (float*)(ws + WS_ROPE);
        f16* HALO = (f16*)(ws + WS_HALO);
        f16* Hb = (f16*)(ws + WS_H);
        f16* KCMP = (f16*)(ws + WS_KCMP);
        float* Gt = (float*)(ws + WS_G);
        unsigned* SEL = (unsigned*)(ws + WS_SEL);
        f16* U = (f16*)(ws + WS_U);
        f16* PROJ = (f16*)(ws + WS_PROJ);
        float* IMP = (float*)(ws + WS_IMP);
        float* OC = (float*)(ws + WS_OC);
        f16* ATT = (f16*)(ws + WS_ATT);
        f16* MIX = (f16*)(ws + WS_MIX);
        f16* Qb = (f16*)(ws + WS_Q);
        f16* KVb = (f16*)(ws + WS_KV);
        f16* CBb = (f16*)(ws + WS_CB);
        f16* Pb = (f16*)(ws + WS_P);
        float* SUMb = (float*)(ws + WS_SUM);
        constexpr int l = (ph >= 1 && ph < 29) ? (ph - 1) / 14 : 0;
        constexpr int k = (ph >= 1 && ph < 29) ? (ph - 1) % 14 : (ph == 0 ? 100 : 101);
        unsigned char* wl = ws + WS_W + (size_t)l * W_LAYER;
        f16* Win_t = (f16*)(wl + W_IN_OFF); f16* Wout_t = (f16*)(wl + W_OUT_OFF); f16* Wup_t = (f16*)(wl + W_UP_OFF); f16* Wdown_t = (f16*)(wl + W_DOWN_OFF);
        const float* modl = MOD + (size_t)l * 16 * 6144;

        if (PH_EN(14) && k == 100) {
            {
                LAS float* scr = (LAS float*)(lds + wave * 16384);
                constexpr int I_IN = 16 * (NINP / 32), I_OUT = 16 * 32, I_UP = 16 * (NUP / 32), I_DN = (DFF / 64) * 32, I_L = I_IN + I_OUT + I_UP + I_DN;
                for (int it = gw; it < 2 * I_L; it += NGW) {
                    const int ll = it / I_L; int r = it % I_L;
                    unsigned char* wll = ws + WS_W + (size_t)ll * W_LAYER;
                    if (r < I_IN) { transpose_item(A.w_in + (size_t)ll * DM * NIN, DM, NIN, NINP, (f16*)(wll + W_IN_OFF), scr, r, lane); continue; } r -= I_IN;
                    if (r < I_OUT) { transpose_item(A.w_out + (size_t)ll * DM * DM, DM, DM, DM, (f16*)(wll + W_OUT_OFF), scr, r, lane); continue; } r -= I_OUT;
                    if (r < I_UP) { transpose_item(A.ffn_up + (size_t)ll * DM * NUP, DM, NUP, NUP, (f16*)(wll + W_UP_OFF), scr, r, lane); continue; } r -= I_UP;
                    transpose_item(A.ffn_down + (size_t)ll * DFF * DM, DFF, DM, DM, (f16*)(wll + W_DOWN_OFF), scr, r, lane);
                }
            }
            __syncthreads();
            for (int it = gt; it < MTOK * 8; it += NGT) {
                const int m = it >> 3, i = it & 7;
                const double fr = (i == 0) ? 1.0 : (i == 1) ? 0.19392274474868576 : (i == 2) ? 0.03760603093086393 : (i == 3) ? 0.007292664737217109 :
                                  (i == 4) ? 0.001414213562373095 : (i == 5) ? 0.0002742481756762073 : (i == 6) ? 5.318295896944988e-05 : 1.031338537721246e-05;
                float s, c; sincos_d((double)A.pos[m] * fr, s, c);
                ROPE[(size_t)m * 16 + i] = c; ROPE[(size_t)m * 16 + 8 + i] = s;
            }
            {
                LAS float* ca = (LAS float*)lds;
                LAS float* red = (LAS float*)(lds + 65536);
                bool staged = false;
                for (int it = bx; it < 2 * 96; it += G) {
                    if (!staged) { for (int i = tid; i < 16 * 1024; i += NTHREADS) ca[i] = silu_f(A.c[i]); staged = true; }
                    __syncthreads();
                    const int ll = it / 96, n0 = (it % 96) * 64;
                    const float* wm = A.w_mod + (size_t)ll * DM * 6144 + n0 + lane;
                    float acc[16];
#pragma unroll
                    for (int b = 0; b < 16; ++b) acc[b] = 0.f;
                    for (int kk = wave * 128; kk < wave * 128 + 128; kk += 8) {
                        float w[8];
#pragma unroll
                        for (int u = 0; u < 8; ++u) w[u] = wm[(size_t)(kk + u) * 6144];
#pragma unroll
                        for (int u = 0; u < 8; ++u)
#pragma unroll
                            for (int b = 0; b < 16; ++b) acc[b] = fmaf(ca[b * 1024 + kk + u], w[u], acc[b]);
                    }
#pragma unroll
                    for (int b = 0; b < 16; ++b) red[(wave * 16 + b) * 64 + lane] = acc[b];
                    __syncthreads();
                    for (int o = tid; o < 1024; o += NTHREADS) { const int b = o >> 6, n = o & 63; float s = 0.f;
#pragma unroll
                        for (int w8 = 0; w8 < 8; ++w8) s += red[(w8 * 16 + b) * 64 + n];
                        MOD[((size_t)ll * 16 + b) * 6144 + n0 + n] = s + A.b_mod[(size_t)ll * 6144 + n0 + n]; }
                    __syncthreads();
                }
            }
        } else if (PH_EN(0) && (k == 0 || k == 9)) {
            const float* xin = (k == 0 && l == 0) ? A.x : A.out;
            const float* gain = (k == 0 ? A.norm1_g : A.norm2_g) + (size_t)l * DM;
            const float* shp = modl + (k == 0 ? 0 : 3) * 1024; const float* scp = modl + (k == 0 ? 1 : 4) * 1024;
            for (int m = gw; m < MTOK; m += NGW) {
                const int b = m >> 11;
                const f32x4* xr = (const f32x4*)(xin + (size_t)m * DM) + lane;
                f32x4 v[4]; float s = 0.f;
#pragma unroll
                for (int j = 0; j < 4; ++j) { v[j] = xr[64 * j]; s += (v[j].x * v[j].x + v[j].y * v[j].y) + (v[j].z * v[j].z + v[j].w * v[j].w); }
                const float r = 1.0f / sqrtf(wave_sum(s) * (1.0f / DM) + 1e-6f);
#pragma unroll
                for (int j = 0; j < 4; ++j) { const int col = 4 * lane + 256 * j;
                    const f32x4 g4 = *(const f32x4*)(gain + col), sc4 = *(const f32x4*)(scp + (size_t)b * 6144 + col), sh4 = *(const f32x4*)(shp + (size_t)b * 6144 + col);
                    const f32x4 o = (v[j] * r) * g4 * (sc4 + 1.0f) + sh4;
                    u32x2 w; w.x = pk2h(o.x, o.y); w.y = pk2h(o.z, o.w);
                    *(u32x2*)(Hb + (size_t)m * DM + col) = w; }
            }
        } else if (PH_EN(1) && (k == 1 || k == 10)) {
            pg8::Gemm g; pg8::EpiF16 E;
            if (k == 1) { g = pg8::Gemm{Hb, Win_t, MTOK, NINP, DM, DM}; E = pg8::EpiF16{PROJ, NINP}; }
            else { g = pg8::Gemm{Hb, Wup_t, MTOK, NUP, DM, DM}; E = pg8::EpiF16{U, NUP}; }
            pg8::StaticOrder S; S.init(g.M, g.N, G, bx);
            pg8::gemm_phase<pg8::EpiF16, pg8::StaticOrder, true, true>(lds, g, S, E, tid);
        } else if (PH_EN(8) && (k == 8 || k == 13)) {
            pg8::Gemm g; pg8::EpiResid E;
            if (k == 8) { g = pg8::Gemm{MIX, Wout_t, MTOK, DM, DM, DM}; E = pg8::EpiResid{(l == 0) ? A.x : A.out, A.out, modl + 2 * 1024}; }
            else { g = pg8::Gemm{U, Wdown_t, MTOK, DM, DFF, NUP}; E = pg8::EpiResid{A.out, A.out, modl + 5 * 1024}; }
            pg8::StaticOrder S; S.init(g.M, g.N, G, bx);
            pg8::gemm_phase<pg8::EpiResid, pg8::StaticOrder, true, true>(lds, g, S, E, tid);
        } else if (PH_EN(2) && k == 2) {
            for (int idx = gt; idx < MTOK * NIN; idx += NGT) {
                const int m = idx / NIN, col = idx - m * NIN;
                const f16* pr = PROJ + (size_t)m * NINP;
                if (col < 1280) {
                    bool rope; int d;
                    if (col < 512) { d = col & 63; rope = d < 16; }
                    else { const int kvi = (col - 512) >> 7; d = (col - 512) & 63; rope = ((kvi & 1) == 0) && d < 16; }
                    float o;
                    if (rope) { const int i = d & 7, base = col - d; const float x1 = (float)pr[base + i], x2 = (float)pr[base + 8 + i];
                        const float cs = ROPE[(size_t)m * 16 + i], sn = ROPE[(size_t)m * 16 + 8 + i];
                        o = (d < 8) ? (x1 * cs - x2 * sn) : (x2 * cs + x1 * sn); }
                    else o = (float)pr[col];
                    if (col < 512) Qb[(size_t)m * 512 + col] = (f16)o;
                    else { const int kvi = (col - 512) >> 7, cc = (col - 512) & 127; KVb[(size_t)kvi * (KV_STRIDE / 2) + (size_t)m * 128 + cc] = (f16)o; }
                } else if (col < 1304) { Gt[(size_t)m * 32 + (col - 1280)] = sigmoid_f((float)pr[col]); }
                else if (col < 1816) { CBb[(size_t)m * 512 + (col - 1304)] = pr[col]; }
                else if (col < 2328) { Pb[(size_t)m * 512 + (col - 1816)] = (f16)((float)pr[col] * (float)pr[col + 512]); }
            }
        } else if (PH_EN(3) && k == 3) {
            LAS float* tokl = (LAS float*)lds;
            LAS float* pel = (LAS float*)(lds + 36864);
            LAS float* red = (LAS float*)(lds + 36864 + 8192);
            LAS float* hid = (LAS float*)(lds + 36864 + 8192 + 18432);
            for (int it = bx; it < 2 * 16 * 2 * 16; it += G) {
                const int jg = it & 15, hk = (it >> 4) & 1, b = (it >> 5) & 15, kv = it >> 9;
                const f16* src = KVb + (size_t)kv * (KV_STRIDE / 2);
                const float* pe = (kv ? A.pe_v : A.pe_k) + (size_t)l * 32 * 64;
                const float* w1 = (kv ? A.w1_v : A.w1_k) + (size_t)l * 2048 * 128;
                const float* w2 = (kv ? A.w2_v : A.w2_k) + (size_t)l * 128 * 64;
                __syncthreads();
                for (int i = tid; i < 144 * 64; i += NTHREADS) { const int tt = 128 * jg + (i >> 6); tokl[i] = (tt < SEQ) ? (float)src[((size_t)(b * SEQ + tt)) * 128 + hk * 64 + (i & 63)] : 0.f; }
                for (int i = tid; i < 32 * 64; i += NTHREADS) pel[i] = pe[i];
                __syncthreads();
                const int n = tid & 127, part = tid >> 7;
                float acc[9];
#pragma unroll
                for (int j = 0; j < 9; ++j) acc[j] = 0.f;
                for (int ld = part * 512; ld < part * 512 + 512; ++ld) {
                    const float w = w1[(size_t)ld * 128 + n];
#pragma unroll
                    for (int j = 0; j < 8; ++j) acc[j] = fmaf(tokl[j * 16 * 64 + ld], w, acc[j]);
                    acc[8] = fmaf(pel[ld], w, acc[8]);
                }
#pragma unroll
                for (int j = 0; j < 9; ++j) red[(part * 9 + j) * 128 + n] = acc[j];
                __syncthreads();
                for (int o = tid; o < 1024; o += NTHREADS) { const int j = o >> 7, nn = o & 127;
                    float s = 0.f;
#pragma unroll
                    for (int p = 0; p < 4; ++p) s += red[(p * 9 + j) * 128 + nn] + red[(p * 9 + 8) * 128 + nn];
                    hid[j * 128 + nn] = silu_f(s); }
                __syncthreads();
                { const int j = tid >> 6, d = tid & 63, jj = 8 * jg + j; float s = 0.f;
                    for (int nn = 0; nn < 128; ++nn) s = fmaf(hid[j * 128 + nn], w2[nn * 64 + d], s);
                    if (jj < 127) KCMP[((((size_t)kv * 16 + b) * 2 + hk) * 128 + jj) * 64 + d] = (f16)s; }
            }
        } else if (PH_EN(4) && k == 4) {
            for (int it = gw; it < 16 * 32 * 8; it += NGW) {
                const int h = it & 7, qb = (it >> 3) & 31, b = it >> 8, hk = h >> 2;
                const int t = 64 * qb + lane, m = b * SEQ + t;
                float q[64];
                { const f16x8* qp = (const f16x8*)(Qb + (size_t)m * 512 + h * 64);
#pragma unroll
                    for (int c8 = 0; c8 < 8; ++c8) { const f16x8 v = qp[c8];
#pragma unroll
                        for (int e = 0; e < 8; ++e) q[c8 * 8 + e] = (float)v[e] * 0.125f; } }
                const int tmax = 64 * qb + 63;
                const int nvw = (tmax >= 31) ? min(127, (tmax - 31) / 16 + 1) : 0;
                const f16* kc = KCMP + (((size_t)0 * 16 + b) * 2 + hk) * 128 * 64;
                const f16* vc = KCMP + (((size_t)1 * 16 + b) * 2 + hk) * 128 * 64;
                float mx = -INFINITY;
                for (int kk = 0; kk < nvw; ++kk) {
                    const f16x8* kp = (const f16x8*)(kc + kk * 64); float s = 0.f;
#pragma unroll
                    for (int c8 = 0; c8 < 8; ++c8) { const f16x8 v = kp[c8];
#pragma unroll
                        for (int e = 0; e < 8; ++e) s = fmaf(q[c8 * 8 + e], (float)v[e], s); }
                    if (16 * kk + 31 <= t) mx = fmaxf(mx, s);
                }
                float sum = 0.f, eprev = 0.f; float oc[64];
#pragma unroll
                for (int d = 0; d < 64; ++d) oc[d] = 0.f;
                float* impp = IMP + ((size_t)m * 8 + h) * 32;
                for (int kb = 0; kb < 32; ++kb) {
                    float eb = eprev;
                    for (int u = 0; u < 4; ++u) {
                        const int kk = 4 * kb + u; float e = 0.f;
                        if (kk < nvw) {
                            const f16x8* kp = (const f16x8*)(kc + kk * 64); float s = 0.f;
#pragma unroll
                            for (int c8 = 0; c8 < 8; ++c8) { const f16x8 v = kp[c8];
#pragma unroll
                                for (int ee = 0; ee < 8; ++ee) s = fmaf(q[c8 * 8 + ee], (float)v[ee], s); }
                            e = (16 * kk + 31 <= t) ? __expf(s - mx) : 0.f;
                            sum += e;
                            const f16x8* vp = (const f16x8*)(vc + kk * 64);
#pragma unroll
                            for (int c8 = 0; c8 < 8; ++c8) { const f16x8 v = vp[c8];
#pragma unroll
                                for (int ee = 0; ee < 8; ++ee) oc[c8 * 8 + ee] = fmaf(e, (float)v[ee], oc[c8 * 8 + ee]); }
                        }
                        eb += e; eprev = e;
                    }
                    impp[kb] = eb;
                }
                SUMb[(size_t)m * 8 + h] = sum;
                const float inv = Gt[(size_t)m * 32 + h * 3 + 0] / fmaxf(sum, 1e-30f);
                float* ocp = OC + (size_t)m * 512 + h * 64;
#pragma unroll
                for (int d = 0; d < 64; d += 4) *(f32x4*)(ocp + d) = (f32x4){oc[d] * inv, oc[d + 1] * inv, oc[d + 2] * inv, oc[d + 3] * inv};
            }
        } else if (PH_EN(5) && k == 5) {
            for (int it = gt; it < MTOK * 2; it += NGT) {
                const int m = it >> 1, hk = it & 1, t = m & (SEQ - 1), bq = t >> 6;
                float inv[4];
#pragma unroll
                for (int g4 = 0; g4 < 4; ++g4) inv[g4] = 1.0f / fmaxf(SUMb[(size_t)m * 8 + hk * 4 + g4], 1e-30f);
                const float* ip = IMP + ((size_t)m * 8 + hk * 4) * 32;
                unsigned mask = 0u;
                for (int r = 0; r < 8; ++r) {
                    int best = -1; float bv = -INFINITY;
                    for (int j = 0; j <= bq; ++j) {
                        if ((mask >> j) & 1u) continue;
                        float v;
                        if (j == 0 || j == bq || j == bq - 1) v = INFINITY;
                        else v = (ip[j] * inv[0] + ip[32 + j] * inv[1]) + (ip[64 + j] * inv[2] + ip[96 + j] * inv[3]);
                        if (v > bv) { bv = v; best = j; }
                    }
                    if (best >= 0) mask |= 1u << best;
                }
                SEL[it] = mask;
            }
        } else if (PH_EN(6) && k == 6) {
            for (int it = gw; it < 16 * 32 * 8; it += NGW) {
                const int h = it & 7, qb = (it >> 3) & 31, b = it >> 8, hk = h >> 2;
                const int t = 64 * qb + lane, m = b * SEQ + t;
                float q[64];
                { const f16x8* qp = (const f16x8*)(Qb + (size_t)m * 512 + h * 64);
#pragma unroll
                    for (int c8 = 0; c8 < 8; ++c8) { const f16x8 v = qp[c8];
#pragma unroll
                        for (int e = 0; e < 8; ++e) q[c8 * 8 + e] = (float)v[e] * 0.125f; } }
                const unsigned mask = SEL[(size_t)m * 2 + hk];
                float* ocp = OC + (size_t)m * 512 + h * 64;
                for (int br = 0; br < 2; ++br) {
                    const f16* Kp = KVb + (size_t)(2 + 2 * br) * (KV_STRIDE / 2) + (size_t)b * SEQ * 128 + hk * 64;
                    const f16* Vp = KVb + (size_t)(3 + 2 * br) * (KV_STRIDE / 2) + (size_t)b * SEQ * 128 + hk * 64;
                    float mr = -INFINITY, lsum = 0.f; float o[64];
#pragma unroll
                    for (int d = 0; d < 64; ++d) o[d] = 0.f;
                    const int jlo = (br == 0) ? 0 : max(0, qb - 8);
                    for (int j = jlo; j <= qb; ++j) {
                        const bool selj = (br == 0) ? (((mask >> j) & 1u) != 0u) : true;
                        if (__ballot(selj) == 0ull) continue;
                        for (int i = 0; i < 64; ++i) {
                            const int p = 64 * j + i;
                            const bool valid = selj && (p <= t) && (br == 0 || (t - p) < 512);
                            if (__ballot(valid) == 0ull) continue;
                            const f16x8* kp = (const f16x8*)(Kp + (size_t)p * 128); float s = 0.f;
#pragma unroll
                            for (int c8 = 0; c8 < 8; ++c8) { const f16x8 v = kp[c8];
#pragma unroll
                                for (int e = 0; e < 8; ++e) s = fmaf(q[c8 * 8 + e], (float)v[e], s); }
                            if (valid) {
                                const float mn = fmaxf(mr, s), a = __expf(mr - mn), pz = __expf(s - mn);
                                lsum = lsum * a + pz; mr = mn;
                                const f16x8* vp = (const f16x8*)(Vp + (size_t)p * 128);
#pragma unroll
                                for (int c8 = 0; c8 < 8; ++c8) { const f16x8 v = vp[c8];
#pragma unroll
                                    for (int e = 0; e < 8; ++e) o[c8 * 8 + e] = fmaf(pz, (float)v[e], o[c8 * 8 + e] * a); }
                            }
                        }
                    }
                    const float gg = Gt[(size_t)m * 32 + h * 3 + 1 + br] / fmaxf(lsum, 1e-30f);
                    if (br == 0) {
#pragma unroll
                        for (int d = 0; d < 64; d += 4) { f32x4 r4 = *(f32x4*)(ocp + d); r4.x = fmaf(gg, o[d], r4.x); r4.y = fmaf(gg, o[d + 1], r4.y); r4.z = fmaf(gg, o[d + 2], r4.z); r4.w = fmaf(gg, o[d + 3], r4.w); *(f32x4*)(ocp + d) = r4; }
                    } else {
                        f16* ap = ATT + (size_t)m * 512 + h * 64;
#pragma unroll
                        for (int d = 0; d < 64; d += 8) { const f32x4 r0 = *(const f32x4*)(ocp + d), r1 = *(const f32x4*)(ocp + d + 4);
                            u32x4 w; w.x = pk2h(fmaf(gg, o[d], r0.x), fmaf(gg, o[d + 1], r0.y)); w.y = pk2h(fmaf(gg, o[d + 2], r0.z), fmaf(gg, o[d + 3], r0.w));
                            w.z = pk2h(fmaf(gg, o[d + 4], r1.x), fmaf(gg, o[d + 5], r1.y)); w.w = pk2h(fmaf(gg, o[d + 6], r1.z), fmaf(gg, o[d + 7], r1.w));
                            *(u32x4*)(ap + d) = w; }
                    }
                }
            }
        } else if (PH_EN(7) && k == 7) {
            const float* ga = A.g_attn + (size_t)l * 512; const float* gc = A.g_conv + (size_t)l * 512; const float* cw = A.conv_w + (size_t)l * 3 * 512;
            for (int m = gw; m < MTOK; m += NGW) {
                const int t = m & (SEQ - 1); const int c0 = 8 * lane;
                { const f16x8 v = *(const f16x8*)(ATT + (size_t)m * 512 + c0); float f[8]; float s = 0.f;
#pragma unroll
                    for (int e = 0; e < 8; ++e) { f[e] = (float)v[e]; s += f[e] * f[e]; }
                    const float r = 1.0f / sqrtf(wave_sum(s) * (1.0f / 512.0f) + 1e-6f);
                    u32x4 w; w.x = pk2h(f[0] * r * ga[c0 + 0], f[1] * r * ga[c0 + 1]); w.y = pk2h(f[2] * r * ga[c0 + 2], f[3] * r * ga[c0 + 3]);
                    w.z = pk2h(f[4] * r * ga[c0 + 4], f[5] * r * ga[c0 + 5]); w.w = pk2h(f[6] * r * ga[c0 + 6], f[7] * r * ga[c0 + 7]);
                    *(u32x4*)(MIX + (size_t)m * DM + c0) = w; }
                { const f16x8 p0 = *(const f16x8*)(Pb + (size_t)m * 512 + c0);
                    f16x8 p1 = (f16x8)(f16)0.f, p2 = (f16x8)(f16)0.f;
                    if (t >= 1) p1 = *(const f16x8*)(Pb + (size_t)(m - 1) * 512 + c0);
                    if (t >= 2) p2 = *(const f16x8*)(Pb + (size_t)(m - 2) * 512 + c0);
                    const f16x8 cb = *(const f16x8*)(CBb + (size_t)m * 512 + c0);
                    float f[8]; float s = 0.f;
#pragma unroll
                    for (int e = 0; e < 8; ++e) { const float y = cw[c0 + e] * (float)p2[e] + cw[512 + c0 + e] * (float)p1[e] + cw[1024 + c0 + e] * (float)p0[e];
                        f[e] = (float)cb[e] * y; s += f[e] * f[e]; }
                    const float r = 1.0f / sqrtf(wave_sum(s) * (1.0f / 512.0f) + 1e-6f);
                    u32x4 w; w.x = pk2h(f[0] * r * gc[c0 + 0], f[1] * r * gc[c0 + 1]); w.y = pk2h(f[2] * r * gc[c0 + 2], f[3] * r * gc[c0 + 3]);
                    w.z = pk2h(f[4] * r * gc[c0 + 4], f[5] * r * gc[c0 + 5]); w.w = pk2h(f[6] * r * gc[c0 + 6], f[7] * r * gc[c0 + 7]);
                    *(u32x4*)(MIX + (size_t)m * DM + 512 + c0) = w; }
            }
        } else if (PH_EN(11) && k == 11) {
            for (int it = gt; it < 512 * 2 * (NUP / 8); it += NGT) {
                const int ch = it % (NUP / 8), rr = (it / (NUP / 8)) & 1, gI = it / (2 * (NUP / 8));
                *(u32x4*)(HALO + ((size_t)gI * 2 + rr) * NUP + ch * 8) = *(const u32x4*)(U + (size_t)(64 * gI + 62 + rr) * NUP + ch * 8);
            }
        } else if (PH_EN(12) && k == 12) {
            const float* fc = A.ffn_conv + (size_t)l * 3 * NUP;
            for (int it = gw; it < 512 * 6; it += NGW) {
                const int gI = it / 6, chunk = it % 6, c8 = chunk * 64 + lane;
                if (c8 < DFF / 8) {
                    const int c = 8 * c8;
                    float wa[3][8], wv[3][8];
#pragma unroll
                    for (int kk = 0; kk < 3; ++kk)
#pragma unroll
                        for (int e = 0; e < 8; ++e) { wa[kk][e] = fc[(size_t)kk * NUP + c + e]; wv[kk][e] = fc[(size_t)kk * NUP + DFF + c + e]; }
                    f16x8 a1 = (f16x8)(f16)0.f, a2 = a1, v1 = a1, v2 = a1;
                    if ((gI & 31) != 0) { const f16* hp = HALO + (size_t)(gI - 1) * 2 * NUP;
                        a2 = *(const f16x8*)(hp + c); v2 = *(const f16x8*)(hp + DFF + c); a1 = *(const f16x8*)(hp + NUP + c); v1 = *(const f16x8*)(hp + NUP + DFF + c); }
                    for (int r = 0; r < 64; ++r) {
                        f16* up = U + (size_t)(64 * gI + r) * NUP;
                        const f16x8 a0 = *(const f16x8*)(up + c), v0 = *(const f16x8*)(up + DFF + c);
                        float o[8];
#pragma unroll
                        for (int e = 0; e < 8; ++e) { const float ya = wa[0][e] * (float)a2[e] + wa[1][e] * (float)a1[e] + wa[2][e] * (float)a0[e];
                            const float yv = wv[0][e] * (float)v2[e] + wv[1][e] * (float)v1[e] + wv[2][e] * (float)v0[e];
                            o[e] = silu_f(ya) * yv; }
                        u32x4 w; w.x = pk2h(o[0], o[1]); w.y = pk2h(o[2], o[3]); w.z = pk2h(o[4], o[5]); w.w = pk2h(o[6], o[7]);
                        *(u32x4*)(up + c) = w;
                        a2 = a1; a1 = a0; v2 = v1; v1 = v0;
                    }
                }
            }
        } else if (PH_EN(15) && k == 101) {
            for (int m = gw; m < MTOK; m += NGW) {
                f32x4* xr = (f32x4*)(A.out + (size_t)m * DM) + lane;
                f32x4 v[4]; float s = 0.f;
#pragma unroll
                for (int j = 0; j < 4; ++j) { v[j] = xr[64 * j]; s += (v[j].x * v[j].x + v[j].y * v[j].y) + (v[j].z * v[j].z + v[j].w * v[j].w); }
                const float r = 1.0f / sqrtf(wave_sum(s) * (1.0f / DM) + 1e-6f);
#pragma unroll
                for (int j = 0; j < 4; ++j) { const f32x4 g4 = *(const f32x4*)(A.final_g + 4 * lane + 256 * j); xr[64 * j] = (v[j] * r) * g4; }
            }
        }
    }
}

__global__ void __launch_bounds__(NTHREADS, 2) fwd_kernel(Args A0) {
    extern __shared__ __attribute__((aligned(16))) unsigned char lds_raw[];
    LAS unsigned char* lds = (LAS unsigned char*)lds_raw;
    cg::grid_group grid = cg::this_grid();
    const int ph_lo = A0.ph_lo, ph_hi = A0.ph_hi;
#define STEP(P) if (ph_lo <= (P) && (P) < ph_hi) { run_phase<(P)>(lds); if ((P) + 1 < ph_hi) grid.sync(); }
    STEP(0) STEP(1) STEP(2) STEP(3) STEP(4) STEP(5) STEP(6) STEP(7) STEP(8) STEP(9)
    STEP(10) STEP(11) STEP(12) STEP(13) STEP(14) STEP(15) STEP(16) STEP(17) STEP(18) STEP(19)
    STEP(20) STEP(21) STEP(22) STEP(23) STEP(24) STEP(25) STEP(26) STEP(27) STEP(28) STEP(29)
#undef STEP
}

extern "C" void kernel_launch(void* const* d_in, const int* in_sizes, int n_in, void* d_out, int out_size, void* d_ws, size_t ws_size, hipStream_t stream) {
    static int grid = 0;
    if (grid == 0) {
        if (n_in != 22 || out_size != MTOK * DM || ws_size < WS_END) { fprintf(stderr, "kernel_launch: unexpected shapes (n_in %d out %d ws %zu)\n", n_in, out_size, ws_size); grid = -1; return; }
        int dev = 0, cus = 0, per_cu = 0;
        hipGetDevice(&dev);
        hipDeviceGetAttribute(&cus, hipDeviceAttributeMultiprocessorCount, dev);
        hipFuncSetAttribute((const void*)fwd_kernel, hipFuncAttributeMaxDynamicSharedMemorySize, LDS_BYTES);
        hipOccupancyMaxActiveBlocksPerMultiprocessor(&per_cu, (const void*)fwd_kernel, NTHREADS, LDS_BYTES);
        (void)hipGetLastError();
        if (per_cu < 1) per_cu = 1;
        grid = cus * per_cu;
    }
    if (grid < 0) return;
    Args a{};
    a.x = (const float*)d_in[0]; a.c = (const float*)d_in[1]; a.pos = (const int*)d_in[2]; a.w_mod = (const float*)d_in[3]; a.b_mod = (const float*)d_in[4];
    a.norm1_g = (const float*)d_in[5]; a.w_in = (const float*)d_in[6]; a.pe_k = (const float*)d_in[7]; a.w1_k = (const float*)d_in[8]; a.w2_k = (const float*)d_in[9];
    a.pe_v = (const float*)d_in[10]; a.w1_v = (const float*)d_in[11]; a.w2_v = (const float*)d_in[12]; a.conv_w = (const float*)d_in[13]; a.g_attn = (const float*)d_in[14];
    a.g_conv = (const float*)d_in[15]; a.w_out = (const float*)d_in[16]; a.norm2_g = (const float*)d_in[17]; a.ffn_up = (const float*)d_in[18]; a.ffn_conv = (const float*)d_in[19];
    a.ffn_down = (const float*)d_in[20]; a.final_g = (const float*)d_in[21];
    a.out = (float*)d_out; a.ws = (unsigned char*)d_ws;
#if MK_ONE_LAUNCH
    a.ph_lo = 0; a.ph_hi = NPH;
    void* args[] = {&a};
    hipError_t e = hipLaunchCooperativeKernel((const void*)fwd_kernel, dim3(grid), dim3(NTHREADS), args, LDS_BYTES, stream);
    if (e != hipSuccess) fprintf(stderr, "cooperative launch failed: %s (grid %d)\n", hipGetErrorString(e), grid);
#else
    for (int ph = 0; ph < NPH; ++ph) {
        a.ph_lo = ph; a.ph_hi = ph + 1;
        hipLaunchKernelGGL(fwd_kernel, dim3(grid), dim3(NTHREADS), LDS_BYTES, stream, a);
    }
#endif
}
```

```cpp
#include <hip/hip_runtime.h>
#include <hip/hip_cooperative_groups.h>
#include <cstdio>
#include <cstdint>
namespace cg = cooperative_groups;

#define LAS __attribute__((address_space(3)))
typedef _Float16 f16;
typedef _Float16 f16x8 __attribute__((ext_vector_type(8)));
typedef _Float16 f16x4 __attribute__((ext_vector_type(4)));
typedef _Float16 f16x2 __attribute__((ext_vector_type(2)));
typedef float f32x4 __attribute__((ext_vector_type(4)));
typedef float f32x2 __attribute__((ext_vector_type(2)));
typedef unsigned u32x4 __attribute__((ext_vector_type(4)));
typedef unsigned u32x2 __attribute__((ext_vector_type(2)));

#ifndef PHMASK
#define PHMASK 0xFFFFFu
#endif
#define PH_EN(b) (((PHMASK) >> (b)) & 1u)
#ifndef MK_ONE_LAUNCH
#define MK_ONE_LAUNCH 1
#endif

constexpr int BATCH = 16, SEQ = 2048, DM = 1024, MTOK = BATCH * SEQ;
constexpr int NIN = 2840, NINP = 3072, DFF = 2816, NUP = 2 * DFF;
constexpr int NWAVES = 8, NTHREADS = 512;
constexpr int NPH = 26;

constexpr size_t MiB = 1u << 20;
constexpr size_t WS_CTL = 0;
constexpr size_t WS_MOD = 1 * MiB;
constexpr size_t WS_ROPE = 2 * MiB;
constexpr size_t WS_HALO = 8 * MiB;
constexpr size_t WS_W = 20 * MiB;
constexpr size_t W_IN_OFF = 0, W_OUT_OFF = 6 * MiB, W_UP_OFF = 8 * MiB, W_DOWN_OFF = 19 * MiB, W_LAYER = 25 * MiB;
constexpr size_t WS_H = 70 * MiB;
constexpr size_t WS_KCMP = 134 * MiB;
constexpr size_t WS_G = 135 * MiB;
constexpr size_t WS_SEL = 139 * MiB;
constexpr size_t WS_BIG = 140 * MiB;
constexpr size_t WS_U = WS_BIG;
constexpr size_t WS_PROJ = WS_BIG;
constexpr size_t WS_IMP = WS_BIG;
constexpr size_t WS_OC = WS_BIG + 32 * MiB;
constexpr size_t WS_ATT = WS_BIG + 96 * MiB;
constexpr size_t WS_MIX = WS_BIG + 128 * MiB;
constexpr size_t WS_Q = WS_BIG + 192 * MiB;
constexpr size_t WS_KV = WS_BIG + 224 * MiB;
constexpr size_t KV_STRIDE = 8 * MiB;
constexpr size_t WS_CB = WS_BIG + 272 * MiB;
constexpr size_t WS_P = WS_BIG + 304 * MiB;
constexpr size_t WS_SUM = WS_BIG + 336 * MiB;
constexpr size_t WS_END = 512 * MiB;

constexpr int RING_BYTES = 131072;
constexpr int LDS_BYTES = 147456;

namespace pg8 {
constexpr int BM = 256, BK = 64, HALF = 128, HTB = HALF * BK * 2, STAGE_BYTES = 8 * HTB, NXCD = 8, WGM = 8;
__host__ __device__ __forceinline__ int lds_byte(int r, int c) { const int st = (r >> 4) * 2 + (c >> 5), rr = r & 15, cc = c & 31, ob = rr * 64 + cc * 2; return st * 1024 + (ob ^ (((ob >> 9) & 1) << 5)); }
__host__ __device__ __forceinline__ void stage_rc(int b, int& R, int& C) { const int st = b / 1024, sb = b % 1024, swz = sb ^ (((sb >> 9) & 1) << 5); R = (st >> 1) * 16 + swz / 64; C = (st & 1) * 32 + (swz % 64) / 2; }
__host__ __device__ __forceinline__ int perm32(int rho) { const int n = rho >> 4, i = rho & 15; return 8 * (i >> 2) + 4 * n + (i & 3); }

struct Unit { int pm, pn; };
struct Gemm { const f16* A; const f16* Bt; int M, N, K, lda; };

struct StaticOrder {
    int nM, nN, nwg, G, c;
    __device__ void init(int M, int N, int G_, int c_) { nM = M / BM; nN = N / BM; nwg = nM * nN; G = G_; c = c_; }
    __device__ bool next(int i, Unit& u) const {
        const long L = (long)i * G + c; if (L >= nwg) return false;
        int wgid = (int)L; { const int q = nwg / NXCD, r = nwg % NXCD, xcd = wgid % NXCD, off = wgid / NXCD; wgid = (xcd < r ? xcd * (q + 1) : r * (q + 1) + (xcd - r) * q) + off; }
        const int nig = WGM * nN, gid = wgid / nig, fm = gid * WGM, gsz = (nM - fm) < WGM ? (nM - fm) : WGM;
        u.pm = fm + ((wgid % nig) % gsz); u.pn = (wgid % nig) / gsz; return true;
    }
};

__device__ __forceinline__ unsigned pk_f16(float lo, float hi) { f32x2 v = {lo, hi}; f16x2 h = __builtin_convertvector(v, f16x2); return __builtin_bit_cast(unsigned, h); }

struct EpiF16 {
    static constexpr bool PERM = true;
    f16* O; int ldc;
    __device__ __forceinline__ void operator()(const f32x4 (&acc)[2][2][4][2], const Unit& u, int wr, int wc, int fr, int fq) const {
        const int row0 = u.pm * BM + wr * 64 + fr; const int col0 = u.pn * BM + wc * 32 + 8 * fq;
#pragma unroll
        for (int ai = 0; ai < 2; ++ai)
#pragma unroll
            for (int m = 0; m < 4; ++m) { f16* rowp = O + (size_t)(row0 + ai * HALF + m * 16) * ldc + col0;
#pragma unroll
                for (int bj = 0; bj < 2; ++bj) { const f32x4 v0 = acc[ai][bj][m][0], v1 = acc[ai][bj][m][1];
                    u32x4 w; w.x = pk_f16(v0[0], v0[1]); w.y = pk_f16(v0[2], v0[3]); w.z = pk_f16(v1[0], v1[1]); w.w = pk_f16(v1[2], v1[3]);
                    *(u32x4*)(rowp + bj * HALF) = w; } }
    }
};
struct EpiResid {
    static constexpr bool PERM = false;
    const float* base; float* out; const float* gate;
    __device__ __forceinline__ void operator()(const f32x4 (&acc)[2][2][4][2], const Unit& u, int wr, int wc, int fr, int fq) const {
        const int col0 = u.pn * BM + wc * 32 + 4 * fq; const int b = (u.pm * BM) >> 11;
        f32x4 gv[2][2];
#pragma unroll
        for (int bj = 0; bj < 2; ++bj)
#pragma unroll
            for (int n = 0; n < 2; ++n) gv[bj][n] = *(const f32x4*)(gate + (size_t)b * 6144 + col0 + bj * HALF + n * 16);
#pragma unroll
        for (int ai = 0; ai < 2; ++ai)
#pragma unroll
            for (int m = 0; m < 4; ++m) { const size_t off = (size_t)(u.pm * BM + ai * HALF + wr * 64 + m * 16 + fr) * DM + col0;
#pragma unroll
                for (int bj = 0; bj < 2; ++bj)
#pragma unroll
                    for (int n = 0; n < 2; ++n) { const f32x4 bs = *(const f32x4*)(base + off + bj * HALF + n * 16);
                        *(f32x4*)(out + off + bj * HALF + n * 16) = bs + gv[bj][n] * acc[ai][bj][m][n]; }
                if (m & 1) asm volatile("" ::: "memory"); }
    }
};

template <class Epi, class Sched, bool ALIGN_EPI = false, bool SP2 = false>
__device__ __forceinline__ void gemm_phase(LAS unsigned char* lds, const Gemm g, const Sched& S, const Epi& E, const int tid) {
    const int wid = __builtin_amdgcn_readfirstlane(tid >> 6), lane = tid & 63, wr = wid >> 2, wc = wid & 3, fr = lane & 15, fq = lane >> 4;
    const int K = g.K, nt = K / BK, lda = g.lda;
    unsigned voffA[2], voffB[2];
#pragma unroll
    for (int i = 0; i < 2; ++i) { int R, C; stage_rc(tid * 16 + i * 8192, R, C); const int Rb = Epi::PERM ? ((R & ~31) + perm32(R & 31)) : R;
        voffA[i] = (unsigned)(R * lda + C) * 2u; voffB[i] = (unsigned)(Rb * K + C) * 2u; }
    const size_t kstep = (size_t)(BK * 2);
    const size_t hstepA = (size_t)HALF * lda * 2, hstepB = (size_t)HALF * K * 2;
    const size_t tstepA = 2 * hstepA, tstepB = 2 * hstepB;
    const unsigned ldsw = (unsigned)wid * 1024u;
    const int aoff = lds_byte(wr * 64 + fr, fq * 8), boff = lds_byte(wc * 32 + fr, fq * 8);
#define PG8_SA(b, h) (((b) * 2 + (h)) * HTB)
#define PG8_SB(b, h) ((4 + (b) * 2 + (h)) * HTB)
#define PG8_STAGE(bufoff, gbase, voff) do { _Pragma("unroll") for (int _i = 0; _i < 2; ++_i) \
        __builtin_amdgcn_global_load_lds((const unsigned*)((const char*)(gbase) + (voff)[_i]), (LAS unsigned*)(lds + (bufoff) + ldsw + _i * 8192), 16, 0, 0); } while (0)
#define PG8_LDA(dst, b, h) do { _Pragma("unroll") for (int m = 0; m < 4; ++m) _Pragma("unroll") for (int k = 0; k < 2; ++k) dst[m][k] = *(const LAS f16x8*)(lds + PG8_SA(b, h) + aoff + m * 2048 + k * 1024); } while (0)
#define PG8_LDB(dst, b, h) do { _Pragma("unroll") for (int n = 0; n < 2; ++n) _Pragma("unroll") for (int k = 0; k < 2; ++k) dst[n][k] = *(const LAS f16x8*)(lds + PG8_SB(b, h) + boff + n * 2048 + k * 1024); } while (0)
#define PG8_MMA(ai, bj, At, Bt) do { __builtin_amdgcn_s_setprio(1); _Pragma("unroll") for (int m = 0; m < 4; ++m) _Pragma("unroll") for (int n = 0; n < 2; ++n) _Pragma("unroll") for (int k = 0; k < 2; ++k) \
        acc[ai][bj][m][n] = __builtin_amdgcn_mfma_f32_16x16x32_f16(Bt[n][k], At[m][k], acc[ai][bj][m][n], 0, 0, 0); __builtin_amdgcn_s_setprio(0); } while (0)
#define PG8_WAIT_V(n) asm volatile("s_waitcnt vmcnt(" #n ")" ::: "memory")
#define PG8_WAIT_L(n) asm volatile("s_waitcnt lgkmcnt(" #n ")" ::: "memory")
#define PG8_BAR __builtin_amdgcn_s_barrier()
#define PG8_SCHED __builtin_amdgcn_sched_barrier(0)
    Unit cur, nxt; int ui = 0;
    if (!S.next(0, cur)) return;
    f32x4 acc[2][2][4][2];
#pragma unroll
    for (int a = 0; a < 2; ++a)
#pragma unroll
        for (int b = 0; b < 2; ++b)
#pragma unroll
            for (int m = 0; m < 4; ++m)
#pragma unroll
                for (int n = 0; n < 2; ++n) acc[a][b][m][n] = (f32x4){0.f, 0.f, 0.f, 0.f};
    f16x8 At[4][2], B0[2][2], B1[2][2];
    const char* cA = (const char*)g.A + (size_t)cur.pm * tstepA; const char* cB = (const char*)g.Bt + (size_t)cur.pn * tstepB;
    if constexpr (SP2) {
        PG8_STAGE(PG8_SB(0, 0), cB, voffB); PG8_STAGE(PG8_SB(0, 1), cB + hstepB, voffB); PG8_STAGE(PG8_SA(0, 0), cA, voffA); PG8_STAGE(PG8_SA(0, 1), cA + hstepA, voffA);
        if (wr == 1) PG8_BAR;
        PG8_WAIT_V(2); PG8_BAR;
        PG8_STAGE(PG8_SB(1, 0), cB + kstep, voffB); PG8_STAGE(PG8_SA(1, 0), cA + kstep, voffA); PG8_STAGE(PG8_SB(1, 1), cB + hstepB + kstep, voffB);
        PG8_WAIT_V(6); PG8_BAR;
    } else {
        PG8_STAGE(PG8_SB(0, 0), cB, voffB); PG8_STAGE(PG8_SA(0, 0), cA, voffA); PG8_STAGE(PG8_SB(0, 1), cB + hstepB, voffB); PG8_STAGE(PG8_SA(0, 1), cA + hstepA, voffA);
        if (wr == 1) PG8_BAR;
        PG8_WAIT_V(4); PG8_BAR;
        PG8_STAGE(PG8_SB(1, 0), cB + kstep, voffB); PG8_STAGE(PG8_SA(1, 0), cA + kstep, voffA); PG8_STAGE(PG8_SB(1, 1), cB + hstepB + kstep, voffB);
        PG8_WAIT_V(6); PG8_BAR;
    }
    for (;;) {
        const bool has_next = S.next(ui + 1, nxt);
        const char* nA = has_next ? (const char*)g.A + (size_t)nxt.pm * tstepA : cA; const char* nB = has_next ? (const char*)g.Bt + (size_t)nxt.pn * tstepB : cB;
        for (int t = 0; t < nt; t += 2) {
            const bool last = (t == nt - 2);
            const char* a1 = cA + (size_t)(t + 1) * kstep;
            const char* a2 = last ? nA : cA + (size_t)(t + 2) * kstep; const char* b2 = last ? nB : cB + (size_t)(t + 2) * kstep;
            const char* a3 = a2 + kstep; const char* b3 = b2 + kstep;
            if constexpr (SP2) {
            PG8_LDB(B0, 0, 0); PG8_LDB(B1, 0, 1); PG8_SCHED; PG8_LDA(At, 0, 0); PG8_STAGE(PG8_SA(1, 1), a1 + hstepA, voffA);
            PG8_WAIT_V(8); PG8_WAIT_L(0); PG8_BAR; PG8_MMA(0, 0, At, B0); PG8_MMA(0, 1, At, B1); PG8_BAR; PG8_SCHED;
            PG8_LDA(At, 0, 1); PG8_STAGE(PG8_SB(0, 0), b2, voffB); PG8_STAGE(PG8_SB(0, 1), b2 + hstepB, voffB); PG8_STAGE(PG8_SA(0, 0), a2, voffA);
            PG8_WAIT_V(8); PG8_WAIT_L(0); PG8_BAR; PG8_MMA(1, 0, At, B0); PG8_MMA(1, 1, At, B1); PG8_BAR; PG8_SCHED;
            PG8_LDB(B0, 1, 0); PG8_LDB(B1, 1, 1); PG8_SCHED; PG8_LDA(At, 1, 0); PG8_STAGE(PG8_SA(0, 1), a2 + hstepA, voffA);
            PG8_WAIT_V(8); PG8_WAIT_L(0); PG8_BAR; PG8_MMA(0, 0, At, B0); PG8_MMA(0, 1, At, B1); PG8_BAR; PG8_SCHED;
            PG8_LDA(At, 1, 1); PG8_STAGE(PG8_SB(1, 0), b3, voffB); PG8_STAGE(PG8_SB(1, 1), b3 + hstepB, voffB); PG8_STAGE(PG8_SA(1, 0), a3, voffA);
            PG8_WAIT_V(8); PG8_WAIT_L(0); PG8_BAR; PG8_MMA(1, 0, At, B0); PG8_MMA(1, 1, At, B1); PG8_BAR; PG8_SCHED;
            } else {
            PG8_LDB(B0, 0, 0); PG8_SCHED; PG8_LDA(At, 0, 0); PG8_STAGE(PG8_SA(1, 1), a1 + hstepA, voffA);
            PG8_WAIT_L(8); PG8_BAR; PG8_WAIT_L(0); PG8_MMA(0, 0, At, B0); PG8_BAR; PG8_SCHED;
            PG8_LDB(B1, 0, 1); PG8_STAGE(PG8_SB(0, 0), b2, voffB);
            PG8_BAR; PG8_WAIT_L(0); PG8_MMA(0, 1, At, B1); PG8_BAR;
            PG8_LDA(At, 0, 1); PG8_STAGE(PG8_SA(0, 0), a2, voffA);
            PG8_BAR; PG8_WAIT_L(0); PG8_MMA(1, 0, At, B0); PG8_BAR; PG8_SCHED;
            PG8_STAGE(PG8_SB(0, 1), b2 + hstepB, voffB);
            PG8_WAIT_V(6); PG8_BAR; PG8_MMA(1, 1, At, B1); PG8_BAR;
            PG8_LDB(B0, 1, 0); PG8_SCHED; PG8_LDA(At, 1, 0); PG8_STAGE(PG8_SA(0, 1), a2 + hstepA, voffA);
            PG8_WAIT_L(8); PG8_BAR; PG8_WAIT_L(0); PG8_MMA(0, 0, At, B0); PG8_BAR; PG8_SCHED;
            PG8_LDB(B1, 1, 1); PG8_STAGE(PG8_SB(1, 0), b3, voffB);
            PG8_BAR; PG8_WAIT_L(0); PG8_MMA(0, 1, At, B1); PG8_BAR;
            PG8_LDA(At, 1, 1); PG8_STAGE(PG8_SA(1, 0), a3, voffA);
            PG8_BAR; PG8_WAIT_L(0); PG8_MMA(1, 0, At, B0); PG8_BAR; PG8_SCHED;
            PG8_STAGE(PG8_SB(1, 1), b3 + hstepB, voffB);
            PG8_WAIT_V(6); PG8_BAR; PG8_MMA(1, 1, At, B1); PG8_BAR;
            }
        }
        if constexpr (ALIGN_EPI) { if (wr == 0) PG8_BAR; }
        E(acc, cur, wr, wc, fr, fq);
        if (!has_next) break;
#pragma unroll
        for (int a = 0; a < 2; ++a)
#pragma unroll
            for (int b = 0; b < 2; ++b)
#pragma unroll
                for (int m = 0; m < 4; ++m)
#pragma unroll
                    for (int n = 0; n < 2; ++n) acc[a][b][m][n] = (f32x4){0.f, 0.f, 0.f, 0.f};
        cur = nxt; cA = nA; cB = nB; ++ui;
        if constexpr (ALIGN_EPI) { if (wr == 1) PG8_BAR; }
    }
    PG8_WAIT_V(0);
    if constexpr (!ALIGN_EPI) { if (wr == 0) PG8_BAR; }
    PG8_BAR;
#undef PG8_SA
#undef PG8_SB
#undef PG8_STAGE
#undef PG8_LDA
#undef PG8_LDB
#undef PG8_MMA
#undef PG8_WAIT_V
#undef PG8_WAIT_L
#undef PG8_BAR
#undef PG8_SCHED
}
}

__device__ __forceinline__ float wave_sum(float v) {
#pragma unroll
    for (int o = 1; o < 64; o <<= 1) v += __shfl_xor(v, o);
    return v;
}
__device__ __forceinline__ float silu_f(float x) { return x / (1.0f + __expf(-x)); }
__device__ __forceinline__ float sigmoid_f(float x) { return 1.0f / (1.0f + __expf(-x)); }
__device__ __forceinline__ unsigned pk2h(float lo, float hi) { return pg8::pk_f16(lo, hi); }


namespace att {
typedef float f32x16 __attribute__((ext_vector_type(16)));
typedef short s16x4 __attribute__((ext_vector_type(4)));
constexpr int L_B0 = 0, L_B1 = 8192, L_WSF = 16384, L_STG = 18432, L_OWN = 51200, L_CAR = 84992, L_VAL = 118784, L_SELM = 127232, L_UNI = 127488;
__device__ __forceinline__ int crow(int r, int hi) { return (r & 3) + 8 * (r >> 2) + 4 * hi; }
__device__ __forceinline__ float swapmax(float m) { auto rr = __builtin_amdgcn_permlane32_swap(__float_as_uint(m), __float_as_uint(m), false, false); return fmaxf(__uint_as_float(rr[0]), __uint_as_float(rr[1])); }
__device__ __forceinline__ float swapadd(float m) { auto rr = __builtin_amdgcn_permlane32_swap(__float_as_uint(m), __float_as_uint(m), false, false); return __uint_as_float(rr[0]) + __uint_as_float(rr[1]); }
__device__ __forceinline__ float ex2(float x) { return __builtin_amdgcn_exp2f(x); }
__device__ __forceinline__ void qkt(f32x16& p0, f32x16& p1, const LAS unsigned char* Kt, const f16x8 (&qr)[4], int r32, int hi) {
    const LAS unsigned char* kb = Kt + hi * 1024 + r32 * 16;
    p0 = (f32x16){}; p1 = (f32x16){};
#pragma unroll
    for (int d0 = 0; d0 < 4; ++d0) {
        const f16x8 b0 = *(const LAS f16x8*)(kb + d0 * 2048), b1 = *(const LAS f16x8*)(kb + d0 * 2048 + 512);
        p0 = __builtin_amdgcn_mfma_f32_32x32x16_f16(b0, qr[d0], p0, 0, 0, 0);
        p1 = __builtin_amdgcn_mfma_f32_32x32x16_f16(b1, qr[d0], p1, 0, 0, 0);
    }
}
__device__ __forceinline__ f16x8 pk8(const f32x16& p, int b) { f16x8 r;
#pragma unroll
    for (int j = 0; j < 8; ++j) r[j] = (f16)p[b + j];
    return r; }
__device__ __forceinline__ void pv(f32x16 (&o)[2], const LAS unsigned char* vb, const f16x8 (&pa)[4]) {
#pragma unroll
    for (int d0 = 0; d0 < 2; ++d0)
#pragma unroll
        for (int ks = 0; ks < 4; ++ks) {
            const s16x4 lo = __builtin_amdgcn_ds_read_tr16_b64_v4i16((LAS s16x4*)(vb + d0 * 4096 + ks * 1024));
            const s16x4 hh = __builtin_amdgcn_ds_read_tr16_b64_v4i16((LAS s16x4*)(vb + d0 * 4096 + ks * 1024 + 512));
            const f16x4 l4 = __builtin_bit_cast(f16x4, lo), h4 = __builtin_bit_cast(f16x4, hh);
            const f16x8 B = {l4[0], l4[1], l4[2], l4[3], h4[0], h4[1], h4[2], h4[3]};
            o[d0] = __builtin_amdgcn_mfma_f32_32x32x16_f16(pa[ks], B, o[d0], 0, 0, 0);
        }
}
__device__ __forceinline__ float rowmax(const f32x16& p0, const f32x16& p1) {
    float a = fmaxf(p0[0], p1[0]);
#pragma unroll
    for (int r = 1; r < 16; ++r) a = fmaxf(a, fmaxf(p0[r], p1[r]));
    return swapmax(a);
}
__device__ __forceinline__ void online(f32x16& p0, f32x16& p1, f32x16 (&o)[2], float& m, float& l, LAS float* wsf, int r32, int hi) {
    const float mn = fmaxf(m, rowmax(p0, p1));
    if (__any(mn > m)) {
        const float alpha = (mn == -INFINITY) ? 1.0f : ex2(m - mn);
        l *= alpha;
        if (hi == 0) wsf[r32] = alpha;
#pragma unroll
        for (int r = 0; r < 16; ++r) { const float a = (wsf + 4 * hi)[crow(r, 0)]; o[0][r] *= a; o[1][r] *= a; }
        m = mn;
    }
    const float mu = (m == -INFINITY) ? 0.0f : m;
    float s = 0.f;
#pragma unroll
    for (int r = 0; r < 16; ++r) { p0[r] = ex2(p0[r] - mu); p1[r] = ex2(p1[r] - mu); s += p0[r] + p1[r]; }
    l += s;
}
__device__ __forceinline__ void accum(f32x16 (&res)[2], const f32x16 (&o)[2], float fac, LAS float* wsf, int r32, int hi) {
    if (hi == 0) wsf[r32] = fac;
#pragma unroll
    for (int r = 0; r < 16; ++r) { const float a = (wsf + 4 * hi)[crow(r, 0)]; res[0][r] = fmaf(a, o[0][r], res[0][r]); res[1][r] = fmaf(a, o[1][r], res[1][r]); }
}

__device__ __forceinline__ void attn_unit(LAS unsigned char* lds, int b, int hk, int qb, const f16* Q, const f16* KVb, const f16* KCMP, const float* Gt, f16* ATT, int tid) {
    const int lane = tid & 63, wave = __builtin_amdgcn_readfirstlane(tid >> 6), r32 = lane & 31, hi = lane >> 5;
    const int g = wave >> 1, qh = wave & 1, h = hk * 4 + g;
    const int tl = 32 * qh + r32, tq = 64 * qb + tl; const size_t mq = (size_t)b * SEQ + tq;
    LAS unsigned char* B0 = lds + L_B0; LAS unsigned char* B1 = lds + L_B1;
    LAS float* wsf = (LAS float*)(lds + L_WSF + wave * 256);
    LAS float* ownl = (LAS float*)(lds + L_OWN); LAS float* carl = (LAS float*)(lds + L_CAR); LAS float* vall = (LAS float*)(lds + L_VAL);
    LAS unsigned* selm = (LAS unsigned*)(lds + L_SELM); LAS unsigned* unim = (LAS unsigned*)(lds + L_UNI);
    const int stoff = wave * 1024 + lane * 16;
    const int kcol = 8 * wave, vrow = 16 * (wave & 3) + (lane >> 2), vcol = 32 * (wave >> 2) + 8 * (lane & 3);
    const LAS unsigned char* vb0 = B0 + ((lane >> 4) & 1) * 32 + (lane & 3) * 8 + (4 * hi + ((lane & 15) >> 2)) * 64;
    const LAS unsigned char* vb1 = vb0 + 8192;
    f16x8 qr[4];
#pragma unroll
    for (int d0 = 0; d0 < 4; ++d0) qr[d0] = *(const f16x8*)(Q + mq * 512 + h * 64 + d0 * 16 + hi * 8);
    f32x16 res[2]; res[0] = (f32x16){}; res[1] = (f32x16){};
    const f16* kc = KCMP + (((size_t)0 * 16 + b) * 2 + hk) * 128 * 64; const f16* vc = KCMP + (((size_t)1 * 16 + b) * 2 + hk) * 128 * 64;
    {
        const f16x8 k0 = *(const f16x8*)(kc + (size_t)lane * 64 + kcol), k1 = *(const f16x8*)(kc + (size_t)(64 + lane) * 64 + kcol);
        __syncthreads();
        *(LAS f16x8*)(B0 + stoff) = k0; *(LAS f16x8*)(B1 + stoff) = k1;
        if (tid < 64) selm[tid] = 0u; if (tid == 64) unim[0] = 0u;
        __syncthreads();
        f32x16 a0, a1, b0, b1;
        qkt(a0, a1, B0, qr, r32, hi); qkt(b0, b1, B1, qr, r32, hi);
        const int nvalid = (tq >= 31) ? (((tq - 31) >> 4) + 1) : 0;
#pragma unroll
        for (int r = 0; r < 16; ++r) { const int kk = crow(r, 0); const int thr = nvalid - 4 * hi;
            a0[r] = (kk >= thr) ? -INFINITY : a0[r]; a1[r] = (kk + 32 >= thr) ? -INFINITY : a1[r]; b0[r] = (kk + 64 >= thr) ? -INFINITY : b0[r]; b1[r] = (kk + 96 >= thr) ? -INFINITY : b1[r]; }
        const float mx = fmaxf(rowmax(a0, a1), rowmax(b0, b1)); const float mu = (mx == -INFINITY) ? 0.0f : mx;
        float sum = 0.f;
#pragma unroll
        for (int r = 0; r < 16; ++r) { a0[r] = ex2(a0[r] - mu); a1[r] = ex2(a1[r] - mu); b0[r] = ex2(b0[r] - mu); b1[r] = ex2(b1[r] - mu); sum += (a0[r] + a1[r]) + (b0[r] + b1[r]); }
        sum = swapadd(sum);
        const float inv = (sum > 0.f) ? 1.0f / sum : 0.f;
        {
            LAS float* op = ownl + (g * 64 + tl) * 33 + hi; LAS float* cp = carl + (g * 64 + tl) * 33 + hi;
#pragma unroll
            for (int X = 0; X < 4; ++X)
#pragma unroll
                for (int a = 0; a < 4; ++a) { const f32x16& P = (X == 0) ? a0 : (X == 1) ? a1 : (X == 2) ? b0 : b1;
                    const int j0 = 8 * X + 2 * a;
                    op[j0] = ((P[4 * a] + P[4 * a + 1]) + (P[4 * a + 2] + P[4 * a + 3])) * inv;
                    if (j0 + 1 < 31) cp[j0 + 1] = P[4 * a + 3] * inv; else if (hi == 0) cp[j0 + 1] = P[4 * a + 3] * inv; }
        }
        f16x8 paA[4], paB[4];
        paA[0] = pk8(a0, 0); paA[1] = pk8(a0, 8); paA[2] = pk8(a1, 0); paA[3] = pk8(a1, 8);
        paB[0] = pk8(b0, 0); paB[1] = pk8(b0, 8); paB[2] = pk8(b1, 0); paB[3] = pk8(b1, 8);
        __syncthreads();
        { const f16x8 v0 = *(const f16x8*)(vc + (size_t)vrow * 64 + vcol), v1 = *(const f16x8*)(vc + (size_t)(64 + vrow) * 64 + vcol);
          *(LAS f16x8*)(B0 + stoff) = v0; *(LAS f16x8*)(B1 + stoff) = v1; }
        {
            const int q = tid & 63, jq = tid >> 6;
#pragma unroll
            for (int i = 0; i < 4; ++i) { const int j = jq + 8 * i; float v = 0.f;
#pragma unroll
                for (int gg = 0; gg < 4; ++gg) v += ownl[(gg * 64 + q) * 33 + j] + ((j > 0) ? carl[(gg * 64 + q) * 33 + j] : 0.f);
                if (j > qb) v = -INFINITY; else if (j == 0 || j == qb || j == qb - 1) v = INFINITY;
                vall[q * 33 + j] = v; }
        }
        __syncthreads();
        {
            const int q = tid & 63, jq = tid >> 6; float vx[4]; int rk[4];
#pragma unroll
            for (int i = 0; i < 4; ++i) { vx[i] = vall[q * 33 + jq + 8 * i]; rk[i] = 0; }
            for (int i2 = 0; i2 < 32; ++i2) { const float vi = vall[q * 33 + i2];
#pragma unroll
                for (int i = 0; i < 4; ++i) rk[i] += ((vi > vx[i]) || (vi == vx[i] && i2 < jq + 8 * i)) ? 1 : 0; }
            unsigned bits = 0u;
#pragma unroll
            for (int i = 0; i < 4; ++i) if (rk[i] < 8 && vx[i] > -INFINITY) bits |= 1u << (jq + 8 * i);
            if (bits) { __hip_atomic_fetch_or(selm + q, bits, __ATOMIC_RELAXED, __HIP_MEMORY_SCOPE_WORKGROUP); __hip_atomic_fetch_or(unim, bits, __ATOMIC_RELAXED, __HIP_MEMORY_SCOPE_WORKGROUP); }
        }
        f32x16 o[2]; o[0] = (f32x16){}; o[1] = (f32x16){};
        pv(o, vb0, paA); pv(o, vb1, paB);
        accum(res, o, Gt[mq * 32 + h * 3 + 0] * inv, wsf, r32, hi);
        __syncthreads();
    }
    const unsigned mysel = selm[tl]; const unsigned uni = unim[0];
#pragma unroll 1
    for (int br = 0; br < 2; ++br) {
        const f16* Kg = KVb + (size_t)(2 + 2 * br) * (KV_STRIDE / 2) + (size_t)b * SEQ * 128 + hk * 64;
        const f16* Vg = KVb + (size_t)(3 + 2 * br) * (KV_STRIDE / 2) + (size_t)b * SEQ * 128 + hk * 64;
        const unsigned lo_bits = (qb >= 8) ? ~((1u << (qb - 8)) - 1u) : 0xFFFFFFFFu;
        const unsigned upto = (qb == 31) ? 0xFFFFFFFFu : ((2u << qb) - 1u);
        unsigned todo = (br == 0) ? (uni & upto) : (upto & lo_bits);
        float m = -INFINITY, l = 0.f; f32x16 o[2]; o[0] = (f32x16){}; o[1] = (f32x16){};
        int j = __builtin_ctz(todo); todo &= todo - 1u;
        f16x8 kr = *(const f16x8*)(Kg + (size_t)(64 * j + lane) * 128 + kcol), vr = *(const f16x8*)(Vg + (size_t)(64 * j + vrow) * 128 + vcol);
#pragma unroll 1
        for (;;) {
            __syncthreads();
            *(LAS f16x8*)(B0 + stoff) = kr; *(LAS f16x8*)(B1 + stoff) = vr;
            __syncthreads();
            const int jn = todo ? __builtin_ctz(todo) : -1; todo &= todo - 1u;
            if (jn >= 0) { kr = *(const f16x8*)(Kg + (size_t)(64 * jn + lane) * 128 + kcol); vr = *(const f16x8*)(Vg + (size_t)(64 * jn + vrow) * 128 + vcol); }
            const bool mine = (br == 0) ? (((mysel >> j) & 1u) != 0u) : true;
            if (__any(mine)) {
                f32x16 p0, p1; qkt(p0, p1, B0, qr, r32, hi);
#pragma unroll
                for (int r = 0; r < 16; ++r) { p0[r] = mine ? p0[r] : -INFINITY; p1[r] = mine ? p1[r] : -INFINITY; }
                if (j == qb) {
#pragma unroll
                    for (int r = 0; r < 16; ++r) { const int ki = crow(r, 0); const int tlh = tl - 4 * hi; p0[r] = (ki > tlh) ? -INFINITY : p0[r]; p1[r] = (ki + 32 > tlh) ? -INFINITY : p1[r]; }
                }
                if (br == 1 && j == qb - 8) {
#pragma unroll
                    for (int r = 0; r < 16; ++r) { const int ki = crow(r, 0); const int tlh = tl - 4 * hi; p0[r] = (ki <= tlh) ? -INFINITY : p0[r]; p1[r] = (ki + 32 <= tlh) ? -INFINITY : p1[r]; }
                }
                online(p0, p1, o, m, l, wsf, r32, hi);
                f16x8 pa[4]; pa[0] = pk8(p0, 0); pa[1] = pk8(p0, 8); pa[2] = pk8(p1, 0); pa[3] = pk8(p1, 8);
                pv(o, vb1, pa);
            }
            if (jn < 0) break;
            j = jn;
        }
        const float lt = swapadd(l);
        accum(res, o, Gt[mq * 32 + h * 3 + 1 + br] / fmaxf(lt, 1e-30f), wsf, r32, hi);
    }
    {
        LAS f16* stg = (LAS f16*)(lds + L_STG + wave * 4096);
        LAS f16* stw = stg + 4 * hi * 64 + r32;
#pragma unroll
        for (int r = 0; r < 16; ++r) { const int orow = crow(r, 0); stw[orow * 64] = (f16)res[0][r]; stw[orow * 64 + 32] = (f16)res[1][r]; }
        f16* Ow = ATT + ((size_t)b * SEQ + 64 * qb + 32 * qh) * 512 + h * 64;
#pragma unroll
        for (int i = 0; i < 4; ++i) { const int row = i * 8 + (lane >> 3), ch = lane & 7; const u32x4 v = *(const LAS u32x4*)(stg + row * 64 + ch * 8); *(u32x4*)(Ow + (size_t)row * 512 + ch * 8) = v; }
    }
}
}

struct Args {
    const float* x; const float* c; const int* pos; const float* w_mod; const float* b_mod; const float* norm1_g; const float* w_in;
    const float* pe_k; const float* w1_k; const float* w2_k; const float* pe_v; const float* w1_v; const float* w2_v;
    const float* conv_w; const float* g_attn; const float* g_conv; const float* w_out; const float* norm2_g;
    const float* ffn_up; const float* ffn_conv; const float* ffn_down; const float* final_g;
    float* out; unsigned char* ws; int ph_lo, ph_hi;
};

__device__ __forceinline__ void transpose_item(const float* W, int K, int Nsrc, int Ndst, f16* WT, LAS float* scr, int item, int lane) {
    const int nblk = Ndst / 32, kb = item / nblk, nb = item % nblk, k0 = 64 * kb, n0 = 32 * nb;
    const int sc = n0 + (lane & 31);
#pragma unroll 8
    for (int i = 0; i < 32; ++i) { const int kk = 2 * i + (lane >> 5); scr[kk * 33 + (lane & 31)] = (sc < Nsrc) ? W[(size_t)(k0 + kk) * Nsrc + sc] : 0.f; }
    asm volatile("s_waitcnt lgkmcnt(0)" ::: "memory");
    const int c = lane & 7;
#pragma unroll
    for (int j = 0; j < 4; ++j) { const int n = (lane >> 3) + 8 * j; const LAS float* s = scr + (8 * c) * 33 + n;
        u32x4 o; o.x = pk2h(s[0 * 33], s[1 * 33]); o.y = pk2h(s[2 * 33], s[3 * 33]); o.z = pk2h(s[4 * 33], s[5 * 33]); o.w = pk2h(s[6 * 33], s[7 * 33]);
        *(u32x4*)(WT + (size_t)(n0 + n) * K + k0 + 8 * c) = o; }
    asm volatile("s_waitcnt lgkmcnt(0)" ::: "memory");
}

__device__ __forceinline__ void sincos_d(double a, float& s, float& c) {
    const double k = rint(a * 0.63661977236758134308);
    double r = fma(-k, 1.57079632679489655800e+00, a); r = fma(-k, 6.12323399573676603587e-17, r);
    const double r2 = r * r;
    double sp = -1.0 / 1307674368000.0;
    sp = fma(sp, r2, 1.0 / 6227020800.0);
    sp = fma(sp, r2, -1.0 / 39916800.0);
    sp = fma(sp, r2, 1.0 / 362880.0);
    sp = fma(sp, r2, -1.0 / 5040.0);
    sp = fma(sp, r2, 1.0 / 120.0);
    sp = fma(sp, r2, -1.0 / 6.0);
    const double sn = fma(sp * r2, r, r);
    double cp = 1.0 / 20922789888000.0;
    cp = fma(cp, r2, -1.0 / 87178291200.0);
    cp = fma(cp, r2, 1.0 / 479001600.0);
    cp = fma(cp, r2, -1.0 / 3628800.0);
    cp = fma(cp, r2, 1.0 / 40320.0);
    cp = fma(cp, r2, -1.0 / 720.0);
    cp = fma(cp, r2, 1.0 / 24.0);
    cp = fma(cp, r2, -0.5);
    const double cs = fma(cp, r2, 1.0);
    const int q = ((int)k) & 3;
    const double ss = (q == 0) ? sn : (q == 1) ? cs : (q == 2) ? -sn : -cs;
    const double cc = (q == 0) ? cs : (q == 1) ? -sn : (q == 2) ? -cs : sn;
    s = (float)ss; c = (float)cc;
}

template <int ph>
__device__ __forceinline__ void run_phase(LAS unsigned char* lds, const Args& A) {
    {
        int tid = threadIdx.x; asm volatile("" : "+v"(tid));
        const int lane = tid & 63, wave = __builtin_amdgcn_readfirstlane(tid >> 6);
        int G = gridDim.x, bx = blockIdx.x; asm volatile("" : "+s"(G), "+s"(bx));
        const int gw = bx * NWAVES + wave, NGW = G * NWAVES;
        const int gt = bx * NTHREADS + tid, NGT = G * NTHREADS;
        unsigned char* ws = A.ws;
        float* MOD = (float*)(ws + WS_MOD);
        float* ROPE = (float*)(ws + WS_ROPE);
        f16* HALO = (f16*)(ws + WS_HALO);
        f16* Hb = (f16*)(ws + WS_H);
        f16* KCMP = (f16*)(ws + WS_KCMP);
        float* Gt = (float*)(ws + WS_G);
        unsigned* SEL = (unsigned*)(ws + WS_SEL);
        f16* U = (f16*)(ws + WS_U);
        f16* PROJ = (f16*)(ws + WS_PROJ);
        float* IMP = (float*)(ws + WS_IMP);
        float* OC = (float*)(ws + WS_OC);
        f16* ATT = (f16*)(ws + WS_ATT);
        f16* MIX = (f16*)(ws + WS_MIX);
        f16* Qb = (f16*)(ws + WS_Q);
        f16* KVb = (f16*)(ws + WS_KV);
        f16* CBb = (f16*)(ws + WS_CB);
        f16* Pb = (f16*)(ws + WS_P);
        float* SUMb = (float*)(ws + WS_SUM);
        constexpr int l = (ph >= 1 && ph < 25) ? (ph - 1) / 12 : 0;
        constexpr int k = (ph >= 1 && ph < 25) ? (ph - 1) % 12 : (ph == 0 ? 100 : 101);
        unsigned char* wl = ws + WS_W + (size_t)l * W_LAYER;
        f16* Win_t = (f16*)(wl + W_IN_OFF); f16* Wout_t = (f16*)(wl + W_OUT_OFF); f16* Wup_t = (f16*)(wl + W_UP_OFF); f16* Wdown_t = (f16*)(wl + W_DOWN_OFF);
        const float* modl = MOD + (size_t)l * 16 * 6144;

        if (PH_EN(14) && k == 100) {
            {
                LAS float* scr = (LAS float*)(lds + wave * 16384);
                constexpr int I_IN = 16 * (NINP / 32), I_OUT = 16 * 32, I_UP = 16 * (NUP / 32), I_DN = (DFF / 64) * 32, I_L = I_IN + I_OUT + I_UP + I_DN;
                for (int it = gw; it < 2 * I_L; it += NGW) {
                    const int ll = it / I_L; int r = it % I_L;
                    unsigned char* wll = ws + WS_W + (size_t)ll * W_LAYER;
                    if (r < I_IN) { transpose_item(A.w_in + (size_t)ll * DM * NIN, DM, NIN, NINP, (f16*)(wll + W_IN_OFF), scr, r, lane); continue; } r -= I_IN;
                    if (r < I_OUT) { transpose_item(A.w_out + (size_t)ll * DM * DM, DM, DM, DM, (f16*)(wll + W_OUT_OFF), scr, r, lane); continue; } r -= I_OUT;
                    if (r < I_UP) { transpose_item(A.ffn_up + (size_t)ll * DM * NUP, DM, NUP, NUP, (f16*)(wll + W_UP_OFF), scr, r, lane); continue; } r -= I_UP;
                    transpose_item(A.ffn_down + (size_t)ll * DFF * DM, DFF, DM, DM, (f16*)(wll + W_DOWN_OFF), scr, r, lane);
                }
            }
            __syncthreads();
            for (int it = gt; it < MTOK * 8; it += NGT) {
                const int m = it >> 3, i = it & 7;
                const double fr = (i == 0) ? 1.0 : (i == 1) ? 0.19392274474868576 : (i == 2) ? 0.03760603093086393 : (i == 3) ? 0.007292664737217109 :
                                  (i == 4) ? 0.001414213562373095 : (i == 5) ? 0.0002742481756762073 : (i == 6) ? 5.318295896944988e-05 : 1.031338537721246e-05;
                float s, c; sincos_d((double)A.pos[m] * fr, s, c);
                ROPE[(size_t)m * 16 + i] = c; ROPE[(size_t)m * 16 + 8 + i] = s;
            }
            {
                LAS float* ca = (LAS float*)lds;
                LAS float* red = (LAS float*)(lds + 65536);
                bool staged = false;
                for (int it = bx; it < 2 * 96; it += G) {
                    if (!staged) { for (int i = tid; i < 16 * 1024; i += NTHREADS) ca[i] = silu_f(A.c[i]); staged = true; }
                    __syncthreads();
                    const int ll = it / 96, n0 = (it % 96) * 64;
                    const float* wm = A.w_mod + (size_t)ll * DM * 6144 + n0 + lane;
                    float acc[16];
#pragma unroll
                    for (int b = 0; b < 16; ++b) acc[b] = 0.f;
                    for (int kk = wave * 128; kk < wave * 128 + 128; kk += 8) {
                        float w[8];
#pragma unroll
                        for (int u = 0; u < 8; ++u) w[u] = wm[(size_t)(kk + u) * 6144];
#pragma unroll
                        for (int u = 0; u < 8; ++u)
#pragma unroll
                            for (int b = 0; b < 16; ++b) acc[b] = fmaf(ca[b * 1024 + kk + u], w[u], acc[b]);
                    }
#pragma unroll
                    for (int b = 0; b < 16; ++b) red[(wave * 16 + b) * 64 + lane] = acc[b];
                    __syncthreads();
                    for (int o = tid; o < 1024; o += NTHREADS) { const int b = o >> 6, n = o & 63; float s = 0.f;
#pragma unroll
                        for (int w8 = 0; w8 < 8; ++w8) s += red[(w8 * 16 + b) * 64 + n];
                        MOD[((size_t)ll * 16 + b) * 6144 + n0 + n] = s + A.b_mod[(size_t)ll * 6144 + n0 + n]; }
                    __syncthreads();
                }
            }
        } else if (PH_EN(0) && (k == 0 || k == 7)) {
            const float* xin = (k == 0 && l == 0) ? A.x : A.out;
            const float* gain = (k == 0 ? A.norm1_g : A.norm2_g) + (size_t)l * DM;
            const float* shp = modl + (k == 0 ? 0 : 3) * 1024; const float* scp = modl + (k == 0 ? 1 : 4) * 1024;
            for (int m = gw; m < MTOK; m += NGW) {
                const int b = m >> 11;
                const f32x4* xr = (const f32x4*)(xin + (size_t)m * DM) + lane;
                f32x4 v[4]; float s = 0.f;
#pragma unroll
                for (int j = 0; j < 4; ++j) { v[j] = xr[64 * j]; s += (v[j].x * v[j].x + v[j].y * v[j].y) + (v[j].z * v[j].z + v[j].w * v[j].w); }
                const float r = 1.0f / sqrtf(wave_sum(s) * (1.0f / DM) + 1e-6f);
#pragma unroll
                for (int j = 0; j < 4; ++j) { const int col = 4 * lane + 256 * j;
                    const f32x4 g4 = *(const f32x4*)(gain + col), sc4 = *(const f32x4*)(scp + (size_t)b * 6144 + col), sh4 = *(const f32x4*)(shp + (size_t)b * 6144 + col);
                    const f32x4 o = (v[j] * r) * g4 * (sc4 + 1.0f) + sh4;
                    u32x2 w; w.x = pk2h(o.x, o.y); w.y = pk2h(o.z, o.w);
                    *(u32x2*)(Hb + (size_t)m * DM + col) = w; }
            }
        } else if (PH_EN(1) && (k == 1 || k == 8)) {
            pg8::Gemm g; pg8::EpiF16 E;
            if (k == 1) { g = pg8::Gemm{Hb, Win_t, MTOK, NINP, DM, DM}; E = pg8::EpiF16{PROJ, NINP}; }
            else { g = pg8::Gemm{Hb, Wup_t, MTOK, NUP, DM, DM}; E = pg8::EpiF16{U, NUP}; }
            pg8::StaticOrder S; S.init(g.M, g.N, G, bx);
            pg8::gemm_phase<pg8::EpiF16, pg8::StaticOrder, true, true>(lds, g, S, E, tid);
        } else if (PH_EN(8) && (k == 6 || k == 11)) {
            pg8::Gemm g; pg8::EpiResid E;
            if (k == 6) { g = pg8::Gemm{MIX, Wout_t, MTOK, DM, DM, DM}; E = pg8::EpiResid{(l == 0) ? A.x : A.out, A.out, modl + 2 * 1024}; }
            else { g = pg8::Gemm{U, Wdown_t, MTOK, DM, DFF, NUP}; E = pg8::EpiResid{A.out, A.out, modl + 5 * 1024}; }
            pg8::StaticOrder S; S.init(g.M, g.N, G, bx);
            pg8::gemm_phase<pg8::EpiResid, pg8::StaticOrder, true, true>(lds, g, S, E, tid);
        } else if (PH_EN(2) && k == 2) {
            for (int idx = gt; idx < MTOK * NIN; idx += NGT) {
                const int m = idx / NIN, col = idx - m * NIN;
                const f16* pr = PROJ + (size_t)m * NINP;
                if (col < 1280) {
                    bool rope; int d;
                    if (col < 512) { d = col & 63; rope = d < 16; }
                    else { const int kvi = (col - 512) >> 7; d = (col - 512) & 63; rope = ((kvi & 1) == 0) && d < 16; }
                    float o;
                    if (rope) { const int i = d & 7, base = col - d; const float x1 = (float)pr[base + i], x2 = (float)pr[base + 8 + i];
                        const float cs = ROPE[(size_t)m * 16 + i], sn = ROPE[(size_t)m * 16 + 8 + i];
                        o = (d < 8) ? (x1 * cs - x2 * sn) : (x2 * cs + x1 * sn); }
                    else o = (float)pr[col];
                    if (col < 512) Qb[(size_t)m * 512 + col] = (f16)(o * 0.18033688011112042f);
                    else { const int kvi = (col - 512) >> 7, cc = (col - 512) & 127; KVb[(size_t)kvi * (KV_STRIDE / 2) + (size_t)m * 128 + cc] = (f16)o; }
                } else if (col < 1304) { Gt[(size_t)m * 32 + (col - 1280)] = sigmoid_f((float)pr[col]); }
                else if (col < 1816) { CBb[(size_t)m * 512 + (col - 1304)] = pr[col]; }
                else if (col < 2328) { Pb[(size_t)m * 512 + (col - 1816)] = (f16)((float)pr[col] * (float)pr[col + 512]); }
            }
        } else if (PH_EN(3) && k == 3) {
            LAS float* tokl = (LAS float*)lds;
            LAS float* pel = (LAS float*)(lds + 36864);
            LAS float* red = (LAS float*)(lds + 36864 + 8192);
            LAS float* hid = (LAS float*)(lds + 36864 + 8192 + 18432);
            for (int it = bx; it < 2 * 16 * 2 * 16; it += G) {
                const int jg = it & 15, hk = (it >> 4) & 1, b = (it >> 5) & 15, kv = it >> 9;
                const f16* src = KVb + (size_t)kv * (KV_STRIDE / 2);
                const float* pe = (kv ? A.pe_v : A.pe_k) + (size_t)l * 32 * 64;
                const float* w1 = (kv ? A.w1_v : A.w1_k) + (size_t)l * 2048 * 128;
                const float* w2 = (kv ? A.w2_v : A.w2_k) + (size_t)l * 128 * 64;
                __syncthreads();
                for (int i = tid; i < 144 * 64; i += NTHREADS) { const int tt = 128 * jg + (i >> 6); tokl[i] = (tt < SEQ) ? (float)src[((size_t)(b * SEQ + tt)) * 128 + hk * 64 + (i & 63)] : 0.f; }
                for (int i = tid; i < 32 * 64; i += NTHREADS) pel[i] = pe[i];
                __syncthreads();
                const int n = tid & 127, part = tid >> 7;
                float acc[9];
#pragma unroll
                for (int j = 0; j < 9; ++j) acc[j] = 0.f;
                for (int ld = part * 512; ld < part * 512 + 512; ++ld) {
                    const float w = w1[(size_t)ld * 128 + n];
#pragma unroll
                    for (int j = 0; j < 8; ++j) acc[j] = fmaf(tokl[j * 16 * 64 + ld], w, acc[j]);
                    acc[8] = fmaf(pel[ld], w, acc[8]);
                }
#pragma unroll
                for (int j = 0; j < 9; ++j) red[(part * 9 + j) * 128 + n] = acc[j];
                __syncthreads();
                for (int o = tid; o < 1024; o += NTHREADS) { const int j = o >> 7, nn = o & 127;
                    float s = 0.f;
#pragma unroll
                    for (int p = 0; p < 4; ++p) s += red[(p * 9 + j) * 128 + nn] + red[(p * 9 + 8) * 128 + nn];
                    hid[j * 128 + nn] = silu_f(s); }
                __syncthreads();
                { const int j = tid >> 6, d = tid & 63, jj = 8 * jg + j; float s = 0.f;
                    for (int nn = 0; nn < 128; ++nn) s = fmaf(hid[j * 128 + nn], w2[nn * 64 + d], s);
                    KCMP[((((size_t)kv * 16 + b) * 2 + hk) * 128 + jj) * 64 + d] = (jj < 127) ? (f16)s : (f16)0.f; }
            }
        } else if (PH_EN(4) && k == 4) {
            for (int it = bx; it < 1024; it += G) {
                const int i4 = it >> 8, c = it & 255, vcu = (c & 7) * 32 + (c >> 3), bh = vcu >> 3, sq = vcu & 7;
                const int qb = (i4 == 0) ? sq : (i4 == 1) ? 15 - sq : (i4 == 2) ? 16 + sq : 31 - sq;
                int tidu = tid; asm volatile("" : "+v"(tidu));
                att::attn_unit(lds, bh >> 1, bh & 1, qb, Qb, KVb, KCMP, Gt, ATT, tidu);
            }
        } else if (PH_EN(7) && k == 5) {
            const float* ga = A.g_attn + (size_t)l * 512; const float* gc = A.g_conv + (size_t)l * 512; const float* cw = A.conv_w + (size_t)l * 3 * 512;
            for (int m = gw; m < MTOK; m += NGW) {
                const int t = m & (SEQ - 1); const int c0 = 8 * lane;
                { const f16x8 v = *(const f16x8*)(ATT + (size_t)m * 512 + c0); float f[8]; float s = 0.f;
#pragma unroll
                    for (int e = 0; e < 8; ++e) { f[e] = (float)v[e]; s += f[e] * f[e]; }
                    const float r = 1.0f / sqrtf(wave_sum(s) * (1.0f / 512.0f) + 1e-6f);
                    u32x4 w; w.x = pk2h(f[0] * r * ga[c0 + 0], f[1] * r * ga[c0 + 1]); w.y = pk2h(f[2] * r * ga[c0 + 2], f[3] * r * ga[c0 + 3]);
                    w.z = pk2h(f[4] * r * ga[c0 + 4], f[5] * r * ga[c0 + 5]); w.w = pk2h(f[6] * r * ga[c0 + 6], f[7] * r * ga[c0 + 7]);
                    *(u32x4*)(MIX + (size_t)m * DM + c0) = w; }
                { const f16x8 p0 = *(const f16x8*)(Pb + (size_t)m * 512 + c0);
                    f16x8 p1 = (f16x8)(f16)0.f, p2 = (f16x8)(f16)0.f;
                    if (t >= 1) p1 = *(const f16x8*)(Pb + (size_t)(m - 1) * 512 + c0);
                    if (t >= 2) p2 = *(const f16x8*)(Pb + (size_t)(m - 2) * 512 + c0);
                    const f16x8 cb = *(const f16x8*)(CBb + (size_t)m * 512 + c0);
                    float f[8]; float s = 0.f;
#pragma unroll
                    for (int e = 0; e < 8; ++e) { const float y = cw[c0 + e] * (float)p2[e] + cw[512 + c0 + e] * (float)p1[e] + cw[1024 + c0 + e] * (float)p0[e];
                        f[e] = (float)cb[e] * y; s += f[e] * f[e]; }
                    const float r = 1.0f / sqrtf(wave_sum(s) * (1.0f / 512.0f) + 1e-6f);
                    u32x4 w; w.x = pk2h(f[0] * r * gc[c0 + 0], f[1] * r * gc[c0 + 1]); w.y = pk2h(f[2] * r * gc[c0 + 2], f[3] * r * gc[c0 + 3]);
                    w.z = pk2h(f[4] * r * gc[c0 + 4], f[5] * r * gc[c0 + 5]); w.w = pk2h(f[6] * r * gc[c0 + 6], f[7] * r * gc[c0 + 7]);
                    *(u32x4*)(MIX + (size_t)m * DM + 512 + c0) = w; }
            }
        } else if (PH_EN(11) && k == 9) {
            for (int it = gt; it < 512 * 2 * (NUP / 8); it += NGT) {
                const int ch = it % (NUP / 8), rr = (it / (NUP / 8)) & 1, gI = it / (2 * (NUP / 8));
                *(u32x4*)(HALO + ((size_t)gI * 2 + rr) * NUP + ch * 8) = *(const u32x4*)(U + (size_t)(64 * gI + 62 + rr) * NUP + ch * 8);
            }
        } else if (PH_EN(12) && k == 10) {
            const float* fc = A.ffn_conv + (size_t)l * 3 * NUP;
            for (int it = gw; it < 512 * 6; it += NGW) {
                const int gI = it / 6, chunk = it % 6, c8 = chunk * 64 + lane;
                if (c8 < DFF / 8) {
                    const int c = 8 * c8;
                    float wa[3][8], wv[3][8];
#pragma unroll
                    for (int kk = 0; kk < 3; ++kk)
#pragma unroll
                        for (int e = 0; e < 8; ++e) { wa[kk][e] = fc[(size_t)kk * NUP + c + e]; wv[kk][e] = fc[(size_t)kk * NUP + DFF + c + e]; }
                    f16x8 a1 = (f16x8)(f16)0.f, a2 = a1, v1 = a1, v2 = a1;
                    if ((gI & 31) != 0) { const f16* hp = HALO + (size_t)(gI - 1) * 2 * NUP;
                        a2 = *(const f16x8*)(hp + c); v2 = *(const f16x8*)(hp + DFF + c); a1 = *(const f16x8*)(hp + NUP + c); v1 = *(const f16x8*)(hp + NUP + DFF + c); }
                    for (int r = 0; r < 64; ++r) {
                        f16* up = U + (size_t)(64 * gI + r) * NUP;
                        const f16x8 a0 = *(const f16x8*)(up + c), v0 = *(const f16x8*)(up + DFF + c);
                        float o[8];
#pragma unroll
                        for (int e = 0; e < 8; ++e) { const float ya = wa[0][e] * (float)a2[e] + wa[1][e] * (float)a1[e] + wa[2][e] * (float)a0[e];
                            const float yv = wv[0][e] * (float)v2[e] + wv[1][e] * (float)v1[e] + wv[2][e] * (float)v0[e];
                            o[e] = silu_f(ya) * yv; }
                        u32x4 w; w.x = pk2h(o[0], o[1]); w.y = pk2h(o[2], o[3]); w.z = pk2h(o[4], o[5]); w.w = pk2h(o[6], o[7]);
                        *(u32x4*)(up + c) = w;
                        a2 = a1; a1 = a0; v2 = v1; v1 = v0;
                    }
                }
            }
        } else if (PH_EN(15) && k == 101) {
            for (int m = gw; m < MTOK; m += NGW) {
                f32x4* xr = (f32x4*)(A.out + (size_t)m * DM) + lane;
                f32x4 v[4]; float s = 0.f;
#pragma unroll
                for (int j = 0; j < 4; ++j) { v[j] = xr[64 * j]; s += (v[j].x * v[j].x + v[j].y * v[j].y) + (v[j].z * v[j].z + v[j].w * v[j].w); }
                const float r = 1.0f / sqrtf(wave_sum(s) * (1.0f / DM) + 1e-6f);
#pragma unroll
                for (int j = 0; j < 4; ++j) { const f32x4 g4 = *(const f32x4*)(A.final_g + 4 * lane + 256 * j); xr[64 * j] = (v[j] * r) * g4; }
            }
        }
    }
}

__global__ void __launch_bounds__(NTHREADS, 2) fwd_kernel(Args A0) {
    extern __shared__ __attribute__((aligned(16))) unsigned char lds_raw[];
    LAS unsigned char* lds = (LAS unsigned char*)lds_raw;
    cg::grid_group grid = cg::this_grid();
    const int ph_lo = A0.ph_lo, ph_hi = A0.ph_hi;
#define STEP(P) if (ph_lo <= (P) && (P) < ph_hi) { run_phase<(P)>(lds, A0); if ((P) + 1 < ph_hi) grid.sync(); }
    STEP(0) STEP(1) STEP(2) STEP(3) STEP(4) STEP(5) STEP(6) STEP(7) STEP(8) STEP(9)
    STEP(10) STEP(11) STEP(12) STEP(13) STEP(14) STEP(15) STEP(16) STEP(17) STEP(18) STEP(19)
    STEP(20) STEP(21) STEP(22) STEP(23) STEP(24) STEP(25)
#undef STEP
}

extern "C" void kernel_launch(void* const* d_in, const int* in_sizes, int n_in, void* d_out, int out_size, void* d_ws, size_t ws_size, hipStream_t stream) {
    static int grid = 0;
    if (grid == 0) {
        if (n_in != 22 || out_size != MTOK * DM || ws_size < WS_END) { fprintf(stderr, "kernel_launch: unexpected shapes (n_in %d out %d ws %zu)\n", n_in, out_size, ws_size); grid = -1; return; }
        int dev = 0, cus = 0, per_cu = 0;
        hipGetDevice(&dev);
        hipDeviceGetAttribute(&cus, hipDeviceAttributeMultiprocessorCount, dev);
        hipFuncSetAttribute((const void*)fwd_kernel, hipFuncAttributeMaxDynamicSharedMemorySize, LDS_BYTES);
        hipOccupancyMaxActiveBlocksPerMultiprocessor(&per_cu, (const void*)fwd_kernel, NTHREADS, LDS_BYTES);
        (void)hipGetLastError();
        if (per_cu < 1) per_cu = 1;
        grid = cus * per_cu;
    }
    if (grid < 0) return;
    Args a{};
    a.x = (const float*)d_in[0]; a.c = (const float*)d_in[1]; a.pos = (const int*)d_in[2]; a.w_mod = (const float*)d_in[3]; a.b_mod = (const float*)d_in[4];
    a.norm1_g = (const float*)d_in[5]; a.w_in = (const float*)d_in[6]; a.pe_k = (const float*)d_in[7]; a.w1_k = (const float*)d_in[8]; a.w2_k = (const float*)d_in[9];
    a.pe_v = (const float*)d_in[10]; a.w1_v = (const float*)d_in[11]; a.w2_v = (const float*)d_in[12]; a.conv_w = (const float*)d_in[13]; a.g_attn = (const float*)d_in[14];
    a.g_conv = (const float*)d_in[15]; a.w_out = (const float*)d_in[16]; a.norm2_g = (const float*)d_in[17]; a.ffn_up = (const float*)d_in[18]; a.ffn_conv = (const float*)d_in[19];
    a.ffn_down = (const float*)d_in[20]; a.final_g = (const float*)d_in[21];
    a.out = (float*)d_out; a.ws = (unsigned char*)d_ws;
#if MK_ONE_LAUNCH
    a.ph_lo = 0; a.ph_hi = NPH;
    void* args[] = {&a};
    hipError_t e = hipLaunchCooperativeKernel((const void*)fwd_kernel, dim3(grid), dim3(NTHREADS), args, LDS_BYTES, stream);
    if (e != hipSuccess) fprintf(stderr, "cooperative launch failed: %s (grid %d)\n", hipGetErrorString(e), grid);
#else
    for (int ph = 0; ph < NPH; ++ph) {
        a.ph_lo = ph; a.ph_hi = ph + 1;
        hipLaunchKernelGGL(fwd_kernel, dim3(grid), dim3(NTHREADS), LDS_BYTES, stream, a);
    }
#endif
}
```

```cpp
#include <hip/hip_runtime.h>
#include <hip/hip_cooperative_groups.h>
#include <cstdio>
#include <cstdint>
namespace cg = cooperative_groups;

#define LAS __attribute__((address_space(3)))
typedef _Float16 f16;
typedef _Float16 f16x8 __attribute__((ext_vector_type(8)));
typedef _Float16 f16x4 __attribute__((ext_vector_type(4)));
typedef _Float16 f16x2 __attribute__((ext_vector_type(2)));
typedef float f32x4 __attribute__((ext_vector_type(4)));
typedef float f32x2 __attribute__((ext_vector_type(2)));
typedef unsigned u32x4 __attribute__((ext_vector_type(4)));
typedef unsigned u32x2 __attribute__((ext_vector_type(2)));

#ifndef PHMASK
#define PHMASK 0xFFFFFu
#endif
#define PH_EN(b) (((PHMASK) >> (b)) & 1u)
#ifndef MK_ONE_LAUNCH
#define MK_ONE_LAUNCH 1
#endif

constexpr int BATCH = 16, SEQ = 2048, DM = 1024, MTOK = BATCH * SEQ;
constexpr int NIN = 2840, NINP = 3072, DFF = 2816, NUP = 2 * DFF;
constexpr int NWAVES = 8, NTHREADS = 512;
constexpr int NPH = 22;

constexpr size_t MiB = 1u << 20;
constexpr size_t WS_CTL = 0;
constexpr size_t WS_MOD = 1 * MiB;
constexpr size_t WS_ROPE = 2 * MiB;
constexpr size_t WS_W1T = 4 * MiB;
constexpr size_t WS_W2T = 6 * MiB;
constexpr size_t WS_BPE = 6 * MiB + 65536;
constexpr size_t WS_HALO = 8 * MiB;
constexpr size_t WS_W = 20 * MiB;
constexpr size_t W_IN_OFF = 0, W_OUT_OFF = 6 * MiB, W_UP_OFF = 8 * MiB, W_DOWN_OFF = 19 * MiB, W_LAYER = 25 * MiB;
constexpr size_t WS_H = 70 * MiB;
constexpr size_t WS_KCMP = 134 * MiB;
constexpr size_t WS_G = 135 * MiB;
constexpr size_t WS_SEL = 139 * MiB;
constexpr size_t WS_BIG = 140 * MiB;
constexpr size_t WS_U = WS_BIG;
constexpr size_t WS_PROJ = WS_BIG;
constexpr size_t WS_IMP = WS_BIG;
constexpr size_t WS_OC = WS_BIG + 32 * MiB;
constexpr size_t WS_ATT = WS_BIG + 96 * MiB;
constexpr size_t WS_MIX = WS_BIG + 128 * MiB;
constexpr size_t WS_Q = WS_BIG + 192 * MiB;
constexpr size_t WS_KV = WS_BIG + 224 * MiB;
constexpr size_t KV_STRIDE = 8 * MiB;
constexpr size_t WS_CB = WS_BIG + 272 * MiB;
constexpr size_t WS_P = WS_BIG + 304 * MiB;
constexpr size_t WS_SUM = WS_BIG + 336 * MiB;
constexpr size_t WS_END = 512 * MiB;

constexpr int RING_BYTES = 131072;
constexpr int LDS_BYTES = 147456;

namespace pg8 {
constexpr int BM = 256, BK = 64, HALF = 128, HTB = HALF * BK * 2, STAGE_BYTES = 8 * HTB, NXCD = 8, WGM = 8;
__host__ __device__ __forceinline__ int lds_byte(int r, int c) { const int st = (r >> 4) * 2 + (c >> 5), rr = r & 15, cc = c & 31, ob = rr * 64 + cc * 2; return st * 1024 + (ob ^ (((ob >> 9) & 1) << 5)); }
__host__ __device__ __forceinline__ void stage_rc(int b, int& R, int& C) { const int st = b / 1024, sb = b % 1024, swz = sb ^ (((sb >> 9) & 1) << 5); R = (st >> 1) * 16 + swz / 64; C = (st & 1) * 32 + (swz % 64) / 2; }
__host__ __device__ __forceinline__ int perm32(int rho) { const int n = rho >> 4, i = rho & 15; return 8 * (i >> 2) + 4 * n + (i & 3); }

struct Unit { int pm, pn; };
struct Gemm { const f16* A; const f16* Bt; int M, N, K, lda; };

struct StaticOrder {
    int nM, nN, nwg, G, c;
    __device__ void init(int M, int N, int G_, int c_) { nM = M / BM; nN = N / BM; nwg = nM * nN; G = G_; c = c_; }
    __device__ bool next(int i, Unit& u) const {
        const long L = (long)i * G + c; if (L >= nwg) return false;
        int wgid = (int)L; { const int q = nwg / NXCD, r = nwg % NXCD, xcd = wgid % NXCD, off = wgid / NXCD; wgid = (xcd < r ? xcd * (q + 1) : r * (q + 1) + (xcd - r) * q) + off; }
        const int nig = WGM * nN, gid = wgid / nig, fm = gid * WGM, gsz = (nM - fm) < WGM ? (nM - fm) : WGM;
        u.pm = fm + ((wgid % nig) % gsz); u.pn = (wgid % nig) / gsz; return true;
    }
};

__device__ __forceinline__ unsigned pk_f16(float lo, float hi) { f32x2 v = {lo, hi}; f16x2 h = __builtin_convertvector(v, f16x2); return __builtin_bit_cast(unsigned, h); }

struct EpiF16 {
    static constexpr bool PERM = true;
    f16* O; int ldc; f16* halo;
    __device__ __forceinline__ void operator()(const f32x4 (&acc)[2][2][4][2], const Unit& u, int wr, int wc, int fr, int fq) const {
        const int row0 = u.pm * BM + wr * 64 + fr; const int col0 = u.pn * BM + wc * 32 + 8 * fq;
#pragma unroll
        for (int ai = 0; ai < 2; ++ai)
#pragma unroll
            for (int m = 0; m < 4; ++m) { f16* rowp = O + (size_t)(row0 + ai * HALF + m * 16) * ldc + col0;
#pragma unroll
                for (int bj = 0; bj < 2; ++bj) { const f32x4 v0 = acc[ai][bj][m][0], v1 = acc[ai][bj][m][1];
                    u32x4 w; w.x = pk_f16(v0[0], v0[1]); w.y = pk_f16(v0[2], v0[3]); w.z = pk_f16(v1[0], v1[1]); w.w = pk_f16(v1[2], v1[3]);
                    *(u32x4*)(rowp + bj * HALF) = w;
                    if (halo != nullptr && m == 3 && fr >= 14) { const int row = row0 + ai * HALF + m * 16; *(u32x4*)(halo + ((size_t)(row >> 6) * 2 + (fr - 14)) * ldc + col0 + bj * HALF) = w; } } }
    }
};

struct EpiIn {
    static constexpr bool PERM = true;
    f16* Q; f16* KV; f16* CB; f16* P; float* Gt; const float* rope;
    __device__ __forceinline__ void operator()(const f32x4 (&acc)[2][2][4][2], const Unit& u, int wr, int wc, int fr, int fq) const {
        const int row0 = u.pm * BM + wr * 64 + fr, pn = u.pn, cl = wc * 32 + 8 * fq;
        const bool ropelane = (cl & 63) < 16; const int ro = (cl & 8) ? 4 : 0;
#pragma unroll
        for (int ai = 0; ai < 2; ++ai)
#pragma unroll
            for (int m = 0; m < 4; ++m) { const int row = row0 + ai * HALF + m * 16;
                f32x4 cs = {1.f, 1.f, 1.f, 1.f}, sn = {0.f, 0.f, 0.f, 0.f};
                if (pn < 5 && ropelane) { cs = *(const f32x4*)(rope + (size_t)row * 16 + ro); sn = *(const f32x4*)(rope + (size_t)row * 16 + 8 + ro); }
#pragma unroll
                for (int bj = 0; bj < 2; ++bj) { f32x4 v0 = acc[ai][bj][m][0], v1 = acc[ai][bj][m][1];
                    if (pn < 5) {
                        if ((pn < 2 || bj == 0) && ropelane) { const f32x4 n0 = v0 * cs - v1 * sn, n1 = v1 * cs + v0 * sn; v0 = n0; v1 = n1; }
                        f16* dst;
                        if (pn < 2) { v0 = v0 * 0.18033688011112042f; v1 = v1 * 0.18033688011112042f; dst = Q + (size_t)row * 512 + (256 * pn + 128 * bj + cl); }
                        else dst = KV + (size_t)(2 * (pn - 2) + bj) * (KV_STRIDE / 2) + (size_t)row * 128 + cl;
                        u32x4 w; w.x = pk_f16(v0[0], v0[1]); w.y = pk_f16(v0[2], v0[3]); w.z = pk_f16(v1[0], v1[1]); w.w = pk_f16(v1[2], v1[3]);
                        *(u32x4*)dst = w;
                    } else if (pn < 7) {
                        u32x4 w; w.x = pk_f16(v0[0], v0[1]); w.y = pk_f16(v0[2], v0[3]); w.z = pk_f16(v1[0], v1[1]); w.w = pk_f16(v1[2], v1[3]);
                        *(u32x4*)(CB + (size_t)row * 512 + (256 * (pn - 5) + 128 * bj + cl)) = w;
                    } else if (pn < 11) {
                        const f32x4 pr = v0 * v1; u32x2 w; w.x = pk_f16(pr[0], pr[1]); w.y = pk_f16(pr[2], pr[3]);
                        *(u32x2*)(P + (size_t)row * 512 + ((256 * (pn - 7) + 128 * bj + cl) >> 1)) = w;
                    } else {
                        const int c = 128 * bj + cl;
                        if (c < 24) { f32x4 g0, g1;
#pragma unroll
                            for (int e = 0; e < 4; ++e) { g0[e] = 1.0f / (1.0f + __expf(-v0[e])); g1[e] = 1.0f / (1.0f + __expf(-v1[e])); }
                            *(f32x4*)(Gt + (size_t)row * 32 + c) = g0; *(f32x4*)(Gt + (size_t)row * 32 + c + 4) = g1; }
                    } } }
    }
};
struct EpiResid {
    static constexpr bool PERM = false;
    const float* base; float* out; const float* gate;
    __device__ __forceinline__ void operator()(const f32x4 (&acc)[2][2][4][2], const Unit& u, int wr, int wc, int fr, int fq) const {
        const int col0 = u.pn * BM + wc * 32 + 4 * fq; const int b = (u.pm * BM) >> 11;
        f32x4 gv[2][2];
#pragma unroll
        for (int bj = 0; bj < 2; ++bj)
#pragma unroll
            for (int n = 0; n < 2; ++n) gv[bj][n] = *(const f32x4*)(gate + (size_t)b * 6144 + col0 + bj * HALF + n * 16);
#pragma unroll
        for (int ai = 0; ai < 2; ++ai)
#pragma unroll
            for (int m = 0; m < 4; ++m) { const size_t off = (size_t)(u.pm * BM + ai * HALF + wr * 64 + m * 16 + fr) * DM + col0;
#pragma unroll
                for (int bj = 0; bj < 2; ++bj)
#pragma unroll
                    for (int n = 0; n < 2; ++n) { const f32x4 bs = *(const f32x4*)(base + off + bj * HALF + n * 16);
                        *(f32x4*)(out + off + bj * HALF + n * 16) = bs + gv[bj][n] * acc[ai][bj][m][n]; }
                if (m & 1) asm volatile("" ::: "memory"); }
    }
};

template <class Epi, class Sched, bool ALIGN_EPI = false, bool SP2 = false>
__device__ __forceinline__ void gemm_phase(LAS unsigned char* lds, const Gemm g, const Sched& S, const Epi& E, const int tid) {
    const int wid = __builtin_amdgcn_readfirstlane(tid >> 6), lane = tid & 63, wr = wid >> 2, wc = wid & 3, fr = lane & 15, fq = lane >> 4;
    const int K = g.K, nt = K / BK, lda = g.lda;
    unsigned voffA[2], voffB[2];
#pragma unroll
    for (int i = 0; i < 2; ++i) { int R, C; stage_rc(tid * 16 + i * 8192, R, C); const int Rb = Epi::PERM ? ((R & ~31) + perm32(R & 31)) : R;
        voffA[i] = (unsigned)(R * lda + C) * 2u; voffB[i] = (unsigned)(Rb * K + C) * 2u; }
    const size_t kstep = (size_t)(BK * 2);
    const size_t hstepA = (size_t)HALF * lda * 2, hstepB = (size_t)HALF * K * 2;
    const size_t tstepA = 2 * hstepA, tstepB = 2 * hstepB;
    const unsigned ldsw = (unsigned)wid * 1024u;
    const int aoff = lds_byte(wr * 64 + fr, fq * 8), boff = lds_byte(wc * 32 + fr, fq * 8);
#define PG8_SA(b, h) (((b) * 2 + (h)) * HTB)
#define PG8_SB(b, h) ((4 + (b) * 2 + (h)) * HTB)
#define PG8_STAGE(bufoff, gbase, voff) do { _Pragma("unroll") for (int _i = 0; _i < 2; ++_i) \
        __builtin_amdgcn_global_load_lds((const unsigned*)((const char*)(gbase) + (voff)[_i]), (LAS unsigned*)(lds + (bufoff) + ldsw + _i * 8192), 16, 0, 0); } while (0)
#define PG8_LDA(dst, b, h) do { _Pragma("unroll") for (int m = 0; m < 4; ++m) _Pragma("unroll") for (int k = 0; k < 2; ++k) dst[m][k] = *(const LAS f16x8*)(lds + PG8_SA(b, h) + aoff + m * 2048 + k * 1024); } while (0)
#define PG8_LDB(dst, b, h) do { _Pragma("unroll") for (int n = 0; n < 2; ++n) _Pragma("unroll") for (int k = 0; k < 2; ++k) dst[n][k] = *(const LAS f16x8*)(lds + PG8_SB(b, h) + boff + n * 2048 + k * 1024); } while (0)
#define PG8_MMA(ai, bj, At, Bt) do { __builtin_amdgcn_s_setprio(1); _Pragma("unroll") for (int m = 0; m < 4; ++m) _Pragma("unroll") for (int n = 0; n < 2; ++n) _Pragma("unroll") for (int k = 0; k < 2; ++k) \
        acc[ai][bj][m][n] = __builtin_amdgcn_mfma_f32_16x16x32_f16(Bt[n][k], At[m][k], acc[ai][bj][m][n], 0, 0, 0); __builtin_amdgcn_s_setprio(0); } while (0)
#define PG8_WAIT_V(n) asm volatile("s_waitcnt vmcnt(" #n ")" ::: "memory")
#define PG8_WAIT_L(n) asm volatile("s_waitcnt lgkmcnt(" #n ")" ::: "memory")
#define PG8_BAR __builtin_amdgcn_s_barrier()
#define PG8_SCHED __builtin_amdgcn_sched_barrier(0)
    Unit cur, nxt; int ui = 0;
    if (!S.next(0, cur)) return;
    f32x4 acc[2][2][4][2];
#pragma unroll
    for (int a = 0; a < 2; ++a)
#pragma unroll
        for (int b = 0; b < 2; ++b)
#pragma unroll
            for (int m = 0; m < 4; ++m)
#pragma unroll
                for (int n = 0; n < 2; ++n) acc[a][b][m][n] = (f32x4){0.f, 0.f, 0.f, 0.f};
    f16x8 At[4][2], B0[2][2], B1[2][2];
    const char* cA = (const char*)g.A + (size_t)cur.pm * tstepA; const char* cB = (const char*)g.Bt + (size_t)cur.pn * tstepB;
    if constexpr (SP2) {
        PG8_STAGE(PG8_SB(0, 0), cB, voffB); PG8_STAGE(PG8_SB(0, 1), cB + hstepB, voffB); PG8_STAGE(PG8_SA(0, 0), cA, voffA); PG8_STAGE(PG8_SA(0, 1), cA + hstepA, voffA);
        if (wr == 1) PG8_BAR;
        PG8_WAIT_V(2); PG8_BAR;
        PG8_STAGE(PG8_SB(1, 0), cB + kstep, voffB); PG8_STAGE(PG8_SA(1, 0), cA + kstep, voffA); PG8_STAGE(PG8_SB(1, 1), cB + hstepB + kstep, voffB);
        PG8_WAIT_V(6); PG8_BAR;
    } else {
        PG8_STAGE(PG8_SB(0, 0), cB, voffB); PG8_STAGE(PG8_SA(0, 0), cA, voffA); PG8_STAGE(PG8_SB(0, 1), cB + hstepB, voffB); PG8_STAGE(PG8_SA(0, 1), cA + hstepA, voffA);
        if (wr == 1) PG8_BAR;
        PG8_WAIT_V(4); PG8_BAR;
        PG8_STAGE(PG8_SB(1, 0), cB + kstep, voffB); PG8_STAGE(PG8_SA(1, 0), cA + kstep, voffA); PG8_STAGE(PG8_SB(1, 1), cB + hstepB + kstep, voffB);
        PG8_WAIT_V(6); PG8_BAR;
    }
    for (;;) {
        const bool has_next = S.next(ui + 1, nxt);
        const char* nA = has_next ? (const char*)g.A + (size_t)nxt.pm * tstepA : cA; const char* nB = has_next ? (const char*)g.Bt + (size_t)nxt.pn * tstepB : cB;
        for (int t = 0; t < nt; t += 2) {
            const bool last = (t == nt - 2);
            const char* a1 = cA + (size_t)(t + 1) * kstep;
            const char* a2 = last ? nA : cA + (size_t)(t + 2) * kstep; const char* b2 = last ? nB : cB + (size_t)(t + 2) * kstep;
            const char* a3 = a2 + kstep; const char* b3 = b2 + kstep;
            if constexpr (SP2) {
            PG8_LDB(B0, 0, 0); PG8_LDB(B1, 0, 1); PG8_SCHED; PG8_LDA(At, 0, 0); PG8_STAGE(PG8_SA(1, 1), a1 + hstepA, voffA);
            PG8_WAIT_V(8); PG8_WAIT_L(0); PG8_BAR; PG8_MMA(0, 0, At, B0); PG8_MMA(0, 1, At, B1); PG8_BAR; PG8_SCHED;
            PG8_LDA(At, 0, 1); PG8_STAGE(PG8_SB(0, 0), b2, voffB); PG8_STAGE(PG8_SB(0, 1), b2 + hstepB, voffB); PG8_STAGE(PG8_SA(0, 0), a2, voffA);
            PG8_WAIT_V(8); PG8_WAIT_L(0); PG8_BAR; PG8_MMA(1, 0, At, B0); PG8_MMA(1, 1, At, B1); PG8_BAR; PG8_SCHED;
            PG8_LDB(B0, 1, 0); PG8_LDB(B1, 1, 1); PG8_SCHED; PG8_LDA(At, 1, 0); PG8_STAGE(PG8_SA(0, 1), a2 + hstepA, voffA);
            PG8_WAIT_V(8); PG8_WAIT_L(0); PG8_BAR; PG8_MMA(0, 0, At, B0); PG8_MMA(0, 1, At, B1); PG8_BAR; PG8_SCHED;
            PG8_LDA(At, 1, 1); PG8_STAGE(PG8_SB(1, 0), b3, voffB); PG8_STAGE(PG8_SB(1, 1), b3 + hstepB, voffB); PG8_STAGE(PG8_SA(1, 0), a3, voffA);
            PG8_WAIT_V(8); PG8_WAIT_L(0); PG8_BAR; PG8_MMA(1, 0, At, B0); PG8_MMA(1, 1, At, B1); PG8_BAR; PG8_SCHED;
            } else {
            PG8_LDB(B0, 0, 0); PG8_SCHED; PG8_LDA(At, 0, 0); PG8_STAGE(PG8_SA(1, 1), a1 + hstepA, voffA);
            PG8_WAIT_L(8); PG8_BAR; PG8_WAIT_L(0); PG8_MMA(0, 0, At, B0); PG8_BAR; PG8_SCHED;
            PG8_LDB(B1, 0, 1); PG8_STAGE(PG8_SB(0, 0), b2, voffB);
            PG8_BAR; PG8_WAIT_L(0); PG8_MMA(0, 1, At, B1); PG8_BAR;
            PG8_LDA(At, 0, 1); PG8_STAGE(PG8_SA(0, 0), a2, voffA);
            PG8_BAR; PG8_WAIT_L(0); PG8_MMA(1, 0, At, B0); PG8_BAR; PG8_SCHED;
            PG8_STAGE(PG8_SB(0, 1), b2 + hstepB, voffB);
            PG8_WAIT_V(6); PG8_BAR; PG8_MMA(1, 1, At, B1); PG8_BAR;
            PG8_LDB(B0, 1, 0); PG8_SCHED; PG8_LDA(At, 1, 0); PG8_STAGE(PG8_SA(0, 1), a2 + hstepA, voffA);
            PG8_WAIT_L(8); PG8_BAR; PG8_WAIT_L(0); PG8_MMA(0, 0, At, B0); PG8_BAR; PG8_SCHED;
            PG8_LDB(B1, 1, 1); PG8_STAGE(PG8_SB(1, 0), b3, voffB);
            PG8_BAR; PG8_WAIT_L(0); PG8_MMA(0, 1, At, B1); PG8_BAR;
            PG8_LDA(At, 1, 1); PG8_STAGE(PG8_SA(1, 0), a3, voffA);
            PG8_BAR; PG8_WAIT_L(0); PG8_MMA(1, 0, At, B0); PG8_BAR; PG8_SCHED;
            PG8_STAGE(PG8_SB(1, 1), b3 + hstepB, voffB);
            PG8_WAIT_V(6); PG8_BAR; PG8_MMA(1, 1, At, B1); PG8_BAR;
            }
        }
        if constexpr (ALIGN_EPI) { if (wr == 0) PG8_BAR; }
        E(acc, cur, wr, wc, fr, fq);
        if (!has_next) break;
#pragma unroll
        for (int a = 0; a < 2; ++a)
#pragma unroll
            for (int b = 0; b < 2; ++b)
#pragma unroll
                for (int m = 0; m < 4; ++m)
#pragma unroll
                    for (int n = 0; n < 2; ++n) acc[a][b][m][n] = (f32x4){0.f, 0.f, 0.f, 0.f};
        cur = nxt; cA = nA; cB = nB; ++ui;
        if constexpr (ALIGN_EPI) { if (wr == 1) PG8_BAR; }
    }
    PG8_WAIT_V(0);
    if constexpr (!ALIGN_EPI) { if (wr == 0) PG8_BAR; }
    PG8_BAR;
#undef PG8_SA
#undef PG8_SB
#undef PG8_STAGE
#undef PG8_LDA
#undef PG8_LDB
#undef PG8_MMA
#undef PG8_WAIT_V
#undef PG8_WAIT_L
#undef PG8_BAR
#undef PG8_SCHED
}
}

__device__ __forceinline__ float wave_sum(float v) {
#pragma unroll
    for (int o = 1; o < 64; o <<= 1) v += __shfl_xor(v, o);
    return v;
}
__device__ __forceinline__ float silu_f(float x) { return x / (1.0f + __expf(-x)); }
__device__ __forceinline__ float sigmoid_f(float x) { return 1.0f / (1.0f + __expf(-x)); }
__device__ __forceinline__ unsigned pk2h(float lo, float hi) { return pg8::pk_f16(lo, hi); }


namespace att {
typedef float f32x16 __attribute__((ext_vector_type(16)));
typedef short s16x4 __attribute__((ext_vector_type(4)));
constexpr int L_B0 = 0, L_B1 = 8192, L_WSF = 16384, L_STG = 18432, L_OWN = 51200, L_CAR = 84992, L_VAL = 118784, L_SELM = 127232, L_UNI = 127488;
__device__ __forceinline__ int crow(int r, int hi) { return (r & 3) + 8 * (r >> 2) + 4 * hi; }
__device__ __forceinline__ float swapmax(float m) { auto rr = __builtin_amdgcn_permlane32_swap(__float_as_uint(m), __float_as_uint(m), false, false); return fmaxf(__uint_as_float(rr[0]), __uint_as_float(rr[1])); }
__device__ __forceinline__ float swapadd(float m) { auto rr = __builtin_amdgcn_permlane32_swap(__float_as_uint(m), __float_as_uint(m), false, false); return __uint_as_float(rr[0]) + __uint_as_float(rr[1]); }
__device__ __forceinline__ float ex2(float x) { return __builtin_amdgcn_exp2f(x); }
__device__ __forceinline__ void qkt(f32x16& p0, f32x16& p1, const LAS unsigned char* Kt, const f16x8 (&qr)[4], int r32, int hi) {
    const LAS unsigned char* kb = Kt + hi * 1024 + r32 * 16;
    p0 = (f32x16){}; p1 = (f32x16){};
#pragma unroll
    for (int d0 = 0; d0 < 4; ++d0) {
        const f16x8 b0 = *(const LAS f16x8*)(kb + d0 * 2048), b1 = *(const LAS f16x8*)(kb + d0 * 2048 + 512);
        p0 = __builtin_amdgcn_mfma_f32_32x32x16_f16(b0, qr[d0], p0, 0, 0, 0);
        p1 = __builtin_amdgcn_mfma_f32_32x32x16_f16(b1, qr[d0], p1, 0, 0, 0);
    }
}
__device__ __forceinline__ f16x8 pk8(const f32x16& p, int b) { f16x8 r;
#pragma unroll
    for (int j = 0; j < 8; ++j) r[j] = (f16)p[b + j];
    return r; }
__device__ __forceinline__ void pv(f32x16 (&o)[2], const LAS unsigned char* vb, const f16x8 (&pa)[4]) {
#pragma unroll
    for (int d0 = 0; d0 < 2; ++d0)
#pragma unroll
        for (int ks = 0; ks < 4; ++ks) {
            const s16x4 lo = __builtin_amdgcn_ds_read_tr16_b64_v4i16((LAS s16x4*)(vb + d0 * 4096 + ks * 1024));
            const s16x4 hh = __builtin_amdgcn_ds_read_tr16_b64_v4i16((LAS s16x4*)(vb + d0 * 4096 + ks * 1024 + 512));
            const f16x4 l4 = __builtin_bit_cast(f16x4, lo), h4 = __builtin_bit_cast(f16x4, hh);
            const f16x8 B = {l4[0], l4[1], l4[2], l4[3], h4[0], h4[1], h4[2], h4[3]};
            o[d0] = __builtin_amdgcn_mfma_f32_32x32x16_f16(pa[ks], B, o[d0], 0, 0, 0);
        }
}
__device__ __forceinline__ float rowmax(const f32x16& p0, const f32x16& p1) {
    float a = fmaxf(p0[0], p1[0]);
#pragma unroll
    for (int r = 1; r < 16; ++r) a = fmaxf(a, fmaxf(p0[r], p1[r]));
    return swapmax(a);
}
__device__ __forceinline__ void online(f32x16& p0, f32x16& p1, f32x16 (&o)[2], float& m, float& l, LAS float* wsf, int r32, int hi) {
    const float mn = fmaxf(m, rowmax(p0, p1));
    if (__any(mn > m)) {
        const float alpha = (mn == -INFINITY) ? 1.0f : ex2(m - mn);
        l *= alpha;
        if (hi == 0) wsf[r32] = alpha;
#pragma unroll
        for (int r = 0; r < 16; ++r) { const float a = (wsf + 4 * hi)[crow(r, 0)]; o[0][r] *= a; o[1][r] *= a; }
        m = mn;
    }
    const float mu = (m == -INFINITY) ? 0.0f : m;
    float s = 0.f;
#pragma unroll
    for (int r = 0; r < 16; ++r) { p0[r] = ex2(p0[r] - mu); p1[r] = ex2(p1[r] - mu); s += p0[r] + p1[r]; }
    l += s;
}
__device__ __forceinline__ void accum(f32x16 (&res)[2], const f32x16 (&o)[2], float fac, LAS float* wsf, int r32, int hi) {
    if (hi == 0) wsf[r32] = fac;
#pragma unroll
    for (int r = 0; r < 16; ++r) { const float a = (wsf + 4 * hi)[crow(r, 0)]; res[0][r] = fmaf(a, o[0][r], res[0][r]); res[1][r] = fmaf(a, o[1][r], res[1][r]); }
}

__device__ __forceinline__ void attn_unit(LAS unsigned char* lds, int b, int hk, int qb, const f16* Q, const f16* KVb, const f16* KCMP, const float* Gt, f16* ATT, int tid) {
    const int lane = tid & 63, wave = __builtin_amdgcn_readfirstlane(tid >> 6), r32 = lane & 31, hi = lane >> 5;
    const int g = wave >> 1, qh = wave & 1, h = hk * 4 + g;
    const int tl = 32 * qh + r32, tq = 64 * qb + tl; const size_t mq = (size_t)b * SEQ + tq;
    LAS unsigned char* B0 = lds + L_B0; LAS unsigned char* B1 = lds + L_B1;
    LAS float* wsf = (LAS float*)(lds + L_WSF + wave * 256);
    LAS float* ownl = (LAS float*)(lds + L_OWN); LAS float* carl = (LAS float*)(lds + L_CAR); LAS float* vall = (LAS float*)(lds + L_VAL);
    LAS unsigned* selm = (LAS unsigned*)(lds + L_SELM); LAS unsigned* unim = (LAS unsigned*)(lds + L_UNI);
    const int stoff = wave * 1024 + lane * 16;
    const int kcol = 8 * wave, vrow = 16 * (wave & 3) + (lane >> 2), vcol = 32 * (wave >> 2) + 8 * (lane & 3);
    const LAS unsigned char* vb0 = B0 + ((lane >> 4) & 1) * 32 + (lane & 3) * 8 + (4 * hi + ((lane & 15) >> 2)) * 64;
    const LAS unsigned char* vb1 = vb0 + 8192;
    f16x8 qr[4];
#pragma unroll
    for (int d0 = 0; d0 < 4; ++d0) qr[d0] = *(const f16x8*)(Q + mq * 512 + h * 64 + d0 * 16 + hi * 8);
    f32x16 res[2]; res[0] = (f32x16){}; res[1] = (f32x16){};
    const f16* kc = KCMP + (((size_t)0 * 16 + b) * 2 + hk) * 128 * 64; const f16* vc = KCMP + (((size_t)1 * 16 + b) * 2 + hk) * 128 * 64;
    {
        const f16x8 k0 = *(const f16x8*)(kc + (size_t)lane * 64 + kcol), k1 = *(const f16x8*)(kc + (size_t)(64 + lane) * 64 + kcol);
        __syncthreads();
        *(LAS f16x8*)(B0 + stoff) = k0; *(LAS f16x8*)(B1 + stoff) = k1;
        if (tid < 64) selm[tid] = 0u; if (tid == 64) unim[0] = 0u;
        __syncthreads();
        f32x16 a0, a1, b0, b1;
        qkt(a0, a1, B0, qr, r32, hi); qkt(b0, b1, B1, qr, r32, hi);
        const int nvalid = (tq >= 31) ? (((tq - 31) >> 4) + 1) : 0;
#pragma unroll
        for (int r = 0; r < 16; ++r) { const int kk = crow(r, 0); const int thr = nvalid - 4 * hi;
            a0[r] = (kk >= thr) ? -INFINITY : a0[r]; a1[r] = (kk + 32 >= thr) ? -INFINITY : a1[r]; b0[r] = (kk + 64 >= thr) ? -INFINITY : b0[r]; b1[r] = (kk + 96 >= thr) ? -INFINITY : b1[r]; }
        const float mx = fmaxf(rowmax(a0, a1), rowmax(b0, b1)); const float mu = (mx == -INFINITY) ? 0.0f : mx;
        float sum = 0.f;
#pragma unroll
        for (int r = 0; r < 16; ++r) { a0[r] = ex2(a0[r] - mu); a1[r] = ex2(a1[r] - mu); b0[r] = ex2(b0[r] - mu); b1[r] = ex2(b1[r] - mu); sum += (a0[r] + a1[r]) + (b0[r] + b1[r]); }
        sum = swapadd(sum);
        const float inv = (sum > 0.f) ? 1.0f / sum : 0.f;
        {
            LAS float* op = ownl + (g * 64 + tl) * 33 + hi; LAS float* cp = carl + (g * 64 + tl) * 33 + hi;
#pragma unroll
            for (int X = 0; X < 4; ++X)
#pragma unroll
                for (int a = 0; a < 4; ++a) { const f32x16& P = (X == 0) ? a0 : (X == 1) ? a1 : (X == 2) ? b0 : b1;
                    const int j0 = 8 * X + 2 * a;
                    op[j0] = ((P[4 * a] + P[4 * a + 1]) + (P[4 * a + 2] + P[4 * a + 3])) * inv;
                    if (j0 + 1 < 31) cp[j0 + 1] = P[4 * a + 3] * inv; else if (hi == 0) cp[j0 + 1] = P[4 * a + 3] * inv; }
        }
        f16x8 paA[4], paB[4];
        paA[0] = pk8(a0, 0); paA[1] = pk8(a0, 8); paA[2] = pk8(a1, 0); paA[3] = pk8(a1, 8);
        paB[0] = pk8(b0, 0); paB[1] = pk8(b0, 8); paB[2] = pk8(b1, 0); paB[3] = pk8(b1, 8);
        __syncthreads();
        { const f16x8 v0 = *(const f16x8*)(vc + (size_t)vrow * 64 + vcol), v1 = *(const f16x8*)(vc + (size_t)(64 + vrow) * 64 + vcol);
          *(LAS f16x8*)(B0 + stoff) = v0; *(LAS f16x8*)(B1 + stoff) = v1; }
        {
            const int q = tid & 63, jq = tid >> 6;
#pragma unroll
            for (int i = 0; i < 4; ++i) { const int j = jq + 8 * i; float v = 0.f;
#pragma unroll
                for (int gg = 0; gg < 4; ++gg) v += ownl[(gg * 64 + q) * 33 + j] + ((j > 0) ? carl[(gg * 64 + q) * 33 + j] : 0.f);
                if (j > qb) v = -INFINITY; else if (j == 0 || j == qb || j == qb - 1) v = INFINITY;
                vall[q * 33 + j] = v; }
        }
        __syncthreads();
        {
            const int q = tid & 63, jq = tid >> 6; float vx[4]; int rk[4];
#pragma unroll
            for (int i = 0; i < 4; ++i) { vx[i] = vall[q * 33 + jq + 8 * i]; rk[i] = 0; }
            for (int i2 = 0; i2 < 32; ++i2) { const float vi = vall[q * 33 + i2];
#pragma unroll
                for (int i = 0; i < 4; ++i) rk[i] += ((vi > vx[i]) || (vi == vx[i] && i2 < jq + 8 * i)) ? 1 : 0; }
            unsigned bits = 0u;
#pragma unroll
            for (int i = 0; i < 4; ++i) if (rk[i] < 8 && vx[i] > -INFINITY) bits |= 1u << (jq + 8 * i);
            if (bits) { __hip_atomic_fetch_or(selm + q, bits, __ATOMIC_RELAXED, __HIP_MEMORY_SCOPE_WORKGROUP); __hip_atomic_fetch_or(unim, bits, __ATOMIC_RELAXED, __HIP_MEMORY_SCOPE_WORKGROUP); }
        }
        f32x16 o[2]; o[0] = (f32x16){}; o[1] = (f32x16){};
        pv(o, vb0, paA); pv(o, vb1, paB);
        accum(res, o, Gt[mq * 32 + h * 3 + 0] * inv, wsf, r32, hi);
        __syncthreads();
    }
    const unsigned mysel = selm[tl]; const unsigned uni = unim[0];
#pragma unroll 1
    for (int br = 0; br < 2; ++br) {
        const f16* Kg = KVb + (size_t)(2 + 2 * br) * (KV_STRIDE / 2) + (size_t)b * SEQ * 128 + hk * 64;
        const f16* Vg = KVb + (size_t)(3 + 2 * br) * (KV_STRIDE / 2) + (size_t)b * SEQ * 128 + hk * 64;
        const unsigned lo_bits = (qb >= 8) ? ~((1u << (qb - 8)) - 1u) : 0xFFFFFFFFu;
        const unsigned upto = (qb == 31) ? 0xFFFFFFFFu : ((2u << qb) - 1u);
        unsigned todo = (br == 0) ? (uni & upto) : (upto & lo_bits);
        float m = -INFINITY, l = 0.f; f32x16 o[2]; o[0] = (f32x16){}; o[1] = (f32x16){};
        int j = __builtin_ctz(todo); todo &= todo - 1u;
        f16x8 kr = *(const f16x8*)(Kg + (size_t)(64 * j + lane) * 128 + kcol), vr = *(const f16x8*)(Vg + (size_t)(64 * j + vrow) * 128 + vcol);
#pragma unroll 1
        for (;;) {
            __syncthreads();
            *(LAS f16x8*)(B0 + stoff) = kr; *(LAS f16x8*)(B1 + stoff) = vr;
            __syncthreads();
            const int jn = todo ? __builtin_ctz(todo) : -1; todo &= todo - 1u;
            if (jn >= 0) { kr = *(const f16x8*)(Kg + (size_t)(64 * jn + lane) * 128 + kcol); vr = *(const f16x8*)(Vg + (size_t)(64 * jn + vrow) * 128 + vcol); }
            const bool mine = (br == 0) ? (((mysel >> j) & 1u) != 0u) : true;
            if (__any(mine)) {
                f32x16 p0, p1; qkt(p0, p1, B0, qr, r32, hi);
#pragma unroll
                for (int r = 0; r < 16; ++r) { p0[r] = mine ? p0[r] : -INFINITY; p1[r] = mine ? p1[r] : -INFINITY; }
                if (j == qb) {
#pragma unroll
                    for (int r = 0; r < 16; ++r) { const int ki = crow(r, 0); const int tlh = tl - 4 * hi; p0[r] = (ki > tlh) ? -INFINITY : p0[r]; p1[r] = (ki + 32 > tlh) ? -INFINITY : p1[r]; }
                }
                if (br == 1 && j == qb - 8) {
#pragma unroll
                    for (int r = 0; r < 16; ++r) { const int ki = crow(r, 0); const int tlh = tl - 4 * hi; p0[r] = (ki <= tlh) ? -INFINITY : p0[r]; p1[r] = (ki + 32 <= tlh) ? -INFINITY : p1[r]; }
                }
                online(p0, p1, o, m, l, wsf, r32, hi);
                f16x8 pa[4]; pa[0] = pk8(p0, 0); pa[1] = pk8(p0, 8); pa[2] = pk8(p1, 0); pa[3] = pk8(p1, 8);
                pv(o, vb1, pa);
            }
            if (jn < 0) break;
            j = jn;
        }
        const float lt = swapadd(l);
        accum(res, o, Gt[mq * 32 + h * 3 + 1 + br] / fmaxf(lt, 1e-30f), wsf, r32, hi);
    }
    {
        LAS f16* stg = (LAS f16*)(lds + L_STG + wave * 4096);
        LAS f16* stw = stg + 4 * hi * 64 + r32;
#pragma unroll
        for (int r = 0; r < 16; ++r) { const int orow = crow(r, 0); stw[orow * 64] = (f16)res[0][r]; stw[orow * 64 + 32] = (f16)res[1][r]; }
        f16* Ow = ATT + ((size_t)b * SEQ + 64 * qb + 32 * qh) * 512 + h * 64;
#pragma unroll
        for (int i = 0; i < 4; ++i) { const int row = i * 8 + (lane >> 3), ch = lane & 7; const u32x4 v = *(const LAS u32x4*)(stg + row * 64 + ch * 8); *(u32x4*)(Ow + (size_t)row * 512 + ch * 8) = v; }
    }
}
}

struct Args {
    const float* x; const float* c; const int* pos; const float* w_mod; const float* b_mod; const float* norm1_g; const float* w_in;
    const float* pe_k; const float* w1_k; const float* w2_k; const float* pe_v; const float* w1_v; const float* w2_v;
    const float* conv_w; const float* g_attn; const float* g_conv; const float* w_out; const float* norm2_g;
    const float* ffn_up; const float* ffn_conv; const float* ffn_down; const float* final_g;
    float* out; unsigned char* ws; int ph_lo, ph_hi;
};

__device__ __forceinline__ int hperm(int j) { return (j < 4 || j >= 12) ? j : (j < 8 ? j + 4 : j - 4); }
__device__ __forceinline__ int win_colmap(int n) {
    if (n < 512) return (n & ~63) | hperm(n & 63);
    if (n < 1280) { const int r = n - 512; return ((r & 128) == 0) ? 512 + ((r & ~63) | hperm(r & 63)) : n; }
    if (n < 1792) return 1304 + (n - 1280);
    if (n < 2816) { const int r = n - 1792, i = r >> 3, e = r & 7; return (e < 4) ? 1816 + 4 * i + e : 2328 + 4 * i + (e - 4); }
    if (n < 2840) return 1280 + (n - 2816);
    return -1;
}
__device__ __forceinline__ void transpose_item(const float* W, int K, int Nsrc, int Ndst, f16* WT, LAS float* scr, int item, int lane, int colmode = 0, int kmode = 0) {
    const int nblk = Ndst / 32, kb = item / nblk, nb = item % nblk, k0 = 64 * kb, n0 = 32 * nb;
    const int nd = n0 + (lane & 31);
    const int sc = (colmode == 1) ? win_colmap(nd) : (colmode == 2) ? ((nd & ~63) | hperm(nd & 63)) : ((nd < Nsrc) ? nd : -1);
#pragma unroll 8
    for (int i = 0; i < 32; ++i) { const int kk = 2 * i + (lane >> 5); const int ks = (kmode == 1) ? hperm(kk) : kk;
        scr[kk * 33 + (lane & 31)] = (sc >= 0) ? W[(size_t)(k0 + ks) * Nsrc + sc] : 0.f; }
    asm volatile("s_waitcnt lgkmcnt(0)" ::: "memory");
    const int c = lane & 7;
#pragma unroll
    for (int j = 0; j < 4; ++j) { const int n = (lane >> 3) + 8 * j; const LAS float* s = scr + (8 * c) * 33 + n;
        u32x4 o; o.x = pk2h(s[0 * 33], s[1 * 33]); o.y = pk2h(s[2 * 33], s[3 * 33]); o.z = pk2h(s[4 * 33], s[5 * 33]); o.w = pk2h(s[6 * 33], s[7 * 33]);
        *(u32x4*)(WT + (size_t)(n0 + n) * K + k0 + 8 * c) = o; }
    asm volatile("s_waitcnt lgkmcnt(0)" ::: "memory");
}

__device__ __forceinline__ void sincos_d(double a, float& s, float& c) {
    const double k = rint(a * 0.63661977236758134308);
    double r = fma(-k, 1.57079632679489655800e+00, a); r = fma(-k, 6.12323399573676603587e-17, r);
    const double r2 = r * r;
    double sp = -1.0 / 1307674368000.0;
    sp = fma(sp, r2, 1.0 / 6227020800.0);
    sp = fma(sp, r2, -1.0 / 39916800.0);
    sp = fma(sp, r2, 1.0 / 362880.0);
    sp = fma(sp, r2, -1.0 / 5040.0);
    sp = fma(sp, r2, 1.0 / 120.0);
    sp = fma(sp, r2, -1.0 / 6.0);
    const double sn = fma(sp * r2, r, r);
    double cp = 1.0 / 20922789888000.0;
    cp = fma(cp, r2, -1.0 / 87178291200.0);
    cp = fma(cp, r2, 1.0 / 479001600.0);
    cp = fma(cp, r2, -1.0 / 3628800.0);
    cp = fma(cp, r2, 1.0 / 40320.0);
    cp = fma(cp, r2, -1.0 / 720.0);
    cp = fma(cp, r2, 1.0 / 24.0);
    cp = fma(cp, r2, -0.5);
    const double cs = fma(cp, r2, 1.0);
    const int q = ((int)k) & 3;
    const double ss = (q == 0) ? sn : (q == 1) ? cs : (q == 2) ? -sn : -cs;
    const double cc = (q == 0) ? cs : (q == 1) ? -sn : (q == 2) ? -cs : sn;
    s = (float)ss; c = (float)cc;
}


#define XB_TMO      128
#define XB_XCNT(j)  (256  + 64 * (j))
#define XB_XSUB(j)  (1280 + 64 * (j))
#define XB_XGEN(j)  (2304 + 64 * (j))
#define XB_TOP      3328
#define XB_TOPGEN   3392
#define XCD_BAR_WORDS 3456
#define XB_SPIN_CAP (1u << 22)
__device__ __forceinline__ unsigned xb_ld(unsigned* p)              { return __hip_atomic_load(p, __ATOMIC_RELAXED, __HIP_MEMORY_SCOPE_AGENT); }
__device__ __forceinline__ unsigned xb_add(unsigned* p, unsigned v) { return __hip_atomic_fetch_add(p, v, __ATOMIC_RELAXED, __HIP_MEMORY_SCOPE_AGENT); }
__device__ __forceinline__ unsigned xb_xcc_id() { return (unsigned)__builtin_amdgcn_s_getreg((3 << 11) | 20) & 0xFu; }
#define XB_SPIN(cond, bar) do { unsigned _sp = 0; while (cond) { __builtin_amdgcn_s_sleep(1); \
    if ((++_sp & 255u) == 0u) { if (xb_ld(&(bar)[XB_TMO])) break; if (_sp > XB_SPIN_CAP) { atomicAdd(&(bar)[XB_TMO], 1u); break; } } } } while (0)
struct XcdBarrier { unsigned* bar; unsigned x; volatile LAS unsigned* st; };
__device__ __forceinline__ XcdBarrier xcd_barrier_post(unsigned* bar, volatile LAS unsigned* st) {
    XcdBarrier b; b.bar = bar; b.x = xb_xcc_id(); b.st = st;
    if (threadIdx.x == 0) (void)xb_add(&bar[XB_XCNT(b.x)], 1u);
    return b;
}
__device__ __forceinline__ void xcd_barrier_complete(unsigned* bar, unsigned x, unsigned& nloc, unsigned& nx) {
    const unsigned G = gridDim.x * gridDim.y * gridDim.z;
    unsigned sum, cnt, mine, sp = 0u;
    for (;;) {
        sum = 0u; cnt = 0u; mine = 0u;
#pragma unroll
        for (unsigned j = 0; j < 16; ++j) { const unsigned c = xb_ld(&bar[XB_XCNT(j)]); sum += c; cnt += (c > 0u) ? 1u : 0u; mine = (j == x) ? c : mine; }
        if (sum == G) break;
        __builtin_amdgcn_s_sleep(1);
        if ((++sp & 255u) == 0u) { if (xb_ld(&bar[XB_TMO])) break; if (sp > XB_SPIN_CAP) { atomicAdd(&bar[XB_TMO], 1u); break; } }
    }
    nloc = mine > 0u ? mine : 1u; nx = cnt > 0u ? cnt : 1u;
}
__device__ __forceinline__ void xcd_barrier(const XcdBarrier& b) {
    asm volatile("s_waitcnt vmcnt(0)" ::: "memory");
    __syncthreads();
    if (threadIdx.x == 0) {
        unsigned* bar = b.bar;
        __builtin_amdgcn_s_waitcnt(0);
        unsigned nloc = b.st[0], nx = b.st[1];
        if (nloc == 0u) { xcd_barrier_complete(bar, b.x, nloc, nx); b.st[0] = nloc; b.st[1] = nx; }
        const unsigned old = xb_add(&bar[XB_XSUB(b.x)], 1u);
        const unsigned gen = old / nloc;
        if (old + 1u == (gen + 1u) * nloc) {
            __builtin_amdgcn_fence(__ATOMIC_RELEASE, "agent");
            asm volatile("s_waitcnt vmcnt(0)" ::: "memory");
            const unsigned og = xb_add(&bar[XB_TOP], 1u);
            const unsigned tg = og / nx;
            if (og + 1u == (tg + 1u) * nx) xb_add(&bar[XB_TOPGEN], 1u);
            else XB_SPIN(xb_ld(&bar[XB_TOPGEN]) == tg, bar);
            __builtin_amdgcn_fence(__ATOMIC_ACQUIRE, "agent");
            xb_add(&bar[XB_XGEN(b.x)], 1u);
            asm volatile("s_waitcnt vmcnt(0)" ::: "memory");
        } else {
            XB_SPIN(xb_ld(&bar[XB_XGEN(b.x)]) == gen, bar);
            __builtin_amdgcn_fence(__ATOMIC_ACQUIRE, "agent");
            asm volatile("s_waitcnt vmcnt(0)" ::: "memory");
        }
    }
    __syncthreads();
}

template <int ph>
__device__ __forceinline__ void run_phase(LAS unsigned char* lds, const Args& A) {
    {
        int tid = threadIdx.x; asm volatile("" : "+v"(tid));
        const int lane = tid & 63, wave = __builtin_amdgcn_readfirstlane(tid >> 6);
        int G = gridDim.x, bx = blockIdx.x; asm volatile("" : "+s"(G), "+s"(bx));
        const int gw = bx * NWAVES + wave, NGW = G * NWAVES;
        const int gt = bx * NTHREADS + tid, NGT = G * NTHREADS;
        unsigned char* ws = A.ws;
        float* MOD = (float*)(ws + WS_MOD);
        float* ROPE = (float*)(ws + WS_ROPE);
        f16* HALO = (f16*)(ws + WS_HALO);
        f16* Hb = (f16*)(ws + WS_H);
        f16* KCMP = (f16*)(ws + WS_KCMP);
        float* Gt = (float*)(ws + WS_G);
        unsigned* SEL = (unsigned*)(ws + WS_SEL);
        f16* U = (f16*)(ws + WS_U);
        f16* PROJ = (f16*)(ws + WS_PROJ);
        float* IMP = (float*)(ws + WS_IMP);
        float* OC = (float*)(ws + WS_OC);
        f16* ATT = (f16*)(ws + WS_ATT);
        f16* MIX = (f16*)(ws + WS_MIX);
        f16* Qb = (f16*)(ws + WS_Q);
        f16* KVb = (f16*)(ws + WS_KV);
        f16* CBb = (f16*)(ws + WS_CB);
        f16* Pb = (f16*)(ws + WS_P);
        float* SUMb = (float*)(ws + WS_SUM);
        constexpr int l = (ph >= 1 && ph < 21) ? (ph - 1) / 10 : 0;
        constexpr int k = (ph >= 1 && ph < 21) ? (ph - 1) % 10 : (ph == 0 ? 100 : 101);
        unsigned char* wl = ws + WS_W + (size_t)l * W_LAYER;
        f16* Win_t = (f16*)(wl + W_IN_OFF); f16* Wout_t = (f16*)(wl + W_OUT_OFF); f16* Wup_t = (f16*)(wl + W_UP_OFF); f16* Wdown_t = (f16*)(wl + W_DOWN_OFF);
        const float* modl = MOD + (size_t)l * 16 * 6144;

        if (PH_EN(14) && k == 100) {
            {
                LAS float* scr = (LAS float*)(lds + wave * 16384);
                constexpr int I_IN = 16 * (NINP / 32), I_OUT = 16 * 32, I_UP = 16 * (NUP / 32), I_DN = (DFF / 64) * 32, I_L = I_IN + I_OUT + I_UP + I_DN;
                for (int it = gw; it < 2 * I_L; it += NGW) {
                    const int ll = it / I_L; int r = it % I_L;
                    unsigned char* wll = ws + WS_W + (size_t)ll * W_LAYER;
                    if (r < I_IN) { transpose_item(A.w_in + (size_t)ll * DM * NIN, DM, NIN, NINP, (f16*)(wll + W_IN_OFF), scr, r, lane, 1, 0); continue; } r -= I_IN;
                    if (r < I_OUT) { transpose_item(A.w_out + (size_t)ll * DM * DM, DM, DM, DM, (f16*)(wll + W_OUT_OFF), scr, r, lane); continue; } r -= I_OUT;
                    if (r < I_UP) { transpose_item(A.ffn_up + (size_t)ll * DM * NUP, DM, NUP, NUP, (f16*)(wll + W_UP_OFF), scr, r, lane); continue; } r -= I_UP;
                    transpose_item(A.ffn_down + (size_t)ll * DFF * DM, DFF, DM, DM, (f16*)(wll + W_DOWN_OFF), scr, r, lane);
                }
                for (int it = gw; it < 4 * 128 + 4 * 4; it += NGW) {
                    if (it < 512) { const int mi = it >> 7, ll = mi >> 1, kv = mi & 1;
                        transpose_item((kv ? A.w1_v : A.w1_k) + (size_t)ll * 2048 * 128, 2048, 128, 128, (f16*)(ws + WS_W1T) + (size_t)mi * 128 * 2048, scr, it & 127, lane, 0, kv == 0 ? 1 : 0); }
                    else { const int r = it - 512, mi = r >> 2, ll = mi >> 1, kv = mi & 1;
                        transpose_item((kv ? A.w2_v : A.w2_k) + (size_t)ll * 128 * 64, 128, 64, 64, (f16*)(ws + WS_W2T) + (size_t)mi * 64 * 128, scr, r & 3, lane, kv == 0 ? 2 : 0, 0); }
                }
            }
            __syncthreads();
            for (int it = gt; it < MTOK * 8; it += NGT) {
                const int m = it >> 3, i = it & 7;
                const double fr = (i == 0) ? 1.0 : (i == 1) ? 0.19392274474868576 : (i == 2) ? 0.03760603093086393 : (i == 3) ? 0.007292664737217109 :
                                  (i == 4) ? 0.001414213562373095 : (i == 5) ? 0.0002742481756762073 : (i == 6) ? 5.318295896944988e-05 : 1.031338537721246e-05;
                float s, c; sincos_d((double)A.pos[m] * fr, s, c);
                ROPE[(size_t)m * 16 + i] = c; ROPE[(size_t)m * 16 + 8 + i] = s;
            }
            {
                LAS float* red = (LAS float*)(lds + 65536);
                for (int it = G - 1 - bx; it < 8; it += G) {
                    const int mi = it >> 1, ll = mi >> 1, kv = mi & 1, n0 = (it & 1) * 64;
                    const float* pe = (kv ? A.pe_v : A.pe_k) + (size_t)ll * 2048; const float* w1 = (kv ? A.w1_v : A.w1_k) + (size_t)ll * 2048 * 128 + n0 + lane;
                    float acc = 0.f;
                    for (int ld = wave * 256; ld < wave * 256 + 256; ld += 8) {
                        float w[8];
#pragma unroll
                        for (int u = 0; u < 8; ++u) w[u] = w1[(size_t)(ld + u) * 128];
#pragma unroll
                        for (int u = 0; u < 8; ++u) acc = fmaf(pe[ld + u], w[u], acc);
                    }
                    __syncthreads();
                    red[wave * 64 + lane] = acc;
                    __syncthreads();
                    if (tid < 64) { float sacc = 0.f;
#pragma unroll
                        for (int w8 = 0; w8 < 8; ++w8) sacc += red[w8 * 64 + tid];
                        ((float*)(ws + WS_BPE))[mi * 128 + n0 + tid] = sacc; }
                }
                __syncthreads();
            }
            {
                LAS float* ca = (LAS float*)lds;
                LAS float* red = (LAS float*)(lds + 65536);
                bool staged = false;
                for (int it = bx; it < 2 * 96; it += G) {
                    if (!staged) { for (int i = tid; i < 16 * 1024; i += NTHREADS) ca[i] = silu_f(A.c[i]); staged = true; }
                    __syncthreads();
                    const int ll = it / 96, n0 = (it % 96) * 64;
                    const float* wm = A.w_mod + (size_t)ll * DM * 6144 + n0 + lane;
                    float acc[16];
#pragma unroll
                    for (int b = 0; b < 16; ++b) acc[b] = 0.f;
                    for (int kk = wave * 128; kk < wave * 128 + 128; kk += 8) {
                        float w[8];
#pragma unroll
                        for (int u = 0; u < 8; ++u) w[u] = wm[(size_t)(kk + u) * 6144];
#pragma unroll
                        for (int u = 0; u < 8; ++u)
#pragma unroll
                            for (int b = 0; b < 16; ++b) acc[b] = fmaf(ca[b * 1024 + kk + u], w[u], acc[b]);
                    }
#pragma unroll
                    for (int b = 0; b < 16; ++b) red[(wave * 16 + b) * 64 + lane] = acc[b];
                    __syncthreads();
                    for (int o = tid; o < 1024; o += NTHREADS) { const int b = o >> 6, n = o & 63; float s = 0.f;
#pragma unroll
                        for (int w8 = 0; w8 < 8; ++w8) s += red[(w8 * 16 + b) * 64 + n];
                        MOD[((size_t)ll * 16 + b) * 6144 + n0 + n] = s + A.b_mod[(size_t)ll * 6144 + n0 + n]; }
                    __syncthreads();
                }
            }
        } else if (PH_EN(0) && (k == 0 || k == 6)) {
            const float* xin = (k == 0 && l == 0) ? A.x : A.out;
            const float* gain = (k == 0 ? A.norm1_g : A.norm2_g) + (size_t)l * DM;
            const float* shp = modl + (k == 0 ? 0 : 3) * 1024; const float* scp = modl + (k == 0 ? 1 : 4) * 1024;
            for (int m = gw; m < MTOK; m += NGW) {
                const int b = m >> 11;
                const f32x4* xr = (const f32x4*)(xin + (size_t)m * DM) + lane;
                f32x4 v[4]; float s = 0.f;
#pragma unroll
                for (int j = 0; j < 4; ++j) { v[j] = xr[64 * j]; s += (v[j].x * v[j].x + v[j].y * v[j].y) + (v[j].z * v[j].z + v[j].w * v[j].w); }
                const float r = 1.0f / sqrtf(wave_sum(s) * (1.0f / DM) + 1e-6f);
#pragma unroll
                for (int j = 0; j < 4; ++j) { const int col = 4 * lane + 256 * j;
                    const f32x4 g4 = *(const f32x4*)(gain + col), sc4 = *(const f32x4*)(scp + (size_t)b * 6144 + col), sh4 = *(const f32x4*)(shp + (size_t)b * 6144 + col);
                    const f32x4 o = (v[j] * r) * g4 * (sc4 + 1.0f) + sh4;
                    u32x2 w; w.x = pk2h(o.x, o.y); w.y = pk2h(o.z, o.w);
                    *(u32x2*)(Hb + (size_t)m * DM + col) = w; }
            }
        } else if (PH_EN(1) && (k == 1 || k == 7)) {
            if (k == 1) {
                const pg8::Gemm g{Hb, Win_t, MTOK, NINP, DM, DM}; const pg8::EpiIn E{Qb, KVb, CBb, Pb, Gt, ROPE};
                pg8::StaticOrder S; S.init(g.M, g.N, G, bx);
                pg8::gemm_phase<pg8::EpiIn, pg8::StaticOrder, true, true>(lds, g, S, E, tid);
            } else {
                const pg8::Gemm g{Hb, Wup_t, MTOK, NUP, DM, DM}; const pg8::EpiF16 E{U, NUP, HALO};
                pg8::StaticOrder S; S.init(g.M, g.N, G, bx);
                pg8::gemm_phase<pg8::EpiF16, pg8::StaticOrder, true, true>(lds, g, S, E, tid);
            }
        } else if (PH_EN(8) && (k == 5 || k == 9)) {
            pg8::Gemm g; pg8::EpiResid E;
            if (k == 5) { g = pg8::Gemm{MIX, Wout_t, MTOK, DM, DM, DM}; E = pg8::EpiResid{(l == 0) ? A.x : A.out, A.out, modl + 2 * 1024}; }
            else { g = pg8::Gemm{U, Wdown_t, MTOK, DM, DFF, NUP}; E = pg8::EpiResid{A.out, A.out, modl + 5 * 1024}; }
            pg8::StaticOrder S; S.init(g.M, g.N, G, bx);
            pg8::gemm_phase<pg8::EpiResid, pg8::StaticOrder, true, true>(lds, g, S, E, tid);
        } else if (PH_EN(3) && k == 2) {
            typedef float f32x4v __attribute__((ext_vector_type(4)));
            constexpr int HS = 136;
            LAS f16* hid = (LAS f16*)lds;
            for (int it = bx; it < 256; it += G) {
                const int grp = it >> 2, j0 = 32 * (it & 3), kv = grp >> 5, b = (grp >> 1) & 15, hk = grp & 1;
                const int rt = wave >> 2, cg4 = wave & 3, fr = lane & 15, fq = lane >> 4;
                const f16* src = KVb + (size_t)kv * (KV_STRIDE / 2) + (size_t)b * SEQ * 128 + hk * 64 + 8 * fq;
                const int jrow = j0 + 16 * rt + fr;
                const f16* w1t = (const f16*)(ws + WS_W1T) + (size_t)(l * 2 + kv) * 128 * 2048 + (size_t)(32 * cg4 + fr) * 2048 + 8 * fq;
                f32x4v acc0 = {0.f, 0.f, 0.f, 0.f}, acc1 = {0.f, 0.f, 0.f, 0.f};
#pragma unroll 8
                for (int kk = 0; kk < 64; ++kk) {
                    const int tok = min(16 * jrow + (kk >> 1), SEQ - 1);
                    const f16x8 a = *(const f16x8*)(src + (size_t)tok * 128 + 32 * (kk & 1));
                    const f16x8 b0 = *(const f16x8*)(w1t + 32 * kk), b1 = *(const f16x8*)(w1t + 16 * 2048 + 32 * kk);
                    acc0 = __builtin_amdgcn_mfma_f32_16x16x32_f16(a, b0, acc0, 0, 0, 0);
                    acc1 = __builtin_amdgcn_mfma_f32_16x16x32_f16(a, b1, acc1, 0, 0, 0);
                }
                const float* bpe = (const float*)(ws + WS_BPE) + (l * 2 + kv) * 128 + 32 * cg4 + fr;
                const float bp0 = bpe[0], bp1 = bpe[16];
                __syncthreads();
#pragma unroll
                for (int r = 0; r < 4; ++r) { const int row = 16 * rt + 4 * fq + r;
                    hid[row * HS + 32 * cg4 + fr] = (f16)silu_f(acc0[r] + bp0); hid[row * HS + 32 * cg4 + 16 + fr] = (f16)silu_f(acc1[r] + bp1); }
                __syncthreads();
                const f16* w2t = (const f16*)(ws + WS_W2T) + (size_t)(l * 2 + kv) * 64 * 128 + (size_t)(16 * cg4 + fr) * 128 + 8 * fq;
                f32x4v o = {0.f, 0.f, 0.f, 0.f};
#pragma unroll
                for (int ks = 0; ks < 4; ++ks) {
                    const f16x8 a = *(const LAS f16x8*)(hid + (16 * rt + fr) * HS + 32 * ks + 8 * fq);
                    const f16x8 bb = *(const f16x8*)(w2t + 32 * ks);
                    o = __builtin_amdgcn_mfma_f32_16x16x32_f16(a, bb, o, 0, 0, 0);
                }
#pragma unroll
                for (int r = 0; r < 4; ++r) { const int jj = j0 + 16 * rt + 4 * fq + r;
                    KCMP[(((size_t)kv * 16 + b) * 2 + hk) * 128 * 64 + (size_t)jj * 64 + 16 * cg4 + fr] = (jj < 127) ? (f16)o[r] : (f16)0.f; }
            }
        } else if (PH_EN(4) && k == 3) {
            for (int it = bx; it < 1024; it += G) {
                const int i4 = it >> 8, c = it & 255, vcu = (c & 7) * 32 + (c >> 3), bh = vcu >> 3, sq = vcu & 7;
                const int qb = (i4 == 0) ? sq : (i4 == 1) ? 15 - sq : (i4 == 2) ? 16 + sq : 31 - sq;
                int tidu = tid; asm volatile("" : "+v"(tidu));
                att::attn_unit(lds, bh >> 1, bh & 1, qb, Qb, KVb, KCMP, Gt, ATT, tidu);
            }
        } else if (PH_EN(7) && k == 4) {
            const float* ga = A.g_attn + (size_t)l * 512; const float* gc = A.g_conv + (size_t)l * 512; const float* cw = A.conv_w + (size_t)l * 3 * 512;
            for (int m = gw; m < MTOK; m += NGW) {
                const int t = m & (SEQ - 1); const int c0 = 8 * lane;
                { const f16x8 v = *(const f16x8*)(ATT + (size_t)m * 512 + c0); float f[8]; float s = 0.f;
#pragma unroll
                    for (int e = 0; e < 8; ++e) { f[e] = (float)v[e]; s += f[e] * f[e]; }
                    const float r = 1.0f / sqrtf(wave_sum(s) * (1.0f / 512.0f) + 1e-6f);
                    u32x4 w; w.x = pk2h(f[0] * r * ga[c0 + 0], f[1] * r * ga[c0 + 1]); w.y = pk2h(f[2] * r * ga[c0 + 2], f[3] * r * ga[c0 + 3]);
                    w.z = pk2h(f[4] * r * ga[c0 + 4], f[5] * r * ga[c0 + 5]); w.w = pk2h(f[6] * r * ga[c0 + 6], f[7] * r * ga[c0 + 7]);
                    *(u32x4*)(MIX + (size_t)m * DM + c0) = w; }
                { const f16x8 p0 = *(const f16x8*)(Pb + (size_t)m * 512 + c0);
                    f16x8 p1 = (f16x8)(f16)0.f, p2 = (f16x8)(f16)0.f;
                    if (t >= 1) p1 = *(const f16x8*)(Pb + (size_t)(m - 1) * 512 + c0);
                    if (t >= 2) p2 = *(const f16x8*)(Pb + (size_t)(m - 2) * 512 + c0);
                    const f16x8 cb = *(const f16x8*)(CBb + (size_t)m * 512 + c0);
                    float f[8]; float s = 0.f;
#pragma unroll
                    for (int e = 0; e < 8; ++e) { const float y = cw[c0 + e] * (float)p2[e] + cw[512 + c0 + e] * (float)p1[e] + cw[1024 + c0 + e] * (float)p0[e];
                        f[e] = (float)cb[e] * y; s += f[e] * f[e]; }
                    const float r = 1.0f / sqrtf(wave_sum(s) * (1.0f / 512.0f) + 1e-6f);
                    u32x4 w; w.x = pk2h(f[0] * r * gc[c0 + 0], f[1] * r * gc[c0 + 1]); w.y = pk2h(f[2] * r * gc[c0 + 2], f[3] * r * gc[c0 + 3]);
                    w.z = pk2h(f[4] * r * gc[c0 + 4], f[5] * r * gc[c0 + 5]); w.w = pk2h(f[6] * r * gc[c0 + 6], f[7] * r * gc[c0 + 7]);
                    *(u32x4*)(MIX + (size_t)m * DM + 512 + c0) = w; }
            }
        } else if (PH_EN(12) && k == 8) {
            const float* fc = A.ffn_conv + (size_t)l * 3 * NUP;
            for (int it = gw; it < 512 * 6; it += NGW) {
                const int gI = it / 6, chunk = it % 6, c8 = chunk * 64 + lane;
                if (c8 < DFF / 8) {
                    const int c = 8 * c8;
                    float wa[3][8], wv[3][8];
#pragma unroll
                    for (int kk = 0; kk < 3; ++kk)
#pragma unroll
                        for (int e = 0; e < 8; ++e) { wa[kk][e] = fc[(size_t)kk * NUP + c + e]; wv[kk][e] = fc[(size_t)kk * NUP + DFF + c + e]; }
                    f16x8 a1 = (f16x8)(f16)0.f, a2 = a1, v1 = a1, v2 = a1;
                    if ((gI & 31) != 0) { const f16* hp = HALO + (size_t)(gI - 1) * 2 * NUP;
                        a2 = *(const f16x8*)(hp + c); v2 = *(const f16x8*)(hp + DFF + c); a1 = *(const f16x8*)(hp + NUP + c); v1 = *(const f16x8*)(hp + NUP + DFF + c); }
                    for (int r = 0; r < 64; ++r) {
                        f16* up = U + (size_t)(64 * gI + r) * NUP;
                        const f16x8 a0 = *(const f16x8*)(up + c), v0 = *(const f16x8*)(up + DFF + c);
                        float o[8];
#pragma unroll
                        for (int e = 0; e < 8; ++e) { const float ya = wa[0][e] * (float)a2[e] + wa[1][e] * (float)a1[e] + wa[2][e] * (float)a0[e];
                            const float yv = wv[0][e] * (float)v2[e] + wv[1][e] * (float)v1[e] + wv[2][e] * (float)v0[e];
                            o[e] = silu_f(ya) * yv; }
                        u32x4 w; w.x = pk2h(o[0], o[1]); w.y = pk2h(o[2], o[3]); w.z = pk2h(o[4], o[5]); w.w = pk2h(o[6], o[7]);
                        *(u32x4*)(up + c) = w;
                        a2 = a1; a1 = a0; v2 = v1; v1 = v0;
                    }
                }
            }
        } else if (PH_EN(15) && k == 101) {
            for (int m = gw; m < MTOK; m += NGW) {
                f32x4* xr = (f32x4*)(A.out + (size_t)m * DM) + lane;
                f32x4 v[4]; float s = 0.f;
#pragma unroll
                for (int j = 0; j < 4; ++j) { v[j] = xr[64 * j]; s += (v[j].x * v[j].x + v[j].y * v[j].y) + (v[j].z * v[j].z + v[j].w * v[j].w); }
                const float r = 1.0f / sqrtf(wave_sum(s) * (1.0f / DM) + 1e-6f);
#pragma unroll
                for (int j = 0; j < 4; ++j) { const f32x4 g4 = *(const f32x4*)(A.final_g + 4 * lane + 256 * j); xr[64 * j] = (v[j] * r) * g4; }
            }
        }
    }
}

__global__ void __launch_bounds__(NTHREADS, 2) fwd_kernel(Args A0) {
    extern __shared__ __attribute__((aligned(16))) unsigned char lds_raw[];
    LAS unsigned char* lds = (LAS unsigned char*)lds_raw;
    cg::grid_group grid = cg::this_grid();
    const int ph_lo = A0.ph_lo, ph_hi = A0.ph_hi;
    volatile LAS unsigned* bst = (volatile LAS unsigned*)(lds + RING_BYTES + 352);
    if (threadIdx.x < 2) bst[threadIdx.x] = 0u;
    __syncthreads();
    const XcdBarrier xbar = xcd_barrier_post((unsigned*)(A0.ws + WS_CTL) + 4096, bst);
#define STEP(P) if (ph_lo <= (P) && (P) < ph_hi) { run_phase<(P)>(lds, A0); if ((P) + 1 < ph_hi) { if ((P) == 0) grid.sync(); else xcd_barrier(xbar); } }
    STEP(0) STEP(1) STEP(2) STEP(3) STEP(4) STEP(5) STEP(6) STEP(7) STEP(8) STEP(9)
    STEP(10) STEP(11) STEP(12) STEP(13) STEP(14) STEP(15) STEP(16) STEP(17) STEP(18) STEP(19)
    STEP(20) STEP(21)
#undef STEP
}

extern "C" void kernel_launch(void* const* d_in, const int* in_sizes, int n_in, void* d_out, int out_size, void* d_ws, size_t ws_size, hipStream_t stream) {
    static int grid = 0;
    if (grid == 0) {
        if (n_in != 22 || out_size != MTOK * DM || ws_size < WS_END) { fprintf(stderr, "kernel_launch: unexpected shapes (n_in %d out %d ws %zu)\n", n_in, out_size, ws_size); grid = -1; return; }
        int dev = 0, cus = 0, per_cu = 0;
        hipGetDevice(&dev);
        hipDeviceGetAttribute(&cus, hipDeviceAttributeMultiprocessorCount, dev);
        hipFuncSetAttribute((const void*)fwd_kernel, hipFuncAttributeMaxDynamicSharedMemorySize, LDS_BYTES);
        hipOccupancyMaxActiveBlocksPerMultiprocessor(&per_cu, (const void*)fwd_kernel, NTHREADS, LDS_BYTES);
        (void)hipGetLastError();
        if (per_cu < 1) per_cu = 1;
        grid = cus * per_cu;
    }
    if (grid < 0) return;
    if (hipMemsetAsync((char*)d_ws + WS_CTL, 0, 1 * MiB, stream) != hipSuccess) { fprintf(stderr, "kernel_launch: memset failed\n"); return; }
    Args a{};
    a.x = (const float*)d_in[0]; a.c = (const float*)d_in[1]; a.pos = (const int*)d_in[2]; a.w_mod = (const float*)d_in[3]; a.b_mod = (const float*)d_in[4];
    a.norm1_g = (const float*)d_in[5]; a.w_in = (const float*)d_in[6]; a.pe_k = (const float*)d_in[7]; a.w1_k = (const float*)d_in[8]; a.w2_k = (const float*)d_in[9];
    a.pe_v = (const float*)d_in[10]; a.w1_v = (const float*)d_in[11]; a.w2_v = (const float*)d_in[12]; a.conv_w = (const float*)d_in[13]; a.g_attn = (const float*)d_in[14];
    a.g_conv = (const float*)d_in[15]; a.w_out = (const float*)d_in[16]; a.norm2_g = (const float*)d_in[17]; a.ffn_up = (const float*)d_in[18]; a.ffn_conv = (const float*)d_in[19];
    a.ffn_down = (const float*)d_in[20]; a.final_g = (const float*)d_in[21];
    a.out = (float*)d_out; a.ws = (unsigned char*)d_ws;
#if MK_ONE_LAUNCH
    a.ph_lo = 0; a.ph_hi = NPH;
    void* args[] = {&a};
    hipError_t e = hipLaunchCooperativeKernel((const void*)fwd_kernel, dim3(grid), dim3(NTHREADS), args, LDS_BYTES, stream);
    if (e != hipSuccess) fprintf(stderr, "cooperative launch failed: %s (grid %d)\n", hipGetErrorString(e), grid);
#else
    for (int ph = 0; ph < NPH; ++ph) {
        a.ph_lo = ph; a.ph_hi = ph + 1;
        hipLaunchKernelGGL(fwd_kernel, dim3(grid), dim3(NTHREADS), LDS_BYTES, stream, a);
    }
#endif
}
```

```cpp
#include <hip/hip_runtime.h>
#include <hip/hip_cooperative_groups.h>
#include <cstdio>
#include <cstdint>
namespace cg = cooperative_groups;

#define LAS __attribute__((address_space(3)))
typedef _Float16 f16;
typedef _Float16 f16x8 __attribute__((ext_vector_type(8)));
typedef _Float16 f16x4 __attribute__((ext_vector_type(4)));
typedef _Float16 f16x2 __attribute__((ext_vector_type(2)));
typedef float f32x4 __attribute__((ext_vector_type(4)));
typedef float f32x2 __attribute__((ext_vector_type(2)));
typedef unsigned u32x4 __attribute__((ext_vector_type(4)));
typedef unsigned u32x2 __attribute__((ext_vector_type(2)));

#ifndef PHMASK
#define PHMASK 0xFFFFFu
#endif
#define PH_EN(b) (((PHMASK) >> (b)) & 1u)
#ifndef MK_ONE_LAUNCH
#define MK_ONE_LAUNCH 1
#endif

constexpr int BATCH = 16, SEQ = 2048, DM = 1024, MTOK = BATCH * SEQ;
constexpr int NIN = 2840, NINP = 3072, DFF = 2816, NUP = 2 * DFF;
constexpr int NWAVES = 8, NTHREADS = 512;
constexpr int NPH = 22;

constexpr size_t MiB = 1u << 20;
constexpr size_t WS_CTL = 0;
constexpr size_t WS_MOD = 1 * MiB;
constexpr size_t WS_ROPE = 2 * MiB;
constexpr size_t WS_W1T = 4 * MiB;
constexpr size_t WS_W2T = 6 * MiB;
constexpr size_t WS_BPE = 6 * MiB + 65536;
constexpr size_t WS_HALO = 8 * MiB;
constexpr size_t WS_W = 20 * MiB;
constexpr size_t W_IN_OFF = 0, W_OUT_OFF = 6 * MiB, W_UP_OFF = 8 * MiB, W_DOWN_OFF = 19 * MiB, W_LAYER = 25 * MiB;
constexpr size_t WS_H = 70 * MiB;
constexpr size_t WS_KCMP = 134 * MiB;
constexpr size_t WS_G = 135 * MiB;
constexpr size_t WS_SEL = 139 * MiB;
constexpr size_t WS_BIG = 140 * MiB;
constexpr size_t WS_U = WS_BIG;
constexpr size_t WS_PROJ = WS_BIG;
constexpr size_t WS_IMP = WS_BIG;
constexpr size_t WS_OC = WS_BIG + 32 * MiB;
constexpr size_t WS_ATT = WS_BIG + 96 * MiB;
constexpr size_t WS_MIX = WS_BIG + 128 * MiB;
constexpr size_t WS_Q = WS_BIG + 192 * MiB;
constexpr size_t WS_KV = WS_BIG + 224 * MiB;
constexpr size_t KV_STRIDE = 8 * MiB;
constexpr size_t WS_CB = WS_BIG + 272 * MiB;
constexpr size_t WS_P = WS_BIG + 304 * MiB;
constexpr size_t WS_RAW = WS_BIG + 340 * MiB;
constexpr size_t WS_END = 512 * MiB;

constexpr int RING_BYTES = 131072;
constexpr int LDS_BYTES = 147456;

namespace pg8 {
constexpr int BM = 256, BK = 64, HALF = 128, HTB = HALF * BK * 2, STAGE_BYTES = 8 * HTB, NXCD = 8, WGM = 8;
__host__ __device__ __forceinline__ int lds_byte(int r, int c) { const int st = (r >> 4) * 2 + (c >> 5), rr = r & 15, cc = c & 31, ob = rr * 64 + cc * 2; return st * 1024 + (ob ^ (((ob >> 9) & 1) << 5)); }
__host__ __device__ __forceinline__ void stage_rc(int b, int& R, int& C) { const int st = b / 1024, sb = b % 1024, swz = sb ^ (((sb >> 9) & 1) << 5); R = (st >> 1) * 16 + swz / 64; C = (st & 1) * 32 + (swz % 64) / 2; }
__host__ __device__ __forceinline__ int perm32(int rho) { const int n = rho >> 4, i = rho & 15; return 8 * (i >> 2) + 4 * n + (i & 3); }

struct Unit { int pm, pn; };
struct Gemm { const f16* A; const f16* Bt; int M, N, K, lda; };

struct StaticOrder {
    int nM, nN, nwg, G, c;
    __device__ void init(int M, int N, int G_, int c_) { nM = M / BM; nN = N / BM; nwg = nM * nN; G = G_; c = c_; }
    __device__ bool next(int i, Unit& u) const {
        const long L = (long)i * G + c; if (L >= nwg) return false;
        int wgid = (int)L; { const int q = nwg / NXCD, r = nwg % NXCD, xcd = wgid % NXCD, off = wgid / NXCD; wgid = (xcd < r ? xcd * (q + 1) : r * (q + 1) + (xcd - r) * q) + off; }
        const int nig = WGM * nN, gid = wgid / nig, fm = gid * WGM, gsz = (nM - fm) < WGM ? (nM - fm) : WGM;
        u.pm = fm + ((wgid % nig) % gsz); u.pn = (wgid % nig) / gsz; return true;
    }
};

__device__ __forceinline__ unsigned pk_f16(float lo, float hi) { f32x2 v = {lo, hi}; f16x2 h = __builtin_convertvector(v, f16x2); return __builtin_bit_cast(unsigned, h); }

struct EpiF16 {
    static constexpr bool PERM = true;
    f16* O; int ldc; f16* halo;
    __device__ __forceinline__ void operator()(const f32x4 (&acc)[2][2][4][2], const Unit& u, int wr, int wc, int fr, int fq) const {
        const int row0 = u.pm * BM + wr * 64 + fr; const int col0 = u.pn * BM + wc * 32 + 8 * fq;
#pragma unroll
        for (int ai = 0; ai < 2; ++ai)
#pragma unroll
            for (int m = 0; m < 4; ++m) { f16* rowp = O + (size_t)(row0 + ai * HALF + m * 16) * ldc + col0;
#pragma unroll
                for (int bj = 0; bj < 2; ++bj) { const f32x4 v0 = acc[ai][bj][m][0], v1 = acc[ai][bj][m][1];
                    u32x4 w; w.x = pk_f16(v0[0], v0[1]); w.y = pk_f16(v0[2], v0[3]); w.z = pk_f16(v1[0], v1[1]); w.w = pk_f16(v1[2], v1[3]);
                    *(u32x4*)(rowp + bj * HALF) = w;
                    if (halo != nullptr && m == 3 && fr >= 14) { const int row = row0 + ai * HALF + m * 16; *(u32x4*)(halo + ((size_t)(row >> 6) * 2 + (fr - 14)) * ldc + col0 + bj * HALF) = w; } } }
    }
};

struct EpiUp {
    static constexpr bool PERM = true;
    f16* ACT; f16* halo; f16* raw; const float* fc; LAS float* hal;
    template <int CTRL> static __device__ __forceinline__ float dpp(float x) { return __builtin_bit_cast(float, __builtin_amdgcn_update_dpp(0, __builtin_bit_cast(int, x), CTRL, 0xf, 0xf, true)); }
    __device__ __forceinline__ void operator()(const f32x4 (&acc)[2][2][4][2], const Unit& u, int wr, int wc, int fr, int fq) const {
        const int row0 = u.pm * BM + wr * 64 + fr; const int col0 = u.pn * BM + wc * 32 + 8 * fq; const int f0b = (col0 >> 1);
        if (fr >= 14) {
#pragma unroll
            for (int ai = 0; ai < 2; ++ai)
#pragma unroll
                for (int bj = 0; bj < 2; ++bj) { LAS float* sl = hal + ((((((2 * ai + wr) * 4 + wc) * 2 + bj) * 4 + fq) * 2 + (fr - 14)) * 8);
                    *(LAS f32x4*)sl = acc[ai][bj][3][0]; *(LAS f32x4*)(sl + 4) = acc[ai][bj][3][1];
                    const f32x4 v0 = acc[ai][bj][3][0], v1 = acc[ai][bj][3][1];
                    u32x4 w; w.x = pk_f16(v0[0], v0[1]); w.y = pk_f16(v0[2], v0[3]); w.z = pk_f16(v1[0], v1[1]); w.w = pk_f16(v1[2], v1[3]);
                    const int row = row0 + ai * HALF + 48; *(u32x4*)(halo + ((size_t)(row >> 6) * 2 + (fr - 14)) * NUP + col0 + bj * HALF) = w; }
        }
        if (wr == 0 && fr < 2) {
#pragma unroll
            for (int bj = 0; bj < 2; ++bj) { const f32x4 v0 = acc[0][bj][0][0], v1 = acc[0][bj][0][1];
                u32x4 w; w.x = pk_f16(v0[0], v0[1]); w.y = pk_f16(v0[2], v0[3]); w.z = pk_f16(v1[0], v1[1]); w.w = pk_f16(v1[2], v1[3]);
                *(u32x4*)(raw + ((size_t)u.pm * 2 + fr) * NUP + col0 + bj * HALF) = w; }
        }
        asm volatile("s_waitcnt lgkmcnt(0)\n\ts_barrier" ::: "memory");
#pragma unroll
        for (int bj = 0; bj < 2; ++bj) {
            const int f0 = f0b + 64 * bj;
            f32x4 wa[3], wv[3];
#pragma unroll
            for (int kk = 0; kk < 3; ++kk) { wa[kk] = *(const f32x4*)(fc + (size_t)kk * NUP + f0); wv[kk] = *(const f32x4*)(fc + (size_t)kk * NUP + DFF + f0); }
#pragma unroll
            for (int ai = 0; ai < 2; ++ai) {
                const int cb = 2 * ai + wr;
                f32x4 pa = {0.f, 0.f, 0.f, 0.f}, pv = {0.f, 0.f, 0.f, 0.f};
                if (cb >= 1 && fr >= 14) { const LAS float* sl = hal + (((((cb - 1) * 4 + wc) * 2 + bj) * 4 + fq) * 2 + (fr - 14)) * 8; pa = *(const LAS f32x4*)sl; pv = *(const LAS f32x4*)(sl + 4); }
#pragma unroll
                for (int m = 0; m < 4; ++m) { const f32x4 ca = acc[ai][bj][m][0], cv = acc[ai][bj][m][1]; f32x4 o;
#pragma unroll
                    for (int e = 0; e < 4; ++e) {
                        const float a1 = dpp<0x111>(ca[e]) + dpp<0x10F>(pa[e]), a2 = dpp<0x112>(ca[e]) + dpp<0x10E>(pa[e]);
                        const float v1 = dpp<0x111>(cv[e]) + dpp<0x10F>(pv[e]), v2 = dpp<0x112>(cv[e]) + dpp<0x10E>(pv[e]);
                        const float ya = fmaf(wa[0][e], a2, fmaf(wa[1][e], a1, wa[2][e] * ca[e]));
                        const float yv = fmaf(wv[0][e], v2, fmaf(wv[1][e], v1, wv[2][e] * cv[e]));
                        o[e] = ya / (1.0f + __expf(-ya)) * yv; }
                    u32x2 w; w.x = pk_f16(o[0], o[1]); w.y = pk_f16(o[2], o[3]);
                    *(u32x2*)(ACT + (size_t)(row0 + ai * HALF + m * 16) * DFF + f0) = w;
                    pa = ca; pv = cv; }
            }
        }
    }
};

struct EpiIn {
    static constexpr bool PERM = true;
    f16* Q; f16* KV; f16* CB; f16* P; float* Gt; const float* rope;
    __device__ __forceinline__ void operator()(const f32x4 (&acc)[2][2][4][2], const Unit& u, int wr, int wc, int fr, int fq) const {
        const int row0 = u.pm * BM + wr * 64 + fr, pn = u.pn, cl = wc * 32 + 8 * fq;
        const bool ropelane = (cl & 63) < 16; const int ro = (cl & 8) ? 4 : 0;
#pragma unroll
        for (int ai = 0; ai < 2; ++ai)
#pragma unroll
            for (int m = 0; m < 4; ++m) { const int row = row0 + ai * HALF + m * 16;
                f32x4 cs = {1.f, 1.f, 1.f, 1.f}, sn = {0.f, 0.f, 0.f, 0.f};
                if (pn < 5 && ropelane) { cs = *(const f32x4*)(rope + (size_t)row * 16 + ro); sn = *(const f32x4*)(rope + (size_t)row * 16 + 8 + ro); }
#pragma unroll
                for (int bj = 0; bj < 2; ++bj) { f32x4 v0 = acc[ai][bj][m][0], v1 = acc[ai][bj][m][1];
                    if (pn < 5) {
                        if ((pn < 2 || bj == 0) && ropelane) { const f32x4 n0 = v0 * cs - v1 * sn, n1 = v1 * cs + v0 * sn; v0 = n0; v1 = n1; }
                        f16* dst;
                        if (pn < 2) { v0 = v0 * 0.18033688011112042f; v1 = v1 * 0.18033688011112042f; dst = Q + (size_t)row * 512 + (256 * pn + 128 * bj + cl); }
                        else dst = KV + (size_t)(2 * (pn - 2) + bj) * (KV_STRIDE / 2) + (size_t)row * 128 + cl;
                        u32x4 w; w.x = pk_f16(v0[0], v0[1]); w.y = pk_f16(v0[2], v0[3]); w.z = pk_f16(v1[0], v1[1]); w.w = pk_f16(v1[2], v1[3]);
                        *(u32x4*)dst = w;
                    } else if (pn < 7) {
                        u32x4 w; w.x = pk_f16(v0[0], v0[1]); w.y = pk_f16(v0[2], v0[3]); w.z = pk_f16(v1[0], v1[1]); w.w = pk_f16(v1[2], v1[3]);
                        *(u32x4*)(CB + (size_t)row * 512 + (256 * (pn - 5) + 128 * bj + cl)) = w;
                    } else if (pn < 11) {
                        const f32x4 pr = v0 * v1; u32x2 w; w.x = pk_f16(pr[0], pr[1]); w.y = pk_f16(pr[2], pr[3]);
                        *(u32x2*)(P + (size_t)row * 512 + ((256 * (pn - 7) + 128 * bj + cl) >> 1)) = w;
                    } else {
                        const int c = 128 * bj + cl;
                        if (c < 24) { f32x4 g0, g1;
#pragma unroll
                            for (int e = 0; e < 4; ++e) { g0[e] = 1.0f / (1.0f + __expf(-v0[e])); g1[e] = 1.0f / (1.0f + __expf(-v1[e])); }
                            *(f32x4*)(Gt + (size_t)row * 32 + c) = g0; *(f32x4*)(Gt + (size_t)row * 32 + c + 4) = g1; }
                    } } }
    }
};
struct EpiResid {
    static constexpr bool PERM = false;
    const float* base; float* out; const float* gate;
    __device__ __forceinline__ void operator()(const f32x4 (&acc)[2][2][4][2], const Unit& u, int wr, int wc, int fr, int fq) const {
        const int col0 = u.pn * BM + wc * 32 + 4 * fq; const int b = (u.pm * BM) >> 11;
        f32x4 gv[2][2];
#pragma unroll
        for (int bj = 0; bj < 2; ++bj)
#pragma unroll
            for (int n = 0; n < 2; ++n) gv[bj][n] = *(const f32x4*)(gate + (size_t)b * 6144 + col0 + bj * HALF + n * 16);
#pragma unroll
        for (int ai = 0; ai < 2; ++ai)
#pragma unroll
            for (int m = 0; m < 4; ++m) { const size_t off = (size_t)(u.pm * BM + ai * HALF + wr * 64 + m * 16 + fr) * DM + col0;
#pragma unroll
                for (int bj = 0; bj < 2; ++bj)
#pragma unroll
                    for (int n = 0; n < 2; ++n) { const f32x4 bs = *(const f32x4*)(base + off + bj * HALF + n * 16);
                        *(f32x4*)(out + off + bj * HALF + n * 16) = bs + gv[bj][n] * acc[ai][bj][m][n]; }
                if (m & 1) asm volatile("" ::: "memory"); }
    }
};

template <class Epi, class Sched, bool ALIGN_EPI = false, bool SP2 = false>
__device__ __forceinline__ void gemm_phase(LAS unsigned char* lds, const Gemm g, const Sched& S, const Epi& E, const int tid) {
    const int wid = __builtin_amdgcn_readfirstlane(tid >> 6), lane = tid & 63, wr = wid >> 2, wc = wid & 3, fr = lane & 15, fq = lane >> 4;
    const int K = g.K, nt = K / BK, lda = g.lda;
    unsigned voffA[2], voffB[2];
#pragma unroll
    for (int i = 0; i < 2; ++i) { int R, C; stage_rc(tid * 16 + i * 8192, R, C); const int Rb = Epi::PERM ? ((R & ~31) + perm32(R & 31)) : R;
        voffA[i] = (unsigned)(R * lda + C) * 2u; voffB[i] = (unsigned)(Rb * K + C) * 2u; }
    const size_t kstep = (size_t)(BK * 2);
    const size_t hstepA = (size_t)HALF * lda * 2, hstepB = (size_t)HALF * K * 2;
    const size_t tstepA = 2 * hstepA, tstepB = 2 * hstepB;
    const unsigned ldsw = (unsigned)wid * 1024u;
    const int aoff = lds_byte(wr * 64 + fr, fq * 8), boff = lds_byte(wc * 32 + fr, fq * 8);
#define PG8_SA(b, h) (((b) * 2 + (h)) * HTB)
#define PG8_SB(b, h) ((4 + (b) * 2 + (h)) * HTB)
#define PG8_STAGE(bufoff, gbase, voff) do { _Pragma("unroll") for (int _i = 0; _i < 2; ++_i) \
        __builtin_amdgcn_global_load_lds((const unsigned*)((const char*)(gbase) + (voff)[_i]), (LAS unsigned*)(lds + (bufoff) + ldsw + _i * 8192), 16, 0, 0); } while (0)
#define PG8_LDA(dst, b, h) do { _Pragma("unroll") for (int m = 0; m < 4; ++m) _Pragma("unroll") for (int k = 0; k < 2; ++k) dst[m][k] = *(const LAS f16x8*)(lds + PG8_SA(b, h) + aoff + m * 2048 + k * 1024); } while (0)
#define PG8_LDB(dst, b, h) do { _Pragma("unroll") for (int n = 0; n < 2; ++n) _Pragma("unroll") for (int k = 0; k < 2; ++k) dst[n][k] = *(const LAS f16x8*)(lds + PG8_SB(b, h) + boff + n * 2048 + k * 1024); } while (0)
#define PG8_MMA(ai, bj, At, Bt) do { __builtin_amdgcn_s_setprio(1); _Pragma("unroll") for (int m = 0; m < 4; ++m) _Pragma("unroll") for (int n = 0; n < 2; ++n) _Pragma("unroll") for (int k = 0; k < 2; ++k) \
        acc[ai][bj][m][n] = __builtin_amdgcn_mfma_f32_16x16x32_f16(Bt[n][k], At[m][k], acc[ai][bj][m][n], 0, 0, 0); __builtin_amdgcn_s_setprio(0); } while (0)
#define PG8_WAIT_V(n) asm volatile("s_waitcnt vmcnt(" #n ")" ::: "memory")
#define PG8_WAIT_L(n) asm volatile("s_waitcnt lgkmcnt(" #n ")" ::: "memory")
#define PG8_BAR __builtin_amdgcn_s_barrier()
#define PG8_SCHED __builtin_amdgcn_sched_barrier(0)
    Unit cur, nxt; int ui = 0;
    if (!S.next(0, cur)) return;
    f32x4 acc[2][2][4][2];
#pragma unroll
    for (int a = 0; a < 2; ++a)
#pragma unroll
        for (int b = 0; b < 2; ++b)
#pragma unroll
            for (int m = 0; m < 4; ++m)
#pragma unroll
                for (int n = 0; n < 2; ++n) acc[a][b][m][n] = (f32x4){0.f, 0.f, 0.f, 0.f};
    f16x8 At[4][2], B0[2][2], B1[2][2];
    const char* cA = (const char*)g.A + (size_t)cur.pm * tstepA; const char* cB = (const char*)g.Bt + (size_t)cur.pn * tstepB;
    if constexpr (SP2) {
        PG8_STAGE(PG8_SB(0, 0), cB, voffB); PG8_STAGE(PG8_SB(0, 1), cB + hstepB, voffB); PG8_STAGE(PG8_SA(0, 0), cA, voffA); PG8_STAGE(PG8_SA(0, 1), cA + hstepA, voffA);
        if (wr == 1) PG8_BAR;
        PG8_WAIT_V(2); PG8_BAR;
        PG8_STAGE(PG8_SB(1, 0), cB + kstep, voffB); PG8_STAGE(PG8_SA(1, 0), cA + kstep, voffA); PG8_STAGE(PG8_SB(1, 1), cB + hstepB + kstep, voffB);
        PG8_WAIT_V(6); PG8_BAR;
    } else {
        PG8_STAGE(PG8_SB(0, 0), cB, voffB); PG8_STAGE(PG8_SA(0, 0), cA, voffA); PG8_STAGE(PG8_SB(0, 1), cB + hstepB, voffB); PG8_STAGE(PG8_SA(0, 1), cA + hstepA, voffA);
        if (wr == 1) PG8_BAR;
        PG8_WAIT_V(4); PG8_BAR;
        PG8_STAGE(PG8_SB(1, 0), cB + kstep, voffB); PG8_STAGE(PG8_SA(1, 0), cA + kstep, voffA); PG8_STAGE(PG8_SB(1, 1), cB + hstepB + kstep, voffB);
        PG8_WAIT_V(6); PG8_BAR;
    }
    for (;;) {
        const bool has_next = S.next(ui + 1, nxt);
        const char* nA = has_next ? (const char*)g.A + (size_t)nxt.pm * tstepA : cA; const char* nB = has_next ? (const char*)g.Bt + (size_t)nxt.pn * tstepB : cB;
        for (int t = 0; t < nt; t += 2) {
            const bool last = (t == nt - 2);
            const char* a1 = cA + (size_t)(t + 1) * kstep;
            const char* a2 = last ? nA : cA + (size_t)(t + 2) * kstep; const char* b2 = last ? nB : cB + (size_t)(t + 2) * kstep;
            const char* a3 = a2 + kstep; const char* b3 = b2 + kstep;
            if constexpr (SP2) {
            PG8_LDB(B0, 0, 0); PG8_LDB(B1, 0, 1); PG8_SCHED; PG8_LDA(At, 0, 0); PG8_STAGE(PG8_SA(1, 1), a1 + hstepA, voffA);
            PG8_WAIT_V(8); PG8_WAIT_L(0); PG8_BAR; PG8_MMA(0, 0, At, B0); PG8_MMA(0, 1, At, B1); PG8_BAR; PG8_SCHED;
            PG8_LDA(At, 0, 1); PG8_STAGE(PG8_SB(0, 0), b2, voffB); PG8_STAGE(PG8_SB(0, 1), b2 + hstepB, voffB); PG8_STAGE(PG8_SA(0, 0), a2, voffA);
            PG8_WAIT_V(8); PG8_WAIT_L(0); PG8_BAR; PG8_MMA(1, 0, At, B0); PG8_MMA(1, 1, At, B1); PG8_BAR; PG8_SCHED;
            PG8_LDB(B0, 1, 0); PG8_LDB(B1, 1, 1); PG8_SCHED; PG8_LDA(At, 1, 0); PG8_STAGE(PG8_SA(0, 1), a2 + hstepA, voffA);
            PG8_WAIT_V(8); PG8_WAIT_L(0); PG8_BAR; PG8_MMA(0, 0, At, B0); PG8_MMA(0, 1, At, B1); PG8_BAR; PG8_SCHED;
            PG8_LDA(At, 1, 1); PG8_STAGE(PG8_SB(1, 0), b3, voffB); PG8_STAGE(PG8_SB(1, 1), b3 + hstepB, voffB); PG8_STAGE(PG8_SA(1, 0), a3, voffA);
            PG8_WAIT_V(8); PG8_WAIT_L(0); PG8_BAR; PG8_MMA(1, 0, At, B0); PG8_MMA(1, 1, At, B1); PG8_BAR; PG8_SCHED;
            } else {
            PG8_LDB(B0, 0, 0); PG8_SCHED; PG8_LDA(At, 0, 0); PG8_STAGE(PG8_SA(1, 1), a1 + hstepA, voffA);
            PG8_WAIT_L(8); PG8_BAR; PG8_WAIT_L(0); PG8_MMA(0, 0, At, B0); PG8_BAR; PG8_SCHED;
            PG8_LDB(B1, 0, 1); PG8_STAGE(PG8_SB(0, 0), b2, voffB);
            PG8_BAR; PG8_WAIT_L(0); PG8_MMA(0, 1, At, B1); PG8_BAR;
            PG8_LDA(At, 0, 1); PG8_STAGE(PG8_SA(0, 0), a2, voffA);
            PG8_BAR; PG8_WAIT_L(0); PG8_MMA(1, 0, At, B0); PG8_BAR; PG8_SCHED;
            PG8_STAGE(PG8_SB(0, 1), b2 + hstepB, voffB);
            PG8_WAIT_V(6); PG8_BAR; PG8_MMA(1, 1, At, B1); PG8_BAR;
            PG8_LDB(B0, 1, 0); PG8_SCHED; PG8_LDA(At, 1, 0); PG8_STAGE(PG8_SA(0, 1), a2 + hstepA, voffA);
            PG8_WAIT_L(8); PG8_BAR; PG8_WAIT_L(0); PG8_MMA(0, 0, At, B0); PG8_BAR; PG8_SCHED;
            PG8_LDB(B1, 1, 1); PG8_STAGE(PG8_SB(1, 0), b3, voffB);
            PG8_BAR; PG8_WAIT_L(0); PG8_MMA(0, 1, At, B1); PG8_BAR;
            PG8_LDA(At, 1, 1); PG8_STAGE(PG8_SA(1, 0), a3, voffA);
            PG8_BAR; PG8_WAIT_L(0); PG8_MMA(1, 0, At, B0); PG8_BAR; PG8_SCHED;
            PG8_STAGE(PG8_SB(1, 1), b3 + hstepB, voffB);
            PG8_WAIT_V(6); PG8_BAR; PG8_MMA(1, 1, At, B1); PG8_BAR;
            }
        }
        if constexpr (ALIGN_EPI) { if (wr == 0) PG8_BAR; }
        E(acc, cur, wr, wc, fr, fq);
        if (!has_next) break;
#pragma unroll
        for (int a = 0; a < 2; ++a)
#pragma unroll
            for (int b = 0; b < 2; ++b)
#pragma unroll
                for (int m = 0; m < 4; ++m)
#pragma unroll
                    for (int n = 0; n < 2; ++n) acc[a][b][m][n] = (f32x4){0.f, 0.f, 0.f, 0.f};
        cur = nxt; cA = nA; cB = nB; ++ui;
        if constexpr (ALIGN_EPI) { if (wr == 1) PG8_BAR; }
    }
    PG8_WAIT_V(0);
    if constexpr (!ALIGN_EPI) { if (wr == 0) PG8_BAR; }
    PG8_BAR;
#undef PG8_SA
#undef PG8_SB
#undef PG8_STAGE
#undef PG8_LDA
#undef PG8_LDB
#undef PG8_MMA
#undef PG8_WAIT_V
#undef PG8_WAIT_L
#undef PG8_BAR
#undef PG8_SCHED
}
}

__device__ __forceinline__ float wave_sum(float v) {
#pragma unroll
    for (int o = 1; o < 64; o <<= 1) v += __shfl_xor(v, o);
    return v;
}
__device__ __forceinline__ float silu_f(float x) { return x / (1.0f + __expf(-x)); }
__device__ __forceinline__ float sigmoid_f(float x) { return 1.0f / (1.0f + __expf(-x)); }
__device__ __forceinline__ unsigned pk2h(float lo, float hi) { return pg8::pk_f16(lo, hi); }


namespace att {
typedef float f32x16 __attribute__((ext_vector_type(16)));
typedef short s16x4 __attribute__((ext_vector_type(4)));
typedef short s16x8 __attribute__((ext_vector_type(8)));
__device__ __forceinline__ unsigned pk_h2(float lo, float hi) { return pg8::pk_f16(lo, hi); }
constexpr int L_B0 = 0, L_B1 = 8192, L_VR = 24576, L_RES = 49152, L_OWN = 49152, L_CAR = 82944, L_WSF = 116736, L_VAL = 118784, L_SELM = 127232, L_UNI = 127488, L_STG = 0;
constexpr float THR = 8.0f;
__device__ __forceinline__ int crow(int r, int hi) { return (r & 3) + 8 * (r >> 2) + 4 * hi; }
__device__ __forceinline__ float swapmax(float m) { auto rr = __builtin_amdgcn_permlane32_swap(__float_as_uint(m), __float_as_uint(m), false, false); return fmaxf(__uint_as_float(rr[0]), __uint_as_float(rr[1])); }
__device__ __forceinline__ float swapadd(float m) { auto rr = __builtin_amdgcn_permlane32_swap(__float_as_uint(m), __float_as_uint(m), false, false); return __uint_as_float(rr[0]) + __uint_as_float(rr[1]); }
__device__ __forceinline__ float ex2(float x) { return __builtin_amdgcn_exp2f(x); }
__device__ __forceinline__ void qkt(f32x16& p0, f32x16& p1, const LAS unsigned char* Kt, const f16x8 (&qr)[4], int r32, int hi) {
    p0 = (f32x16){}; p1 = (f32x16){};
    const LAS unsigned char* kb0 = Kt + hi * 1024 + r32 * 16;
#pragma unroll
    for (int d0 = 0; d0 < 4; ++d0) { const LAS unsigned char* kb = kb0 + d0 * 2048;
        const f16x8 b0 = *(const LAS f16x8*)(kb), b1 = *(const LAS f16x8*)(kb + 512);
        p0 = __builtin_amdgcn_mfma_f32_32x32x16_f16(b0, qr[d0], p0, 0, 0, 0);
        p1 = __builtin_amdgcn_mfma_f32_32x32x16_f16(b1, qr[d0], p1, 0, 0, 0);
    }
}
__device__ __forceinline__ f16x8 pk8(const f32x16& p, int b) { f16x8 r;
#pragma unroll
    for (int j = 0; j < 8; ++j) r[j] = (f16)p[b + j];
    return r; }
__device__ __forceinline__ void qkt_c(f32x16& p0, f32x16& p1, const LAS unsigned char* Kt, const f16x8 (&qr)[4], const f32x16& cinit, int r32, int hi) {
    const LAS unsigned char* kb = Kt + hi * 1024 + r32 * 16;
    { const f16x8 b0 = *(const LAS f16x8*)(kb), b1 = *(const LAS f16x8*)(kb + 512);
      p0 = __builtin_amdgcn_mfma_f32_32x32x16_f16(b0, qr[0], cinit, 0, 0, 0);
      p1 = __builtin_amdgcn_mfma_f32_32x32x16_f16(b1, qr[0], cinit, 0, 0, 0); }
#pragma unroll
    for (int d0 = 1; d0 < 4; ++d0) {
        const f16x8 b0 = *(const LAS f16x8*)(kb + d0 * 2048), b1 = *(const LAS f16x8*)(kb + d0 * 2048 + 512);
        p0 = __builtin_amdgcn_mfma_f32_32x32x16_f16(b0, qr[d0], p0, 0, 0, 0);
        p1 = __builtin_amdgcn_mfma_f32_32x32x16_f16(b1, qr[d0], p1, 0, 0, 0);
    }
}
__device__ __forceinline__ void kfrags(f16x8 (&kf)[8], const LAS unsigned char* Kt, int r32, int hi) {
    const LAS unsigned char* kb = Kt + hi * 1024 + r32 * 16;
#pragma unroll
    for (int d0 = 0; d0 < 4; ++d0) { kf[2 * d0] = *(const LAS f16x8*)(kb + d0 * 2048); kf[2 * d0 + 1] = *(const LAS f16x8*)(kb + d0 * 2048 + 512); }
}
__device__ __forceinline__ void vfrags(f16x8 (&vf)[8], const LAS unsigned char* vb) {
#pragma unroll
    for (int i = 0; i < 8; ++i) {
        const s16x4 lo = __builtin_amdgcn_ds_read_tr16_b64_v4i16((LAS s16x4*)(vb + (i >> 2) * 4096 + (i & 3) * 1024));
        const s16x4 hh = __builtin_amdgcn_ds_read_tr16_b64_v4i16((LAS s16x4*)(vb + (i >> 2) * 4096 + (i & 3) * 1024 + 512));
        const f16x4 l4 = __builtin_bit_cast(f16x4, lo), h4 = __builtin_bit_cast(f16x4, hh);
        vf[i] = (f16x8){l4[0], l4[1], l4[2], l4[3], h4[0], h4[1], h4[2], h4[3]};
    }
}
__device__ __forceinline__ void qkt_f(f32x16& p0, f32x16& p1, const f16x8 (&kf)[8], const f16x8 (&qr)[4], const f32x16& cinit) {
    p0 = __builtin_amdgcn_mfma_f32_32x32x16_f16(kf[0], qr[0], cinit, 0, 0, 0);
    p1 = __builtin_amdgcn_mfma_f32_32x32x16_f16(kf[1], qr[0], cinit, 0, 0, 0);
#pragma unroll
    for (int d0 = 1; d0 < 4; ++d0) { p0 = __builtin_amdgcn_mfma_f32_32x32x16_f16(kf[2 * d0], qr[d0], p0, 0, 0, 0); p1 = __builtin_amdgcn_mfma_f32_32x32x16_f16(kf[2 * d0 + 1], qr[d0], p1, 0, 0, 0); }
}
__device__ __forceinline__ void pv_f(f32x16 (&o)[2], const f16x8 (&vf)[8], const f16x8 (&pa)[4]) {
#pragma unroll
    for (int ks = 0; ks < 4; ++ks) { o[0] = __builtin_amdgcn_mfma_f32_32x32x16_f16(pa[ks], vf[ks], o[0], 0, 0, 0); o[1] = __builtin_amdgcn_mfma_f32_32x32x16_f16(pa[ks], vf[4 + ks], o[1], 0, 0, 0); }
}
__device__ __forceinline__ void glds16(const void* gsrc, unsigned lds_dst) { unsigned keep;
    asm volatile("s_mov_b32 %0, m0\n\ts_mov_b32 m0, %2\n\ts_nop 0\n\tglobal_load_lds_dwordx4 %1, off\n\ts_mov_b32 m0, %0" : "=&s"(keep) : "v"(gsrc), "s"(lds_dst) : "memory"); }
__device__ __forceinline__ float max3f(float a, float b, float c) { float r; asm("v_max3_f32 %0, %1, %2, %3" : "=v"(r) : "v"(a), "v"(b), "v"(c)); return r; }
__device__ __forceinline__ float rowmax3(const f32x16& p0, const f32x16& p1) {
    float a = max3f(p0[0], p0[1], p1[0]), b = max3f(p0[2], p0[3], p1[1]); a = max3f(a, p1[2], p1[3]);
#pragma unroll
    for (int r = 4; r < 16; r += 4) { a = max3f(a, p0[r], p0[r + 1]); b = max3f(b, p0[r + 2], p0[r + 3]); a = max3f(a, p1[r], p1[r + 1]); b = max3f(b, p1[r + 2], p1[r + 3]); }
    return swapmax(max3f(a, b, b));
}
__device__ __forceinline__ void pv(f32x16 (&o)[2], const LAS unsigned char* vb, const f16x8 (&pa)[4]) {
#pragma unroll
    for (int d0 = 0; d0 < 2; ++d0)
#pragma unroll
        for (int ks = 0; ks < 4; ++ks) {
            const s16x4 lo = __builtin_amdgcn_ds_read_tr16_b64_v4i16((LAS s16x4*)(vb + d0 * 4096 + ks * 1024));
            const s16x4 hh = __builtin_amdgcn_ds_read_tr16_b64_v4i16((LAS s16x4*)(vb + d0 * 4096 + ks * 1024 + 512));
            const f16x4 l4 = __builtin_bit_cast(f16x4, lo), h4 = __builtin_bit_cast(f16x4, hh);
            const f16x8 B = {l4[0], l4[1], l4[2], l4[3], h4[0], h4[1], h4[2], h4[3]};
            o[d0] = __builtin_amdgcn_mfma_f32_32x32x16_f16(pa[ks], B, o[d0], 0, 0, 0);
        }
}
__device__ __forceinline__ float rowmax(const f32x16& p0, const f32x16& p1) {
    float a = fmaxf(p0[0], p1[0]);
#pragma unroll
    for (int r = 1; r < 16; ++r) a = fmaxf(a, fmaxf(p0[r], p1[r]));
    return swapmax(a);
}
__device__ __forceinline__ void online(f32x16& p0, f32x16& p1, f32x16 (&o)[2], float& m, float& l, LAS float* wsf, int r32, int hi) {
    const float mn = fmaxf(m, rowmax(p0, p1));
    if (__any(mn > m)) {
        const float alpha = (mn == -INFINITY) ? 1.0f : ex2(m - mn);
        l *= alpha;
        if (hi == 0) wsf[r32] = alpha;
#pragma unroll
        for (int r = 0; r < 16; ++r) { const float a = (wsf + 4 * hi)[crow(r, 0)]; o[0][r] *= a; o[1][r] *= a; }
        m = mn;
    }
    const float mu = (m == -INFINITY) ? 0.0f : m;
    float s = 0.f;
#pragma unroll
    for (int r = 0; r < 16; ++r) { p0[r] = ex2(p0[r] - mu); p1[r] = ex2(p1[r] - mu); s += p0[r] + p1[r]; }
    l += s;
}
template <bool FIRST>
__device__ __forceinline__ void accum(LAS float* resw, const f32x16 (&o)[2], float fac, LAS float* wsf, int r32, int hi) {
    if (hi == 0) wsf[r32] = fac;
#pragma unroll
    for (int r = 0; r < 16; ++r) { const float a = (wsf + 4 * hi)[crow(r, 0)];
        if (FIRST) { resw[r * 64] = a * o[0][r]; resw[(16 + r) * 64] = a * o[1][r]; }
        else { resw[r * 64] = fmaf(a, o[0][r], resw[r * 64]); resw[(16 + r) * 64] = fmaf(a, o[1][r], resw[(16 + r) * 64]); } }
}

__device__ __forceinline__ void attn_unit(LAS unsigned char* lds, int b, int hk, int qb, const f16* Q, const f16* KVb, const f16* KCMP, const float* Gt, f16* ATT, int tid) {
    const int lane = tid & 63, wave = __builtin_amdgcn_readfirstlane(tid >> 6), r32 = lane & 31, hi = lane >> 5;
    const int g = wave >> 1, qh = wave & 1, h = hk * 4 + g;
    const int tl = 32 * qh + r32, tq = 64 * qb + tl; const size_t mq = (size_t)b * SEQ + tq;
    LAS unsigned char* B0 = lds + L_B0; LAS unsigned char* B1 = lds + L_B1;
    LAS float* wsf = (LAS float*)(lds + L_WSF + wave * 256);
    LAS float* ownl = (LAS float*)(lds + L_OWN); LAS float* carl = (LAS float*)(lds + L_CAR); LAS float* vall = (LAS float*)(lds + L_VAL);
    LAS unsigned* selm = (LAS unsigned*)(lds + L_SELM); LAS unsigned* unim = (LAS unsigned*)(lds + L_UNI);
    const int kst = wave * 1024 + lane * 16, vst = kst;
    const int kcol = 8 * wave, vrow = 16 * (wave & 3) + (lane >> 2), vcol = 32 * (wave >> 2) + 8 * (lane & 3);
    const int vlo = ((lane >> 4) & 1) * 32 + (lane & 3) * 8 + (4 * hi + ((lane & 15) >> 2)) * 64;
    const LAS unsigned char* vb0 = B0 + vlo;
    const LAS unsigned char* vb1 = vb0 + 8192;
    f16x8 qr[4];
#pragma unroll
    for (int d0 = 0; d0 < 4; ++d0) qr[d0] = *(const f16x8*)(Q + mq * 512 + h * 64 + d0 * 16 + hi * 8);
    LAS float* resw = (LAS float*)(lds + L_RES + wave * 8192) + lane;
    const f16* kc = KCMP + (((size_t)0 * 16 + b) * 2 + hk) * 128 * 64; const f16* vc = KCMP + (((size_t)1 * 16 + b) * 2 + hk) * 128 * 64;
    {
        const f16x8 k0 = *(const f16x8*)(kc + (size_t)lane * 64 + kcol), k1 = *(const f16x8*)(kc + (size_t)(64 + lane) * 64 + kcol);
        __syncthreads();
        *(LAS f16x8*)(B0 + kst) = k0; *(LAS f16x8*)(B1 + kst) = k1;
        if (tid < 64) selm[tid] = 0u; if (tid == 64) unim[0] = 0u;
        __syncthreads();
        f32x16 a0, a1, b0, b1;
        qkt(a0, a1, B0, qr, r32, hi); qkt(b0, b1, B1, qr, r32, hi);
        const int nvalid = (tq >= 31) ? (((tq - 31) >> 4) + 1) : 0;
#pragma unroll
        for (int r = 0; r < 16; ++r) { const int kk = crow(r, 0); const int thr = nvalid - 4 * hi;
            a0[r] = (kk >= thr) ? -INFINITY : a0[r]; a1[r] = (kk + 32 >= thr) ? -INFINITY : a1[r]; b0[r] = (kk + 64 >= thr) ? -INFINITY : b0[r]; b1[r] = (kk + 96 >= thr) ? -INFINITY : b1[r]; }
        const float mx = fmaxf(rowmax(a0, a1), rowmax(b0, b1)); const float mu = (mx == -INFINITY) ? 0.0f : mx;
        float sum = 0.f;
#pragma unroll
        for (int r = 0; r < 16; ++r) { a0[r] = ex2(a0[r] - mu); a1[r] = ex2(a1[r] - mu); b0[r] = ex2(b0[r] - mu); b1[r] = ex2(b1[r] - mu); sum += (a0[r] + a1[r]) + (b0[r] + b1[r]); }
        sum = swapadd(sum);
        const float inv = (sum > 0.f) ? 1.0f / sum : 0.f;
        {
            LAS float* op = ownl + (g * 64 + tl) * 33 + hi; LAS float* cp = carl + (g * 64 + tl) * 33 + hi;
#pragma unroll
            for (int X = 0; X < 4; ++X)
#pragma unroll
                for (int a = 0; a < 4; ++a) { const f32x16& P = (X == 0) ? a0 : (X == 1) ? a1 : (X == 2) ? b0 : b1;
                    const int j0 = 8 * X + 2 * a;
                    op[j0] = ((P[4 * a] + P[4 * a + 1]) + (P[4 * a + 2] + P[4 * a + 3])) * inv;
                    if (j0 + 1 < 31) cp[j0 + 1] = P[4 * a + 3] * inv; else if (hi == 0) cp[j0 + 1] = P[4 * a + 3] * inv; }
        }
        f16x8 paA[4], paB[4];
        paA[0] = pk8(a0, 0); paA[1] = pk8(a0, 8); paA[2] = pk8(a1, 0); paA[3] = pk8(a1, 8);
        paB[0] = pk8(b0, 0); paB[1] = pk8(b0, 8); paB[2] = pk8(b1, 0); paB[3] = pk8(b1, 8);
        __syncthreads();
        { const f16x8 v0 = *(const f16x8*)(vc + (size_t)vrow * 64 + vcol), v1 = *(const f16x8*)(vc + (size_t)(64 + vrow) * 64 + vcol);
          *(LAS f16x8*)(B0 + vst) = v0; *(LAS f16x8*)(B1 + vst) = v1; }
        {
            const int q = tid & 63, jq = tid >> 6;
#pragma unroll
            for (int i = 0; i < 4; ++i) { const int j = jq + 8 * i; float v = 0.f;
#pragma unroll
                for (int gg = 0; gg < 4; ++gg) v += ownl[(gg * 64 + q) * 33 + j] + ((j > 0) ? carl[(gg * 64 + q) * 33 + j] : 0.f);
                if (j > qb) v = -INFINITY; else if (j == 0 || j == qb || j == qb - 1) v = INFINITY;
                vall[q * 33 + j] = v; }
        }
        __syncthreads();
        {
            const int q = tid & 63, jq = tid >> 6; float vx[4]; int rk[4];
#pragma unroll
            for (int i = 0; i < 4; ++i) { vx[i] = vall[q * 33 + jq + 8 * i]; rk[i] = 0; }
            for (int i2 = 0; i2 < 32; ++i2) { const float vi = vall[q * 33 + i2];
#pragma unroll
                for (int i = 0; i < 4; ++i) rk[i] += ((vi > vx[i]) || (vi == vx[i] && i2 < jq + 8 * i)) ? 1 : 0; }
            unsigned bits = 0u;
#pragma unroll
            for (int i = 0; i < 4; ++i) if (rk[i] < 8 && vx[i] > -INFINITY) bits |= 1u << (jq + 8 * i);
            if (bits) { __hip_atomic_fetch_or(selm + q, bits, __ATOMIC_RELAXED, __HIP_MEMORY_SCOPE_WORKGROUP); __hip_atomic_fetch_or(unim, bits, __ATOMIC_RELAXED, __HIP_MEMORY_SCOPE_WORKGROUP); }
        }
        f32x16 o[2]; o[0] = (f32x16){}; o[1] = (f32x16){};
        pv(o, vb0, paA); pv(o, vb1, paB);
        accum<true>(resw, o, Gt[mq * 32 + h * 3 + 0] * inv, wsf, r32, hi);
        __syncthreads();
    }
    const unsigned mysel = selm[tl]; const unsigned uni = unim[0];
#ifndef ATT_PROBE
#define ATT_PROBE 0
#endif
#pragma unroll 1
    for (int bri = 0; bri < ((ATT_PROBE == 1 || ATT_PROBE == 2) ? 3 : 2); ++bri) {
        const int br = (ATT_PROBE == 1) ? (bri >> 1) : (ATT_PROBE == 2) ? ((bri + 1) >> 1) : bri;
        const float pfac = ((ATT_PROBE == 1 && bri == 0) || (ATT_PROBE == 2 && bri == 1)) ? 0.0f : 1.0f;
        const f16* Kg = KVb + (size_t)(2 + 2 * br) * (KV_STRIDE / 2) + (size_t)b * SEQ * 128 + hk * 64;
        const f16* Vg = KVb + (size_t)(3 + 2 * br) * (KV_STRIDE / 2) + (size_t)b * SEQ * 128 + hk * 64;
        const unsigned lo_bits = (qb >= 8) ? ~((1u << (qb - 8)) - 1u) : 0xFFFFFFFFu;
        const unsigned upto = (qb == 31) ? 0xFFFFFFFFu : ((2u << qb) - 1u);
        const unsigned todo = (br == 0) ? (uni & upto) : (upto & lo_bits);
        unsigned tK = todo, tV = todo, tC = todo; int jK = 0, jV = 0; const unsigned lds0 = (unsigned)(__UINTPTR_TYPE__)lds;
#define ISSUE_K(soff) do { if (tK) { jK = __builtin_ctz(tK); tK &= tK - 1u; } \
            glds16(Kg + (size_t)(64 * jK + lane) * 128 + kcol, (unsigned)__builtin_amdgcn_readfirstlane((int)(lds0 + (soff) + wave * 1024))); } while (0)
#define ISSUE_V(soff) do { if (tV) { jV = __builtin_ctz(tV); tV &= tV - 1u; } \
            glds16(Vg + (size_t)(64 * jV + vrow) * 128 + vcol, (unsigned)__builtin_amdgcn_readfirstlane((int)(lds0 + L_VR + (soff) + wave * 1024))); } while (0)
#define WAITV(n) asm volatile("s_waitcnt vmcnt(" #n ")" ::: "memory")
#define SBAR() __builtin_amdgcn_sched_barrier(0)
#define PINV(x) asm volatile("" : "+v"(x))
#define MF(a_, b_, c_) __builtin_amdgcn_mfma_f32_32x32x16_f16(a_, b_, c_, 0, 0, 0)
#define PKW(P, B) pk_h2(P[B], P[(B) + 1])
#define PAF(k) __builtin_bit_cast(f16x8, pw##k)
#define VFR(i) __builtin_bit_cast(f16x8, (s16x8){vtl[i][0], vtl[i][1], vtl[i][2], vtl[i][3], vth[i][0], vth[i][1], vth[i][2], vth[i][3]})
#define VRD(i) do { vtl[i] = __builtin_amdgcn_ds_read_tr16_b64_v4i16((LAS s16x4*)(vp_ + (((i) >> 2) * 4096 + ((i) & 3) * 1024))); \
                    vth[i] = __builtin_amdgcn_ds_read_tr16_b64_v4i16((LAS s16x4*)(vp_ + (((i) >> 2) * 4096 + ((i) & 3) * 1024 + 512))); } while (0)
#define KRD(j_) do { kf[2 * (j_)] = *(const LAS f16x8*)(kp_ + (j_) * 2048); kf[2 * (j_) + 1] = *(const LAS f16x8*)(kp_ + (j_) * 2048 + 512); SBAR(); } while (0)
#define GAPA(MFX, A0, A1, A2, A3, W0, W1, PW) do { MFX; sacc += A0; sacc += A1; sacc += A2; sacc += A3; PINV(sacc); W0; W1; PINV(PW); SBAR(); } while (0)
#define GAPB(MFX, X, B) do { MFX; X[B] = ex2(X[B]); X[(B) + 1] = ex2(X[(B) + 1]); X[(B) + 2] = ex2(X[(B) + 2]); X[(B) + 3] = ex2(X[(B) + 3]); PINV(X); SBAR(); } while (0)
#define STEP(C0, C1, P0, P1) do { SBAR(); \
            const LAS unsigned char* vp_ = lds + L_VR + vM + vlo; const LAS unsigned char* kp_ = lds + kB + hi * 1024 + r32 * 16; \
            VRD(0); SBAR(); float sacc = P0[0] + P0[1]; \
            GAPA(C0 = MF(kf[0], qr[0], negm), P0[2], P0[3], P0[4], P0[5],     pw0[0] = PKW(P0, 0),  pw0[1] = PKW(P0, 2),  pw0); \
            VRD(4); SBAR(); GAPA(C1 = MF(kf[1], qr[0], negm), P0[6], P0[7], P0[8], P0[9],     pw0[2] = PKW(P0, 4),  pw0[3] = PKW(P0, 6),  pw0); \
            VRD(1); SBAR(); GAPA(C0 = MF(kf[2], qr[1], C0),   P0[10], P0[11], P0[12], P0[13], pw1[0] = PKW(P0, 8),  pw1[1] = PKW(P0, 10), pw1); \
            VRD(5); SBAR(); GAPA(C1 = MF(kf[3], qr[1], C1),   P0[14], P0[15], P1[0], P1[1],   pw1[2] = PKW(P0, 12), pw1[3] = PKW(P0, 14), pw1); \
            VRD(2); SBAR(); GAPA(C0 = MF(kf[4], qr[2], C0),   P1[2], P1[3], P1[4], P1[5],     pw2[0] = PKW(P1, 0),  pw2[1] = PKW(P1, 2),  pw2); \
            VRD(6); SBAR(); GAPA(C1 = MF(kf[5], qr[2], C1),   P1[6], P1[7], P1[8], P1[9],     pw2[2] = PKW(P1, 4),  pw2[3] = PKW(P1, 6),  pw2); \
            VRD(3); SBAR(); GAPA(C0 = MF(kf[6], qr[3], C0),   P1[10], P1[11], P1[12], P1[13], pw3[0] = PKW(P1, 8),  pw3[1] = PKW(P1, 10), pw3); \
            VRD(7); SBAR(); GAPA(C1 = MF(kf[7], qr[3], C1),   P1[14], P1[15], 0.f, 0.f,       pw3[2] = PKW(P1, 12), pw3[3] = PKW(P1, 14), pw3); \
            l += sacc; \
            ISSUE_K(kA); ISSUE_V(v1); \
            asm volatile("s_nop 15\n\ts_nop 7" : "+v"(C0), "+v"(C1)); \
            if (jc == qb) { _Pragma("unroll") for (int r = 0; r < 16; ++r) { const int ki = crow(r, 0); const int tlh = tl - 4 * hi; C0[r] = (ki > tlh) ? -INFINITY : C0[r]; C1[r] = (ki + 32 > tlh) ? -INFINITY : C1[r]; } } \
            if (br == 1 && jc == qb - 8) { _Pragma("unroll") for (int r = 0; r < 16; ++r) { const int ki = crow(r, 0); const int tlh = tl - 4 * hi; C0[r] = (ki <= tlh) ? -INFINITY : C0[r]; C1[r] = (ki + 32 <= tlh) ? -INFINITY : C1[r]; } } \
            { const float tm = rowmax3(C0, C1); resc = false; \
              const bool need = started ? (tm > THR) : (tm > -INFINITY); \
              if (__builtin_expect(__any(need), 0)) { const float dl = need ? tm : 0.f; mhat += dl; \
                  _Pragma("unroll") for (int r = 0; r < 16; ++r) { C0[r] -= dl; C1[r] -= dl; } \
                  const float f = started ? ex2(-dl) : 1.0f; l *= f; if (hi == 0) wsf[r32] = f; resc = true; } \
              started = started || (tm > -INFINITY); } \
            { const bool minen = (jn >= 0) && ((br == 1) || (((mysel >> jn) & 1u) != 0u)); const float cn = minen ? -mhat : -INFINITY; \
              _Pragma("unroll") for (int r = 0; r < 16; ++r) negm[r] = cn; PINV(negm); } \
            SBAR(); \
            GAPB(o[0] = MF(PAF(0), VFR(0), o[0]), C0, 0); \
            GAPB(o[1] = MF(PAF(0), VFR(4), o[1]), C0, 4); \
            KRD(0); GAPB(o[0] = MF(PAF(1), VFR(1), o[0]), C0, 8); \
            KRD(1); GAPB(o[1] = MF(PAF(1), VFR(5), o[1]), C0, 12); \
            KRD(2); GAPB(o[0] = MF(PAF(2), VFR(2), o[0]), C1, 0); \
            KRD(3); GAPB(o[1] = MF(PAF(2), VFR(6), o[1]), C1, 4); \
            GAPB(o[0] = MF(PAF(3), VFR(3), o[0]), C1, 8); \
            GAPB(o[1] = MF(PAF(3), VFR(7), o[1]), C1, 12); \
            asm volatile("s_waitcnt vmcnt(2) lgkmcnt(0)\n\ts_barrier" ::: "memory"); \
            if (resc) { _Pragma("unroll") for (int r = 0; r < 16; ++r) { const float a = (wsf + 4 * hi)[crow(r, 0)]; o[0][r] *= a; o[1][r] *= a; } } \
            last_ = (jc < 0); jc = jn; jn = tC ? __builtin_ctz(tC) : -1; tC &= tC - 1u; \
            { const int t_ = kA; kA = kB; kB = kC; kC = t_; } vM = v0_; v0_ = v1; v1 = (v1 == 16384) ? 0 : v1 + 8192; \
        } while (0)
        ISSUE_K(0); ISSUE_V(0); ISSUE_K(8192); ISSUE_K(16384);
        int jc = __builtin_ctz(tC); tC &= tC - 1u;
        int jn = tC ? __builtin_ctz(tC) : -1; tC &= tC - 1u;
        float mhat = 0.f, l = 0.f; bool started = false, resc = false, last_ = false; f32x16 o[2]; o[0] = (f32x16){}; o[1] = (f32x16){};
        f32x16 pA0 = (f32x16){}, pA1 = (f32x16){}, pB0, pB1, negm;
        u32x4 pw0, pw1, pw2, pw3; s16x4 vtl[8], vth[8]; f16x8 kf[8];
        { const bool mine0 = (br == 1) || (((mysel >> jc) & 1u) != 0u); const float c0 = mine0 ? 0.f : -INFINITY;
#pragma unroll
          for (int r = 0; r < 16; ++r) negm[r] = c0; }
        int kA = 0, kB = 8192, kC = 16384, vM = 0, v0_ = 0, v1 = 8192;
        asm volatile("s_waitcnt vmcnt(0)\n\ts_barrier" ::: "memory");
        kfrags(kf, lds, r32, hi);
        asm volatile("s_waitcnt lgkmcnt(0)\n\ts_barrier" ::: "memory");
#pragma unroll 1
        for (;;) {
            STEP(pB0, pB1, pA0, pA1); if (last_) break;
            STEP(pA0, pA1, pB0, pB1); if (last_) break;
        }
        asm volatile("s_waitcnt vmcnt(0)\n\ts_barrier" ::: "memory");
#undef STEP
#undef GAPA
#undef GAPB
#undef KRD
#undef VRD
#undef VFR
#undef PAF
#undef PKW
#undef MF
#undef PINV
#undef SBAR
#undef ISSUE_K
#undef ISSUE_V
#undef WAITV
        const float lt = swapadd(l);
        const float facb = pfac * Gt[mq * 32 + h * 3 + 1 + br] / fmaxf(lt, 1e-30f);
        if (br == 0) accum<false>(resw, o, facb, wsf, r32, hi);
        else {
            if (hi == 0) wsf[r32] = facb;
            LAS f16* stg = (LAS f16*)(lds + L_STG + wave * 4096);
            LAS f16* stw = stg + 4 * hi * 64 + r32;
#pragma unroll
            for (int r = 0; r < 16; ++r) { const float a = (wsf + 4 * hi)[crow(r, 0)]; const int orow = crow(r, 0);
                stw[orow * 64] = (f16)fmaf(a, o[0][r], resw[r * 64]); stw[orow * 64 + 32] = (f16)fmaf(a, o[1][r], resw[(16 + r) * 64]); }
            if (bri + 1 == ((ATT_PROBE == 1 || ATT_PROBE == 2) ? 3 : 2)) {
                f16* Ow = ATT + ((size_t)b * SEQ + 64 * qb + 32 * qh) * 512 + h * 64;
#pragma unroll
                for (int i = 0; i < 4; ++i) { const int row = i * 8 + (lane >> 3), ch = lane & 7; const u32x4 v = *(const LAS u32x4*)(stg + row * 64 + ch * 8); *(u32x4*)(Ow + (size_t)row * 512 + ch * 8) = v; }
            }
        }
    }
}
}

struct Args {
    const float* x; const float* c; const int* pos; const float* w_mod; const float* b_mod; const float* norm1_g; const float* w_in;
    const float* pe_k; const float* w1_k; const float* w2_k; const float* pe_v; const float* w1_v; const float* w2_v;
    const float* conv_w; const float* g_attn; const float* g_conv; const float* w_out; const float* norm2_g;
    const float* ffn_up; const float* ffn_conv; const float* ffn_down; const float* final_g;
    float* out; unsigned char* ws; int ph_lo, ph_hi;
};

__device__ __forceinline__ int hperm(int j) { return (j < 4 || j >= 12) ? j : (j < 8 ? j + 4 : j - 4); }
__device__ __forceinline__ int win_colmap(int n) {
    if (n < 512) return (n & ~63) | hperm(n & 63);
    if (n < 1280) { const int r = n - 512; return ((r & 128) == 0) ? 512 + ((r & ~63) | hperm(r & 63)) : n; }
    if (n < 1792) return 1304 + (n - 1280);
    if (n < 2816) { const int r = n - 1792, i = r >> 3, e = r & 7; return (e < 4) ? 1816 + 4 * i + e : 2328 + 4 * i + (e - 4); }
    if (n < 2840) return 1280 + (n - 2816);
    return -1;
}
__device__ __forceinline__ void transpose_item(const float* W, int K, int Nsrc, int Ndst, f16* WT, LAS float* scr, int item, int lane, int colmode = 0, int kmode = 0) {
    const int nblk = Ndst / 32, kb = item / nblk, nb = item % nblk, k0 = 64 * kb, n0 = 32 * nb;
    const int nd = n0 + (lane & 31);
    const int sc = (colmode == 1) ? win_colmap(nd) : (colmode == 2) ? ((nd & ~63) | hperm(nd & 63)) : (colmode == 3) ? (((nd & 4) ? DFF : 0) + ((nd >> 3) << 2) + (nd & 3)) : ((nd < Nsrc) ? nd : -1);
#pragma unroll 8
    for (int i = 0; i < 32; ++i) { const int kk = 2 * i + (lane >> 5); const int ks = (kmode == 1) ? hperm(kk) : kk;
        scr[kk * 33 + (lane & 31)] = (sc >= 0) ? W[(size_t)(k0 + ks) * Nsrc + sc] : 0.f; }
    asm volatile("s_waitcnt lgkmcnt(0)" ::: "memory");
    const int c = lane & 7;
#pragma unroll
    for (int j = 0; j < 4; ++j) { const int n = (lane >> 3) + 8 * j; const LAS float* s = scr + (8 * c) * 33 + n;
        u32x4 o; o.x = pk2h(s[0 * 33], s[1 * 33]); o.y = pk2h(s[2 * 33], s[3 * 33]); o.z = pk2h(s[4 * 33], s[5 * 33]); o.w = pk2h(s[6 * 33], s[7 * 33]);
        *(u32x4*)(WT + (size_t)(n0 + n) * K + k0 + 8 * c) = o; }
    asm volatile("s_waitcnt lgkmcnt(0)" ::: "memory");
}

__device__ __forceinline__ void sincos_d(double a, float& s, float& c) {
    const double k = rint(a * 0.63661977236758134308);
    double r = fma(-k, 1.57079632679489655800e+00, a); r = fma(-k, 6.12323399573676603587e-17, r);
    const double r2 = r * r;
    double sp = -1.0 / 1307674368000.0;
    sp = fma(sp, r2, 1.0 / 6227020800.0);
    sp = fma(sp, r2, -1.0 / 39916800.0);
    sp = fma(sp, r2, 1.0 / 362880.0);
    sp = fma(sp, r2, -1.0 / 5040.0);
    sp = fma(sp, r2, 1.0 / 120.0);
    sp = fma(sp, r2, -1.0 / 6.0);
    const double sn = fma(sp * r2, r, r);
    double cp = 1.0 / 20922789888000.0;
    cp = fma(cp, r2, -1.0 / 87178291200.0);
    cp = fma(cp, r2, 1.0 / 479001600.0);
    cp = fma(cp, r2, -1.0 / 3628800.0);
    cp = fma(cp, r2, 1.0 / 40320.0);
    cp = fma(cp, r2, -1.0 / 720.0);
    cp = fma(cp, r2, 1.0 / 24.0);
    cp = fma(cp, r2, -0.5);
    const double cs = fma(cp, r2, 1.0);
    const int q = ((int)k) & 3;
    const double ss = (q == 0) ? sn : (q == 1) ? cs : (q == 2) ? -sn : -cs;
    const double cc = (q == 0) ? cs : (q == 1) ? -sn : (q == 2) ? -cs : sn;
    s = (float)ss; c = (float)cc;
}


#define XB_TMO      128
#define XB_XCNT(j)  (256  + 64 * (j))
#define XB_XSUB(j)  (1280 + 64 * (j))
#define XB_XGEN(j)  (2304 + 64 * (j))
#define XB_TOP      3328
#define XB_TOPGEN   3392
#define XCD_BAR_WORDS 3456
#define XB_SPIN_CAP (1u << 22)
__device__ __forceinline__ unsigned xb_ld(unsigned* p)              { return __hip_atomic_load(p, __ATOMIC_RELAXED, __HIP_MEMORY_SCOPE_AGENT); }
__device__ __forceinline__ unsigned xb_add(unsigned* p, unsigned v) { return __hip_atomic_fetch_add(p, v, __ATOMIC_RELAXED, __HIP_MEMORY_SCOPE_AGENT); }
__device__ __forceinline__ unsigned xb_xcc_id() { return (unsigned)__builtin_amdgcn_s_getreg((3 << 11) | 20) & 0xFu; }
#define XB_SPIN(cond, bar) do { unsigned _sp = 0; while (cond) { __builtin_amdgcn_s_sleep(1); \
    if ((++_sp & 255u) == 0u) { if (xb_ld(&(bar)[XB_TMO])) break; if (_sp > XB_SPIN_CAP) { atomicAdd(&(bar)[XB_TMO], 1u); break; } } } } while (0)
struct XcdBarrier { unsigned* bar; unsigned x; volatile LAS unsigned* st; };
__device__ __forceinline__ XcdBarrier xcd_barrier_post(unsigned* bar, volatile LAS unsigned* st) {
    XcdBarrier b; b.bar = bar; b.x = xb_xcc_id(); b.st = st;
    if (threadIdx.x == 0) (void)xb_add(&bar[XB_XCNT(b.x)], 1u);
    return b;
}
__device__ __forceinline__ void xcd_barrier_complete(unsigned* bar, unsigned x, unsigned& nloc, unsigned& nx) {
    const unsigned G = gridDim.x * gridDim.y * gridDim.z;
    unsigned sum, cnt, mine, sp = 0u;
    for (;;) {
        sum = 0u; cnt = 0u; mine = 0u;
#pragma unroll
        for (unsigned j = 0; j < 16; ++j) { const unsigned c = xb_ld(&bar[XB_XCNT(j)]); sum += c; cnt += (c > 0u) ? 1u : 0u; mine = (j == x) ? c : mine; }
        if (sum == G) break;
        __builtin_amdgcn_s_sleep(1);
        if ((++sp & 255u) == 0u) { if (xb_ld(&bar[XB_TMO])) break; if (sp > XB_SPIN_CAP) { atomicAdd(&bar[XB_TMO], 1u); break; } }
    }
    nloc = mine > 0u ? mine : 1u; nx = cnt > 0u ? cnt : 1u;
}
__device__ __forceinline__ void xcd_barrier(const XcdBarrier& b) {
    asm volatile("s_waitcnt vmcnt(0)" ::: "memory");
    __syncthreads();
    if (threadIdx.x == 0) {
        unsigned* bar = b.bar;
        __builtin_amdgcn_s_waitcnt(0);
        unsigned nloc = b.st[0], nx = b.st[1];
        if (nloc == 0u) { xcd_barrier_complete(bar, b.x, nloc, nx); b.st[0] = nloc; b.st[1] = nx; }
        const unsigned old = xb_add(&bar[XB_XSUB(b.x)], 1u);
        const unsigned gen = old / nloc;
        if (old + 1u == (gen + 1u) * nloc) {
            __builtin_amdgcn_fence(__ATOMIC_RELEASE, "agent");
            asm volatile("s_waitcnt vmcnt(0)" ::: "memory");
            const unsigned og = xb_add(&bar[XB_TOP], 1u);
            const unsigned tg = og / nx;
            if (og + 1u == (tg + 1u) * nx) xb_add(&bar[XB_TOPGEN], 1u);
            else XB_SPIN(xb_ld(&bar[XB_TOPGEN]) == tg, bar);
            __builtin_amdgcn_fence(__ATOMIC_ACQUIRE, "agent");
            xb_add(&bar[XB_XGEN(b.x)], 1u);
            asm volatile("s_waitcnt vmcnt(0)" ::: "memory");
        } else {
            XB_SPIN(xb_ld(&bar[XB_XGEN(b.x)]) == gen, bar);
            __builtin_amdgcn_fence(__ATOMIC_ACQUIRE, "agent");
            asm volatile("s_waitcnt vmcnt(0)" ::: "memory");
        }
    }
    __syncthreads();
}

template <int ph>
__device__ __forceinline__ void run_phase(LAS unsigned char* lds, const Args& A) {
    {
        int tid = threadIdx.x; asm volatile("" : "+v"(tid));
        const int lane = tid & 63, wave = __builtin_amdgcn_readfirstlane(tid >> 6);
        int G = gridDim.x, bx = blockIdx.x; asm volatile("" : "+s"(G), "+s"(bx));
        const int gw = bx * NWAVES + wave, NGW = G * NWAVES;
        const int gt = bx * NTHREADS + tid, NGT = G * NTHREADS;
        unsigned char* ws = A.ws;
        float* MOD = (float*)(ws + WS_MOD);
        float* ROPE = (float*)(ws + WS_ROPE);
        f16* HALO = (f16*)(ws + WS_HALO);
        f16* Hb = (f16*)(ws + WS_H);
        f16* KCMP = (f16*)(ws + WS_KCMP);
        float* Gt = (float*)(ws + WS_G);
        unsigned* SEL = (unsigned*)(ws + WS_SEL);
        f16* U = (f16*)(ws + WS_U);
        f16* RAWb = (f16*)(ws + WS_RAW);
        f16* PROJ = (f16*)(ws + WS_PROJ);
        float* IMP = (float*)(ws + WS_IMP);
        float* OC = (float*)(ws + WS_OC);
        f16* ATT = (f16*)(ws + WS_ATT);
        f16* MIX = (f16*)(ws + WS_MIX);
        f16* Qb = (f16*)(ws + WS_Q);
        f16* KVb = (f16*)(ws + WS_KV);
        f16* CBb = (f16*)(ws + WS_CB);
        f16* Pb = (f16*)(ws + WS_P);
        constexpr int l = (ph >= 1 && ph < 21) ? (ph - 1) / 10 : 0;
        constexpr int k = (ph >= 1 && ph < 21) ? (ph - 1) % 10 : (ph == 0 ? 100 : 101);
        unsigned char* wl = ws + WS_W + (size_t)l * W_LAYER;
        f16* Win_t = (f16*)(wl + W_IN_OFF); f16* Wout_t = (f16*)(wl + W_OUT_OFF); f16* Wup_t = (f16*)(wl + W_UP_OFF); f16* Wdown_t = (f16*)(wl + W_DOWN_OFF);
        const float* modl = MOD + (size_t)l * 16 * 6144;

        if (PH_EN(14) && k == 100) {
            {
                LAS float* scr = (LAS float*)(lds + wave * 16384);
                constexpr int I_IN = 16 * (NINP / 32), I_OUT = 16 * 32, I_UP = 16 * (NUP / 32), I_DN = (DFF / 64) * 32, I_L = I_IN + I_OUT + I_UP + I_DN;
                for (int it = gw; it < 2 * I_L; it += NGW) {
                    const int ll = it / I_L; int r = it % I_L;
                    unsigned char* wll = ws + WS_W + (size_t)ll * W_LAYER;
                    if (r < I_IN) { transpose_item(A.w_in + (size_t)ll * DM * NIN, DM, NIN, NINP, (f16*)(wll + W_IN_OFF), scr, r, lane, 1, 0); continue; } r -= I_IN;
                    if (r < I_OUT) { transpose_item(A.w_out + (size_t)ll * DM * DM, DM, DM, DM, (f16*)(wll + W_OUT_OFF), scr, r, lane); continue; } r -= I_OUT;
                    if (r < I_UP) { transpose_item(A.ffn_up + (size_t)ll * DM * NUP, DM, NUP, NUP, (f16*)(wll + W_UP_OFF), scr, r, lane, 3, 0); continue; } r -= I_UP;
                    transpose_item(A.ffn_down + (size_t)ll * DFF * DM, DFF, DM, DM, (f16*)(wll + W_DOWN_OFF), scr, r, lane);
                }
                for (int it = gw; it < 4 * 128 + 4 * 4; it += NGW) {
                    if (it < 512) { const int mi = it >> 7, ll = mi >> 1, kv = mi & 1;
                        transpose_item((kv ? A.w1_v : A.w1_k) + (size_t)ll * 2048 * 128, 2048, 128, 128, (f16*)(ws + WS_W1T) + (size_t)mi * 128 * 2048, scr, it & 127, lane, 0, kv == 0 ? 1 : 0); }
                    else { const int r = it - 512, mi = r >> 2, ll = mi >> 1, kv = mi & 1;
                        transpose_item((kv ? A.w2_v : A.w2_k) + (size_t)ll * 128 * 64, 128, 64, 64, (f16*)(ws + WS_W2T) + (size_t)mi * 64 * 128, scr, r & 3, lane, kv == 0 ? 2 : 0, 0); }
                }
            }
            __syncthreads();
            for (int it = gt; it < MTOK * 8; it += NGT) {
                const int m = it >> 3, i = it & 7;
                const double fr = (i == 0) ? 1.0 : (i == 1) ? 0.19392274474868576 : (i == 2) ? 0.03760603093086393 : (i == 3) ? 0.007292664737217109 :
                                  (i == 4) ? 0.001414213562373095 : (i == 5) ? 0.0002742481756762073 : (i == 6) ? 5.318295896944988e-05 : 1.031338537721246e-05;
                float s, c; sincos_d((double)A.pos[m] * fr, s, c);
                ROPE[(size_t)m * 16 + i] = c; ROPE[(size_t)m * 16 + 8 + i] = s;
            }
            {
                LAS float* red = (LAS float*)(lds + 65536);
                for (int it = G - 1 - bx; it < 8; it += G) {
                    const int mi = it >> 1, ll = mi >> 1, kv = mi & 1, n0 = (it & 1) * 64;
                    const float* pe = (kv ? A.pe_v : A.pe_k) + (size_t)ll * 2048; const float* w1 = (kv ? A.w1_v : A.w1_k) + (size_t)ll * 2048 * 128 + n0 + lane;
                    float acc = 0.f;
                    for (int ld = wave * 256; ld < wave * 256 + 256; ld += 8) {
                        float w[8];
#pragma unroll
                        for (int u = 0; u < 8; ++u) w[u] = w1[(size_t)(ld + u) * 128];
#pragma unroll
                        for (int u = 0; u < 8; ++u) acc = fmaf(pe[ld + u], w[u], acc);
                    }
                    __syncthreads();
                    red[wave * 64 + lane] = acc;
                    __syncthreads();
                    if (tid < 64) { float sacc = 0.f;
#pragma unroll
                        for (int w8 = 0; w8 < 8; ++w8) sacc += red[w8 * 64 + tid];
                        ((float*)(ws + WS_BPE))[mi * 128 + n0 + tid] = sacc; }
                }
                __syncthreads();
            }
            {
                LAS float* ca = (LAS float*)lds;
                LAS float* red = (LAS float*)(lds + 65536);
                bool staged = false;
                for (int it = bx; it < 2 * 96; it += G) {
                    if (!staged) { for (int i = tid; i < 16 * 1024; i += NTHREADS) ca[i] = silu_f(A.c[i]); staged = true; }
                    __syncthreads();
                    const int ll = it / 96, n0 = (it % 96) * 64;
                    const float* wm = A.w_mod + (size_t)ll * DM * 6144 + n0 + lane;
                    float acc[16];
#pragma unroll
                    for (int b = 0; b < 16; ++b) acc[b] = 0.f;
                    for (int kk = wave * 128; kk < wave * 128 + 128; kk += 8) {
                        float w[8];
#pragma unroll
                        for (int u = 0; u < 8; ++u) w[u] = wm[(size_t)(kk + u) * 6144];
#pragma unroll
                        for (int u = 0; u < 8; ++u)
#pragma unroll
                            for (int b = 0; b < 16; ++b) acc[b] = fmaf(ca[b * 1024 + kk + u], w[u], acc[b]);
                    }
#pragma unroll
                    for (int b = 0; b < 16; ++b) red[(wave * 16 + b) * 64 + lane] = acc[b];
                    __syncthreads();
                    for (int o = tid; o < 1024; o += NTHREADS) { const int b = o >> 6, n = o & 63; float s = 0.f;
#pragma unroll
                        for (int w8 = 0; w8 < 8; ++w8) s += red[(w8 * 16 + b) * 64 + n];
                        MOD[((size_t)ll * 16 + b) * 6144 + n0 + n] = s + A.b_mod[(size_t)ll * 6144 + n0 + n]; }
                    __syncthreads();
                }
            }
        } else if (PH_EN(0) && (k == 0 || k == 6)) {
            const float* xin = (k == 0 && l == 0) ? A.x : A.out;
            const float* gain = (k == 0 ? A.norm1_g : A.norm2_g) + (size_t)l * DM;
            const float* shp = modl + (k == 0 ? 0 : 3) * 1024; const float* scp = modl + (k == 0 ? 1 : 4) * 1024;
            for (int m = gw; m < MTOK; m += NGW) {
                const int b = m >> 11;
                const f32x4* xr = (const f32x4*)(xin + (size_t)m * DM) + lane;
                f32x4 v[4]; float s = 0.f;
#pragma unroll
                for (int j = 0; j < 4; ++j) { v[j] = xr[64 * j]; s += (v[j].x * v[j].x + v[j].y * v[j].y) + (v[j].z * v[j].z + v[j].w * v[j].w); }
                const float r = 1.0f / sqrtf(wave_sum(s) * (1.0f / DM) + 1e-6f);
#pragma unroll
                for (int j = 0; j < 4; ++j) { const int col = 4 * lane + 256 * j;
                    const f32x4 g4 = *(const f32x4*)(gain + col), sc4 = *(const f32x4*)(scp + (size_t)b * 6144 + col), sh4 = *(const f32x4*)(shp + (size_t)b * 6144 + col);
                    const f32x4 o = (v[j] * r) * g4 * (sc4 + 1.0f) + sh4;
                    u32x2 w; w.x = pk2h(o.x, o.y); w.y = pk2h(o.z, o.w);
                    *(u32x2*)(Hb + (size_t)m * DM + col) = w; }
            }
        } else if (PH_EN(1) && (k == 1 || k == 7)) {
            if (k == 1) {
                const pg8::Gemm g{Hb, Win_t, MTOK, NINP, DM, DM}; const pg8::EpiIn E{Qb, KVb, CBb, Pb, Gt, ROPE};
                pg8::StaticOrder S; S.init(g.M, g.N, G, bx);
                pg8::gemm_phase<pg8::EpiIn, pg8::StaticOrder, true, true>(lds, g, S, E, tid);
            } else {
                const pg8::Gemm g{Hb, Wup_t, MTOK, NUP, DM, DM}; const pg8::EpiUp E{U, HALO, RAWb, A.ffn_conv + (size_t)l * 3 * NUP, (LAS float*)(lds + RING_BYTES + 2048)};
                pg8::StaticOrder S; S.init(g.M, g.N, G, bx);
                pg8::gemm_phase<pg8::EpiUp, pg8::StaticOrder, true, true>(lds, g, S, E, tid);
            }
        } else if (PH_EN(8) && (k == 5 || k == 9)) {
            pg8::Gemm g; pg8::EpiResid E;
            if (k == 5) { g = pg8::Gemm{MIX, Wout_t, MTOK, DM, DM, DM}; E = pg8::EpiResid{(l == 0) ? A.x : A.out, A.out, modl + 2 * 1024}; }
            else { g = pg8::Gemm{U, Wdown_t, MTOK, DM, DFF, DFF}; E = pg8::EpiResid{A.out, A.out, modl + 5 * 1024}; }
            pg8::StaticOrder S; S.init(g.M, g.N, G, bx);
            pg8::gemm_phase<pg8::EpiResid, pg8::StaticOrder, true, true>(lds, g, S, E, tid);
        } else if (PH_EN(3) && k == 2) {
            typedef float f32x4v __attribute__((ext_vector_type(4)));
            constexpr int HS = 136;
            LAS f16* hid = (LAS f16*)lds;
            for (int it = bx; it < 256; it += G) {
                const int grp = it >> 2, j0 = 32 * (it & 3), kv = grp >> 5, b = (grp >> 1) & 15, hk = grp & 1;
                const int rt = wave >> 2, cg4 = wave & 3, fr = lane & 15, fq = lane >> 4;
                const f16* src = KVb + (size_t)kv * (KV_STRIDE / 2) + (size_t)b * SEQ * 128 + hk * 64 + 8 * fq;
                const int jrow = j0 + 16 * rt + fr;
                const f16* w1t = (const f16*)(ws + WS_W1T) + (size_t)(l * 2 + kv) * 128 * 2048 + (size_t)(32 * cg4 + fr) * 2048 + 8 * fq;
                f32x4v acc0 = {0.f, 0.f, 0.f, 0.f}, acc1 = {0.f, 0.f, 0.f, 0.f};
#pragma unroll 8
                for (int kk = 0; kk < 64; ++kk) {
                    const int tok = min(16 * jrow + (kk >> 1), SEQ - 1);
                    const f16x8 a = *(const f16x8*)(src + (size_t)tok * 128 + 32 * (kk & 1));
                    const f16x8 b0 = *(const f16x8*)(w1t + 32 * kk), b1 = *(const f16x8*)(w1t + 16 * 2048 + 32 * kk);
                    acc0 = __builtin_amdgcn_mfma_f32_16x16x32_f16(a, b0, acc0, 0, 0, 0);
                    acc1 = __builtin_amdgcn_mfma_f32_16x16x32_f16(a, b1, acc1, 0, 0, 0);
                }
                const float* bpe = (const float*)(ws + WS_BPE) + (l * 2 + kv) * 128 + 32 * cg4 + fr;
                const float bp0 = bpe[0], bp1 = bpe[16];
                __syncthreads();
#pragma unroll
                for (int r = 0; r < 4; ++r) { const int row = 16 * rt + 4 * fq + r;
                    hid[row * HS + 32 * cg4 + fr] = (f16)silu_f(acc0[r] + bp0); hid[row * HS + 32 * cg4 + 16 + fr] = (f16)silu_f(acc1[r] + bp1); }
                __syncthreads();
                const f16* w2t = (const f16*)(ws + WS_W2T) + (size_t)(l * 2 + kv) * 64 * 128 + (size_t)(16 * cg4 + fr) * 128 + 8 * fq;
                f32x4v o = {0.f, 0.f, 0.f, 0.f};
#pragma unroll
                for (int ks = 0; ks < 4; ++ks) {
                    const f16x8 a = *(const LAS f16x8*)(hid + (16 * rt + fr) * HS + 32 * ks + 8 * fq);
                    const f16x8 bb = *(const f16x8*)(w2t + 32 * ks);
                    o = __builtin_amdgcn_mfma_f32_16x16x32_f16(a, bb, o, 0, 0, 0);
                }
#pragma unroll
                for (int r = 0; r < 4; ++r) { const int jj = j0 + 16 * rt + 4 * fq + r;
                    KCMP[(((size_t)kv * 16 + b) * 2 + hk) * 128 * 64 + (size_t)jj * 64 + 16 * cg4 + fr] = (jj < 127) ? (f16)o[r] : (f16)0.f; }
            }
        } else if (PH_EN(4) && k == 3) {
            for (int it = bx; it < 1024; it += G) {
                const int i4 = it >> 8, c = it & 255, vcu = (c & 7) * 32 + (c >> 3), bh = vcu >> 3, sq = vcu & 7;
                const int qb = (i4 == 0) ? sq : (i4 == 1) ? 15 - sq : (i4 == 2) ? 16 + sq : 31 - sq;
                int tidu = tid; asm volatile("" : "+v"(tidu));
                att::attn_unit(lds, bh >> 1, bh & 1, qb, Qb, KVb, KCMP, Gt, ATT, tidu);
            }
        } else if (PH_EN(7) && k == 4) {
            const float* ga = A.g_attn + (size_t)l * 512; const float* gc = A.g_conv + (size_t)l * 512; const float* cw = A.conv_w + (size_t)l * 3 * 512;
            for (int m = gw; m < MTOK; m += NGW) {
                const int t = m & (SEQ - 1); const int c0 = 8 * lane;
                { const f16x8 v = *(const f16x8*)(ATT + (size_t)m * 512 + c0); float f[8]; float s = 0.f;
#pragma unroll
                    for (int e = 0; e < 8; ++e) { f[e] = (float)v[e]; s += f[e] * f[e]; }
                    const float r = 1.0f / sqrtf(wave_sum(s) * (1.0f / 512.0f) + 1e-6f);
                    u32x4 w; w.x = pk2h(f[0] * r * ga[c0 + 0], f[1] * r * ga[c0 + 1]); w.y = pk2h(f[2] * r * ga[c0 + 2], f[3] * r * ga[c0 + 3]);
                    w.z = pk2h(f[4] * r * ga[c0 + 4], f[5] * r * ga[c0 + 5]); w.w = pk2h(f[6] * r * ga[c0 + 6], f[7] * r * ga[c0 + 7]);
                    *(u32x4*)(MIX + (size_t)m * DM + c0) = w; }
                { const f16x8 p0 = *(const f16x8*)(Pb + (size_t)m * 512 + c0);
                    f16x8 p1 = (f16x8)(f16)0.f, p2 = (f16x8)(f16)0.f;
                    if (t >= 1) p1 = *(const f16x8*)(Pb + (size_t)(m - 1) * 512 + c0);
                    if (t >= 2) p2 = *(const f16x8*)(Pb + (size_t)(m - 2) * 512 + c0);
                    const f16x8 cb = *(const f16x8*)(CBb + (size_t)m * 512 + c0);
                    float f[8]; float s = 0.f;
#pragma unroll
                    for (int e = 0; e < 8; ++e) { const float y = cw[c0 + e] * (float)p2[e] + cw[512 + c0 + e] * (float)p1[e] + cw[1024 + c0 + e] * (float)p0[e];
                        f[e] = (float)cb[e] * y; s += f[e] * f[e]; }
                    const float r = 1.0f / sqrtf(wave_sum(s) * (1.0f / 512.0f) + 1e-6f);
                    u32x4 w; w.x = pk2h(f[0] * r * gc[c0 + 0], f[1] * r * gc[c0 + 1]); w.y = pk2h(f[2] * r * gc[c0 + 2], f[3] * r * gc[c0 + 3]);
                    w.z = pk2h(f[4] * r * gc[c0 + 4], f[5] * r * gc[c0 + 5]); w.w = pk2h(f[6] * r * gc[c0 + 6], f[7] * r * gc[c0 + 7]);
                    *(u32x4*)(MIX + (size_t)m * DM + 512 + c0) = w; }
            }
        } else if (PH_EN(12) && k == 8) {
            const float* fc = A.ffn_conv + (size_t)l * 3 * NUP;
            for (int it = gt; it < 128 * 2 * (DFF / 4); it += NGT) {
                const int i = it % (DFF / 4), rr = (it / (DFF / 4)) & 1, pm = it / (2 * (DFF / 4)); const int c = 8 * i, f0 = 4 * i;
                const f16x8 cur = *(const f16x8*)(RAWb + ((size_t)pm * 2 + rr) * NUP + c);
                f16x8 p1 = (f16x8)(f16)0.f, p2 = (f16x8)(f16)0.f;
                if ((pm & 7) != 0) { const f16* hp = HALO + (size_t)(4 * pm - 1) * 2 * NUP + c;
                    if (rr == 0) { p1 = *(const f16x8*)(hp + NUP); p2 = *(const f16x8*)hp; } else p2 = *(const f16x8*)(hp + NUP); }
                if (rr == 1) p1 = *(const f16x8*)(RAWb + (size_t)pm * 2 * NUP + c);
                float o[4];
#pragma unroll
                for (int e = 0; e < 4; ++e) {
                    const float ya = fc[f0 + e] * (float)p2[e] + fc[NUP + f0 + e] * (float)p1[e] + fc[2 * NUP + f0 + e] * (float)cur[e];
                    const float yv = fc[DFF + f0 + e] * (float)p2[4 + e] + fc[NUP + DFF + f0 + e] * (float)p1[4 + e] + fc[2 * NUP + DFF + f0 + e] * (float)cur[4 + e];
                    o[e] = silu_f(ya) * yv; }
                u32x2 w; w.x = pk2h(o[0], o[1]); w.y = pk2h(o[2], o[3]);
                *(u32x2*)(U + (size_t)(256 * pm + rr) * DFF + f0) = w;
            }
        } else if (PH_EN(15) && k == 101) {
            for (int m = gw; m < MTOK; m += NGW) {
                f32x4* xr = (f32x4*)(A.out + (size_t)m * DM) + lane;
                f32x4 v[4]; float s = 0.f;
#pragma unroll
                for (int j = 0; j < 4; ++j) { v[j] = xr[64 * j]; s += (v[j].x * v[j].x + v[j].y * v[j].y) + (v[j].z * v[j].z + v[j].w * v[j].w); }
                const float r = 1.0f / sqrtf(wave_sum(s) * (1.0f / DM) + 1e-6f);
#pragma unroll
                for (int j = 0; j < 4; ++j) { const f32x4 g4 = *(const f32x4*)(A.final_g + 4 * lane + 256 * j); xr[64 * j] = (v[j] * r) * g4; }
            }
        }
    }
}

__global__ void __launch_bounds__(NTHREADS, 2) fwd_kernel(Args A0) {
    extern __shared__ __attribute__((aligned(16))) unsigned char lds_raw[];
    LAS unsigned char* lds = (LAS unsigned char*)lds_raw;
    cg::grid_group grid = cg::this_grid();
    const int ph_lo = A0.ph_lo, ph_hi = A0.ph_hi;
    volatile LAS unsigned* bst = (volatile LAS unsigned*)(lds + RING_BYTES + 352);
    if (threadIdx.x < 2) bst[threadIdx.x] = 0u;
    __syncthreads();
    const XcdBarrier xbar = xcd_barrier_post((unsigned*)(A0.ws + WS_CTL) + 4096, bst);
#ifndef DUPMASK
#define DUPMASK 0u
#endif
#define DUP_K(P) (((P) >= 1 && (P) < 21) ? (((DUPMASK) >> (((P) - 1) % 10)) & 1u) : (((P) == 0) ? (((DUPMASK) >> 10) & 1u) : 0u))
#define STEP(P) if (ph_lo <= (P) && (P) < ph_hi) { run_phase<(P)>(lds, A0); if (DUP_K(P)) { __syncthreads(); run_phase<(P)>(lds, A0); } if ((P) + 1 < ph_hi) { if ((P) == 0) grid.sync(); else xcd_barrier(xbar); } }
    STEP(0) STEP(1) STEP(2) STEP(3) STEP(4) STEP(5) STEP(6) STEP(7) STEP(8) STEP(9)
    STEP(10) STEP(11) STEP(12) STEP(13) STEP(14) STEP(15) STEP(16) STEP(17) STEP(18) STEP(19)
    STEP(20) STEP(21)
#undef STEP
}

extern "C" void kernel_launch(void* const* d_in, const int* in_sizes, int n_in, void* d_out, int out_size, void* d_ws, size_t ws_size, hipStream_t stream) {
    static int grid = 0;
    if (grid == 0) {
        if (n_in != 22 || out_size != MTOK * DM || ws_size < WS_END) { fprintf(stderr, "kernel_launch: unexpected shapes (n_in %d out %d ws %zu)\n", n_in, out_size, ws_size); grid = -1; return; }
        int dev = 0, cus = 0, per_cu = 0;
        hipGetDevice(&dev);
        hipDeviceGetAttribute(&cus, hipDeviceAttributeMultiprocessorCount, dev);
        hipFuncSetAttribute((const void*)fwd_kernel, hipFuncAttributeMaxDynamicSharedMemorySize, LDS_BYTES);
        hipOccupancyMaxActiveBlocksPerMultiprocessor(&per_cu, (const void*)fwd_kernel, NTHREADS, LDS_BYTES);
        (void)hipGetLastError();
        if (per_cu < 1) per_cu = 1;
        grid = cus * per_cu;
    }
    if (grid < 0) return;
    if (hipMemsetAsync((char*)d_ws + WS_CTL, 0, 1 * MiB, stream) != hipSuccess) { fprintf(stderr, "kernel_launch: memset failed\n"); return; }
    Args a{};
    a.x = (const float*)d_in[0]; a.c = (const float*)d_in[1]; a.pos = (const int*)d_in[2]; a.w_mod = (const float*)d_in[3]; a.b_mod = (const float*)d_in[4];
    a.norm1_g = (const float*)d_in[5]; a.w_in = (const float*)d_in[6]; a.pe_k = (const float*)d_in[7]; a.w1_k = (const float*)d_in[8]; a.w2_k = (const float*)d_in[9];
    a.pe_v = (const float*)d_in[10]; a.w1_v = (const float*)d_in[11]; a.w2_v = (const float*)d_in[12]; a.conv_w = (const float*)d_in[13]; a.g_attn = (const float*)d_in[14];
    a.g_conv = (const float*)d_in[15]; a.w_out = (const float*)d_in[16]; a.norm2_g = (const float*)d_in[17]; a.ffn_up = (const float*)d_in[18]; a.ffn_conv = (const float*)d_in[19];
    a.ffn_down = (const float*)d_in[20]; a.final_g = (const float*)d_in[21];
    a.out = (float*)d_out; a.ws = (unsigned char*)d_ws;
#if MK_ONE_LAUNCH
    a.ph_lo = 0; a.ph_hi = NPH;
    void* args[] = {&a};
    hipError_t e = hipLaunchCooperativeKernel((const void*)fwd_kernel, dim3(grid), dim3(NTHREADS), args, LDS_BYTES, stream);
    if (e != hipSuccess) fprintf(stderr, "cooperative launch failed: %s (grid %d)\n", hipGetErrorString(e), grid);
#else
    for (int ph = 0; ph < NPH; ++ph) {
        a.ph_lo = ph; a.ph_hi = ph + 1;
        hipLaunchKernelGGL(fwd_kernel, dim3(grid), dim3(NTHREADS), LDS_BYTES, stream, a);
    }
#endif
}
```

```cpp
#include <hip/hip_runtime.h>
#include <hip/hip_cooperative_groups.h>
#include <cstdio>
#include <cstdint>
namespace cg = cooperative_groups;

#define LAS __attribute__((address_space(3)))
typedef _Float16 f16;
typedef _Float16 f16x8 __attribute__((ext_vector_type(8)));
typedef _Float16 f16x4 __attribute__((ext_vector_type(4)));
typedef _Float16 f16x2 __attribute__((ext_vector_type(2)));
typedef float f32x4 __attribute__((ext_vector_type(4)));
typedef float f32x2 __attribute__((ext_vector_type(2)));
typedef unsigned u32x4 __attribute__((ext_vector_type(4)));
typedef unsigned u32x2 __attribute__((ext_vector_type(2)));

#ifndef PHMASK
#define PHMASK 0xFFFFFu
#endif
#define PH_EN(b) (((PHMASK) >> (b)) & 1u)
#ifndef MK_ONE_LAUNCH
#define MK_ONE_LAUNCH 1
#endif

constexpr int BATCH = 16, SEQ = 2048, DM = 1024, MTOK = BATCH * SEQ;
constexpr int NIN = 2840, NINP = 3072, DFF = 2816, NUP = 2 * DFF;
constexpr int NWAVES = 8, NTHREADS = 512;
constexpr int NPH = 15;
__host__ __device__ constexpr int ph_l(int ph) { return (ph >= 8 && ph < 14) ? 1 : 0; }
__host__ __device__ constexpr int ph_k(int ph) { return ph == 0 ? 100 : ph == 14 ? 101 : ph == 1 ? 0 : (((ph - 2) % 6) < 3 ? ((ph - 2) % 6) + 1 : ((ph - 2) % 6) == 3 ? 5 : ((ph - 2) % 6) == 4 ? 7 : 9); }

constexpr size_t MiB = 1u << 20;
constexpr size_t WS_CTL = 0;
constexpr size_t WS_MOD = 1 * MiB;
constexpr size_t WS_ROPE = 2 * MiB;
constexpr size_t WS_W1T = 4 * MiB;
constexpr size_t WS_W2T = 6 * MiB;
constexpr size_t WS_BPE = 6 * MiB + 65536;
constexpr size_t WS_BIAS1 = 7 * MiB;
constexpr size_t WS_BIAS2 = 7 * MiB + 256 * 1024;
constexpr size_t WS_HALO = 8 * MiB;
constexpr size_t WS_W = 20 * MiB;
constexpr size_t W_IN_OFF = 0, W_OUT_OFF = 6 * MiB, W_UP_OFF = 8 * MiB, W_DOWN_OFF = 19 * MiB, W_LAYER = 25 * MiB;
constexpr size_t WS_H = 70 * MiB;
constexpr size_t WS_KCMP = 134 * MiB;
constexpr size_t WS_G = 135 * MiB;
constexpr size_t WS_SSP = 139 * MiB;
constexpr size_t WS_BIG = 140 * MiB;
constexpr size_t WS_U = WS_BIG;
constexpr size_t WS_MIX = WS_BIG + 128 * MiB;
constexpr size_t WS_Q = WS_BIG + 192 * MiB;
constexpr size_t WS_KV = WS_BIG + 224 * MiB;
constexpr size_t KV_STRIDE = 8 * MiB;
constexpr size_t WS_CB = WS_BIG + 272 * MiB;
constexpr size_t WS_P = WS_BIG + 304 * MiB;
constexpr size_t WS_SSA = WS_BIG + 344 * MiB;
constexpr size_t WS_SSC = WS_BIG + 345 * MiB;
constexpr size_t WS_XF = WS_H;
constexpr size_t WS_RAW = WS_BIG + 340 * MiB;
constexpr size_t WS_END = 512 * MiB;

constexpr int RING_BYTES = 131072;
constexpr int LDS_BYTES = 148480;

namespace pg8 {
constexpr int BM = 256, BK = 64, HALF = 128, HTB = HALF * BK * 2, STAGE_BYTES = 8 * HTB, NXCD = 8, WGM = 8;
__host__ __device__ __forceinline__ int lds_byte(int r, int c) { const int st = (r >> 4) * 2 + (c >> 5), rr = r & 15, cc = c & 31, ob = rr * 64 + cc * 2; return st * 1024 + (ob ^ (((ob >> 9) & 1) << 5)); }
__host__ __device__ __forceinline__ void stage_rc(int b, int& R, int& C) { const int st = b / 1024, sb = b % 1024, swz = sb ^ (((sb >> 9) & 1) << 5); R = (st >> 1) * 16 + swz / 64; C = (st & 1) * 32 + (swz % 64) / 2; }
__host__ __device__ __forceinline__ int perm32(int rho) { const int n = rho >> 4, i = rho & 15; return 8 * (i >> 2) + 4 * n + (i & 3); }

struct Unit { int pm, pn; };
struct Gemm { const f16* A; const f16* Bt; int M, N, K, lda; };

struct StaticOrder {
    int nM, nN, nwg, G, c;
    __device__ void init(int M, int N, int G_, int c_) { nM = M / BM; nN = N / BM; nwg = nM * nN; G = G_; c = c_; }
    __device__ bool next(int i, Unit& u) const {
        const long L = (long)i * G + c; if (L >= nwg) return false;
        int wgid = (int)L; { const int q = nwg / NXCD, r = nwg % NXCD, xcd = wgid % NXCD, off = wgid / NXCD; wgid = (xcd < r ? xcd * (q + 1) : r * (q + 1) + (xcd - r) * q) + off; }
        const int nig = WGM * nN, gid = wgid / nig, fm = gid * WGM, gsz = (nM - fm) < WGM ? (nM - fm) : WGM;
        u.pm = fm + ((wgid % nig) % gsz); u.pn = (wgid % nig) / gsz; return true;
    }
};

__device__ __forceinline__ unsigned pk_f16(float lo, float hi) { f32x2 v = {lo, hi}; f16x2 h = __builtin_convertvector(v, f16x2); return __builtin_bit_cast(unsigned, h); }


struct EpiUp {
    static constexpr bool PERM = true; static constexpr bool MID = false; static constexpr bool PREF = true;
    f16* ACT; f16* halo; f16* raw; const float* fc; LAS float* hal; const float* ssp; const float* bias; LAS float* wst;
    LAS unsigned char* lb;
    static __device__ __forceinline__ int ssp_off(int chunk) { return chunk == 0 ? 14336 : chunk == 1 ? 15360 : chunk == 2 ? 1024 : 16384; }
    __device__ __forceinline__ void pref(const Unit& u, int wide) const {
        if (wide < 5) { unsigned z_ = 0u; asm volatile("" : "+v"(z_)); const int ln_ = (int)__builtin_amdgcn_mbcnt_hi(~0u, __builtin_amdgcn_mbcnt_lo(~0u, z_)); unsigned keep;
            const float* bs = (wide < 4) ? ssp : bias;
            const unsigned soff = (wide < 4) ? (unsigned)(((u.pm * BM + 64 * wide + ln_) * 4) * 4) : (unsigned)(((((u.pm * BM) >> 11) * NUP) + u.pn * BM + 4 * ln_) * 4);
            const unsigned dst = (unsigned)__builtin_amdgcn_readfirstlane((int)((unsigned)(__UINTPTR_TYPE__)lb + (wide < 4 ? ssp_off(wide) : 10240)));
            asm volatile("s_mov_b32 %0, m0\n\ts_mov_b32 m0, %2\n\ts_nop 0\n\tglobal_load_lds_dwordx4 %1, %3\n\ts_mov_b32 m0, %0" : "=&s"(keep) : "v"(soff), "s"(dst), "s"(bs) : "memory"); }
    }
    template <int CTRL> static __device__ __forceinline__ float dpp(float x) { return __builtin_bit_cast(float, __builtin_amdgcn_update_dpp(0, __builtin_bit_cast(int, x), CTRL, 0xf, 0xf, true)); }
    static __device__ __forceinline__ f32x4 conv4(const f32x4 y, const f32x4 c, const f32x4 p, const f32x4 w0, const f32x4 w1) {
        float y0 = y[0], y1 = y[1], y2 = y[2], y3 = y[3];
        asm("s_nop 1\n\t"
            "v_fmac_f32_dpp %0, %4, %16 row_shr:1 row_mask:0xf bank_mask:0xf bound_ctrl:1\n\t"
            "v_fmac_f32_dpp %1, %5, %17 row_shr:1 row_mask:0xf bank_mask:0xf bound_ctrl:1\n\t"
            "v_fmac_f32_dpp %2, %6, %18 row_shr:1 row_mask:0xf bank_mask:0xf bound_ctrl:1\n\t"
            "v_fmac_f32_dpp %3, %7, %19 row_shr:1 row_mask:0xf bank_mask:0xf bound_ctrl:1\n\t"
            "v_fmac_f32_dpp %0, %8, %16 row_shl:15 row_mask:0xf bank_mask:0xf bound_ctrl:1\n\t"
            "v_fmac_f32_dpp %1, %9, %17 row_shl:15 row_mask:0xf bank_mask:0xf bound_ctrl:1\n\t"
            "v_fmac_f32_dpp %2, %10, %18 row_shl:15 row_mask:0xf bank_mask:0xf bound_ctrl:1\n\t"
            "v_fmac_f32_dpp %3, %11, %19 row_shl:15 row_mask:0xf bank_mask:0xf bound_ctrl:1\n\t"
            "v_fmac_f32_dpp %0, %4, %12 row_shr:2 row_mask:0xf bank_mask:0xf bound_ctrl:1\n\t"
            "v_fmac_f32_dpp %1, %5, %13 row_shr:2 row_mask:0xf bank_mask:0xf bound_ctrl:1\n\t"
            "v_fmac_f32_dpp %2, %6, %14 row_shr:2 row_mask:0xf bank_mask:0xf bound_ctrl:1\n\t"
            "v_fmac_f32_dpp %3, %7, %15 row_shr:2 row_mask:0xf bank_mask:0xf bound_ctrl:1\n\t"
            "v_fmac_f32_dpp %0, %8, %12 row_shl:14 row_mask:0xf bank_mask:0xf bound_ctrl:1\n\t"
            "v_fmac_f32_dpp %1, %9, %13 row_shl:14 row_mask:0xf bank_mask:0xf bound_ctrl:1\n\t"
            "v_fmac_f32_dpp %2, %10, %14 row_shl:14 row_mask:0xf bank_mask:0xf bound_ctrl:1\n\t"
            "v_fmac_f32_dpp %3, %11, %15 row_shl:14 row_mask:0xf bank_mask:0xf bound_ctrl:1"
            : "+v"(y0), "+v"(y1), "+v"(y2), "+v"(y3)
            : "v"(c[0]), "v"(c[1]), "v"(c[2]), "v"(c[3]), "v"(p[0]), "v"(p[1]), "v"(p[2]), "v"(p[3]),
              "v"(w0[0]), "v"(w0[1]), "v"(w0[2]), "v"(w0[3]), "v"(w1[0]), "v"(w1[1]), "v"(w1[2]), "v"(w1[3]));
        return (f32x4){y0, y1, y2, y3};
    }
    __device__ __forceinline__ void operator()(f32x4 (&acc)[2][2][4][2], const Unit& u, int wr, int wc, int fr, int fq, const bool has_next, const Unit& nxt) const {
        const int row0 = u.pm * BM + wr * 64 + fr; const int col0 = u.pn * BM + wc * 32 + 8 * fq; const int f0b = (col0 >> 1);
        const int wide = wr * 4 + wc;
        if (wide < 3) { unsigned z_ = 0u; asm volatile("" : "+v"(z_)); const int ln_ = (int)__builtin_amdgcn_mbcnt_hi(~0u, __builtin_amdgcn_mbcnt_lo(~0u, z_));
            const int tide = wide * 64 + ln_, k6 = tide >> 5, i4 = tide & 31; unsigned keep;
            const unsigned soff = (unsigned)(((k6 % 3) * NUP + (k6 >= 3 ? DFF : 0) + u.pn * 128 + 4 * i4) * 4);
            const unsigned dst = (unsigned)__builtin_amdgcn_readfirstlane((int)((unsigned)(__UINTPTR_TYPE__)wst + wide * 1024));
            asm volatile("s_mov_b32 %0, m0\n\ts_mov_b32 m0, %2\n\ts_nop 0\n\tglobal_load_lds_dwordx4 %1, %3\n\ts_mov_b32 m0, %0" : "=&s"(keep) : "v"(soff), "s"(dst), "s"(fc) : "memory"); }
        { int fl_ = fq * 16 + fr; asm volatile("" : "+v"(fl_));
          const LAS float* bp = (const LAS float*)(lb + 10240) + wc * 32 + 8 * (fl_ >> 4); f32x4 bv[2][2];
#pragma unroll
          for (int bj = 0; bj < 2; ++bj) { bv[bj][0] = *(const LAS f32x4*)(bp + bj * HALF); bv[bj][1] = *(const LAS f32x4*)(bp + bj * HALF + 4); }
#pragma unroll
          for (int ai = 0; ai < 2; ++ai)
#pragma unroll
            for (int m = 0; m < 4; ++m) { const f32x4 p4 = *(const LAS f32x4*)(lb + ssp_off(ai * 2 + wr) + (m * 16 + (fl_ & 15)) * 16);
                const float rs = __builtin_amdgcn_rsqf(((p4[0] + p4[1]) + (p4[2] + p4[3])) * (1.0f / DM) + 1e-6f);
#pragma unroll
                for (int bj = 0; bj < 2; ++bj) { acc[ai][bj][m][0] = acc[ai][bj][m][0] * rs + bv[bj][0]; acc[ai][bj][m][1] = acc[ai][bj][m][1] * rs + bv[bj][1]; }
                asm volatile("" ::: "memory"); } }
        if (fr >= 14) {
#pragma unroll
            for (int ai = 0; ai < 2; ++ai)
#pragma unroll
                for (int bj = 0; bj < 2; ++bj) { LAS float* sl = hal + ((((wr * 4 + wc) * 2) * 4 + fq) * 2 + (fr - 14)) * 8 + ai * 1024 + bj * 64;
                    *(LAS f32x4*)sl = acc[ai][bj][3][0]; *(LAS f32x4*)(sl + 4) = acc[ai][bj][3][1];
                    const f32x4 v0 = acc[ai][bj][3][0], v1 = acc[ai][bj][3][1];
                    u32x4 w; w.x = pk_f16(v0[0], v0[1]); w.y = pk_f16(v0[2], v0[3]); w.z = pk_f16(v1[0], v1[1]); w.w = pk_f16(v1[2], v1[3]);
                    const int row = row0 + ai * HALF + 48; *(u32x4*)(halo + ((size_t)(row >> 6) * 2 + (fr - 14)) * NUP + col0 + bj * HALF) = w; }
        }
        if (wr == 0 && fr < 2) {
#pragma unroll
            for (int bj = 0; bj < 2; ++bj) { const f32x4 v0 = acc[0][bj][0][0], v1 = acc[0][bj][0][1];
                u32x4 w; w.x = pk_f16(v0[0], v0[1]); w.y = pk_f16(v0[2], v0[3]); w.z = pk_f16(v1[0], v1[1]); w.w = pk_f16(v1[2], v1[3]);
                *(u32x4*)(raw + ((size_t)u.pm * 2 + fr) * NUP + col0 + bj * HALF) = w; }
        }
        if (wide < 3) asm volatile("s_waitcnt vmcnt(0)" ::: "memory");
        asm volatile("s_waitcnt lgkmcnt(0)\n\ts_barrier" ::: "memory");
        if (has_next) pref(nxt, wide);
#pragma unroll
        for (int bj = 0; bj < 2; ++bj) {
            const int f0 = f0b + 64 * bj;
            f32x4 wa[3], wv[3];
            int fql_ = fq; asm volatile("" : "+v"(fql_));
            const LAS float* wl_ = wst + wc * 16 + 4 * fql_ + 64 * bj;
#pragma unroll
            for (int kk = 0; kk < 3; ++kk) { wa[kk] = *(const LAS f32x4*)(wl_ + kk * 128); wv[kk] = *(const LAS f32x4*)(wl_ + (3 + kk) * 128); }
#pragma unroll
            for (int ai = 0; ai < 2; ++ai) {
                const int cb = 2 * ai + wr;
                f32x4 pa = {0.f, 0.f, 0.f, 0.f}, pv = {0.f, 0.f, 0.f, 0.f};
                if (cb >= 1 && fr >= 14) { const LAS float* sl = hal + (((((wr - 1) * 4 + wc) * 2) * 4 + fq) * 2 + (fr - 14)) * 8 + ai * 1024 + bj * 64;
                    pa = *(const LAS f32x4*)sl; pv = *(const LAS f32x4*)(sl + 4); }
#pragma unroll
                for (int m = 0; m < 4; ++m) { const f32x4 ca = acc[ai][bj][m][0], cv = acc[ai][bj][m][1]; f32x4 o;
                    const f32x4 ya4 = conv4(wa[2] * ca, ca, pa, wa[0], wa[1]), yv4 = conv4(wv[2] * cv, cv, pv, wv[0], wv[1]);
#pragma unroll
                    for (int e = 0; e < 4; ++e) { const float ya = ya4[e], yv = yv4[e];
                        o[e] = ya * __builtin_amdgcn_rcpf(1.0f + __expf(-ya)) * yv; }
                    u32x2 w; w.x = pk_f16(o[0], o[1]); w.y = pk_f16(o[2], o[3]);
                    *(u32x2*)(ACT + (size_t)(row0 + ai * HALF + m * 16) * DFF + f0) = w;
                    pa = ca; pv = cv; }
            }
        }
    }
};

template <bool NORM>
struct EpiIn {
    static constexpr bool PERM = true; static constexpr bool MID = false; static constexpr bool PREF = false;
    f16* Q; f16* KV; f16* CB; f16* P; float* Gt; const float* rope;
    const float* ssp; const float* bias;
    __device__ __forceinline__ void operator()(const f32x4 (&acc)[2][2][4][2], const Unit& u, int wr, int wc, int fr, int fq) const {
        const int row0 = u.pm * BM + wr * 64 + fr, pn = u.pn, cl = wc * 32 + 8 * fq;
        const bool ropelane = (cl & 63) < 16; const int ro = (cl & 8) ? 4 : 0;
        f32x4 bv[2][2];
        if (NORM) { const float* bp = bias + (size_t)((u.pm * BM) >> 11) * NINP + (256 * pn + cl);
#pragma unroll
            for (int bj = 0; bj < 2; ++bj) { bv[bj][0] = *(const f32x4*)(bp + 128 * bj); bv[bj][1] = *(const f32x4*)(bp + 128 * bj + 4); } }
#pragma unroll
        for (int ai = 0; ai < 2; ++ai) {
            f32x4 csv[4], snv[4], p4v[4]; float rsv[2][4];
            if (NORM) {
#pragma unroll
                for (int m = 0; m < 4; ++m) p4v[m] = *(const f32x4*)(ssp + (size_t)(row0 + ai * HALF + m * 16) * 4); }
            if (pn < 5) {
#pragma unroll
                for (int m = 0; m < 4; ++m) { const float* rp = rope + (size_t)(row0 + ai * HALF + m * 16) * 16 + ro; csv[m] = *(const f32x4*)rp; snv[m] = *(const f32x4*)(rp + 8); } }
            if (NORM) {
#pragma unroll
                for (int m = 0; m < 4; ++m) rsv[ai][m] = __builtin_amdgcn_rsqf(((p4v[m][0] + p4v[m][1]) + (p4v[m][2] + p4v[m][3])) * (1.0f / DM) + 1e-6f); }
#pragma unroll
            for (int m = 0; m < 4; ++m) { const int row = row0 + ai * HALF + m * 16;
                const f32x4 cs = csv[m], sn = snv[m];
#pragma unroll
                for (int bj = 0; bj < 2; ++bj) { f32x4 v0 = acc[ai][bj][m][0], v1 = acc[ai][bj][m][1];
                    if (NORM) { const float rs = rsv[ai][m]; v0 = v0 * rs + bv[bj][0]; v1 = v1 * rs + bv[bj][1]; }
                    if (pn < 5) {
                        if ((pn < 2 || bj == 0) && ropelane) { const f32x4 n0 = v0 * cs - v1 * sn, n1 = v1 * cs + v0 * sn; v0 = n0; v1 = n1; }
                        f16* dst;
                        if (pn < 2) { v0 = v0 * 0.18033688011112042f; v1 = v1 * 0.18033688011112042f; dst = Q + (size_t)row * 512 + (256 * pn + 128 * bj + cl); }
                        else dst = KV + (size_t)(2 * (pn - 2) + bj) * (KV_STRIDE / 2) + (size_t)row * 128 + cl;
                        u32x4 w; w.x = pk_f16(v0[0], v0[1]); w.y = pk_f16(v0[2], v0[3]); w.z = pk_f16(v1[0], v1[1]); w.w = pk_f16(v1[2], v1[3]);
                        *(u32x4*)dst = w;
                    } else if (pn < 7) {
                        u32x4 w; w.x = pk_f16(v0[0], v0[1]); w.y = pk_f16(v0[2], v0[3]); w.z = pk_f16(v1[0], v1[1]); w.w = pk_f16(v1[2], v1[3]);
                        *(u32x4*)(CB + (size_t)row * 512 + (256 * (pn - 5) + 128 * bj + cl)) = w;
                    } else if (pn < 11) {
                        const f32x4 pr = v0 * v1; u32x2 w; w.x = pk_f16(pr[0], pr[1]); w.y = pk_f16(pr[2], pr[3]);
                        *(u32x2*)(P + (size_t)row * 512 + ((256 * (pn - 7) + 128 * bj + cl) >> 1)) = w;
                    } else {
                        const int c = 128 * bj + cl;
                        if (c < 24) { f32x4 g0, g1;
#pragma unroll
                            for (int e = 0; e < 4; ++e) { g0[e] = 1.0f / (1.0f + __expf(-v0[e])); g1[e] = 1.0f / (1.0f + __expf(-v1[e])); }
                            *(f32x4*)(Gt + (size_t)row * 32 + c) = g0; *(f32x4*)(Gt + (size_t)row * 32 + c + 4) = g1; }
                    } } }
            asm volatile("" ::: "memory"); }
    }
};
template <bool XG, bool B16, bool O16, bool MIXM = false>
struct EpiResid {
    static constexpr bool PERM = true; static constexpr bool MID = MIXM; static constexpr bool PREF = false;
    const void* base; void* out; const float* gate;
    f16* xg; const float* gain; const float* sc; float* ssp; LAS float* part;
    const float* ssa; const float* ssc; LAS float* rat; LAS float* rcs;
    __device__ __forceinline__ void rows(int pm, int t) const {
        if (t < 256) { const size_t row = (size_t)pm * BM + t; const f32x4 a0 = *(const f32x4*)(ssa + row * 8), a1 = *(const f32x4*)(ssa + row * 8 + 4); const f32x2 c2 = *(const f32x2*)(ssc + row * 2);
            const float ra = __builtin_amdgcn_rsqf((((a0[0] + a0[1]) + (a0[2] + a0[3])) + ((a1[0] + a1[1]) + (a1[2] + a1[3]))) * (1.0f / 512.0f) + 1e-6f);
            const float rc = __builtin_amdgcn_rsqf((c2[0] + c2[1]) * (1.0f / 512.0f) + 1e-6f);
            rat[t] = ra / rc; rcs[t] = rc; }
    }
    __device__ __forceinline__ void mid(f32x4 (&acc)[2][2][4][2], int wr, int fr) const {
#pragma unroll
        for (int ai = 0; ai < 2; ++ai)
#pragma unroll
            for (int m = 0; m < 4; ++m) { const float rt = rat[ai * HALF + wr * 64 + m * 16 + fr];
#pragma unroll
                for (int bj = 0; bj < 2; ++bj) { acc[ai][bj][m][0] = acc[ai][bj][m][0] * rt; acc[ai][bj][m][1] = acc[ai][bj][m][1] * rt; } }
    }
    __device__ __forceinline__ void operator()(const f32x4 (&acc)[2][2][4][2], const Unit& u, int wr, int wc, int fr, int fq, int next_pm = -1) const {
        const int col0 = u.pn * BM + wc * 32 + 8 * fq; const int b = (u.pm * BM) >> 11;
        f32x4 gv[2][2], gg[2][2];
#pragma unroll
        for (int bj = 0; bj < 2; ++bj)
#pragma unroll
            for (int n = 0; n < 2; ++n) { gv[bj][n] = *(const f32x4*)(gate + (size_t)b * 6144 + col0 + bj * HALF + n * 4);
                if (XG) gg[bj][n] = *(const f32x4*)(gain + col0 + bj * HALF + n * 4) * (*(const f32x4*)(sc + (size_t)b * 6144 + col0 + bj * HALF + n * 4) + 1.0f); }
        constexpr int PFD = B16 ? 4 : 2;
        f16x8 bq[16]; f32x4 bf[16][2];
        const size_t offb = (size_t)(u.pm * BM + wr * 64 + fr) * DM + col0;
#pragma unroll
        for (int i = 0; i < PFD; ++i) { const size_t o = offb + (size_t)(((i >> 3) * HALF + ((i >> 1) & 3) * 16) * DM + (i & 1) * HALF);
            if (B16) bq[i] = __builtin_nontemporal_load((const f16x8*)((const f16*)base + o)); else { bf[i][0] = __builtin_nontemporal_load((const f32x4*)((const float*)base + o)); bf[i][1] = __builtin_nontemporal_load((const f32x4*)((const float*)base + o + 4)); } }
        float ss = 0.f;
#pragma unroll
        for (int i = 0; i < 16; ++i) { const int ai = i >> 3, m = (i >> 1) & 3, bj = i & 1;
            if (i + PFD < 16) { const int k = i + PFD; const size_t o = offb + (size_t)(((k >> 3) * HALF + ((k >> 1) & 3) * 16) * DM + (k & 1) * HALF);
                if (B16) bq[k] = __builtin_nontemporal_load((const f16x8*)((const f16*)base + o)); else { bf[k][0] = __builtin_nontemporal_load((const f32x4*)((const float*)base + o)); bf[k][1] = __builtin_nontemporal_load((const f32x4*)((const float*)base + o + 4)); } }
            asm volatile("" ::: "memory");
            const size_t off = offb + (size_t)((ai * HALF + m * 16) * DM + bj * HALF);
            f32x4 xn[2];
            if (B16) { const f16x8 bs = bq[i];
                xn[0] = (f32x4){(float)bs[0], (float)bs[1], (float)bs[2], (float)bs[3]}; xn[1] = (f32x4){(float)bs[4], (float)bs[5], (float)bs[6], (float)bs[7]}; }
            else { xn[0] = bf[i][0]; xn[1] = bf[i][1]; }
            if (MIXM) { const float rc = rcs[ai * HALF + wr * 64 + m * 16 + fr]; xn[0] = xn[0] + (gv[bj][0] * rc) * acc[ai][bj][m][0]; xn[1] = xn[1] + (gv[bj][1] * rc) * acc[ai][bj][m][1]; }
            else { xn[0] = xn[0] + gv[bj][0] * acc[ai][bj][m][0]; xn[1] = xn[1] + gv[bj][1] * acc[ai][bj][m][1]; }
            if (O16) { u32x4 w; w.x = pk_f16(xn[0][0], xn[0][1]); w.y = pk_f16(xn[0][2], xn[0][3]); w.z = pk_f16(xn[1][0], xn[1][1]); w.w = pk_f16(xn[1][2], xn[1][3]);
                *(u32x4*)((f16*)out + off) = w; }
            else { *(f32x4*)((float*)out + off) = xn[0]; *(f32x4*)((float*)out + off + 4) = xn[1]; }
            if (XG) { ss += ((xn[0][0] * xn[0][0] + xn[0][1] * xn[0][1]) + (xn[0][2] * xn[0][2] + xn[0][3] * xn[0][3])) + ((xn[1][0] * xn[1][0] + xn[1][1] * xn[1][1]) + (xn[1][2] * xn[1][2] + xn[1][3] * xn[1][3]));
                const f32x4 y0 = xn[0] * gg[bj][0], y1 = xn[1] * gg[bj][1];
                u32x4 w; w.x = pk_f16(y0[0], y0[1]); w.y = pk_f16(y0[2], y0[3]); w.z = pk_f16(y1[0], y1[1]); w.w = pk_f16(y1[2], y1[3]);
                *(u32x4*)(xg + off) = w;
                if (bj == 1) { ss += __shfl_xor(ss, 16); ss += __shfl_xor(ss, 32); if (fq == 0) part[wc * 256 + ai * HALF + wr * 64 + m * 16 + fr] = ss; ss = 0.f; } } }
        if (XG) {
            asm volatile("s_waitcnt lgkmcnt(0)\n\ts_barrier" ::: "memory");
            const int t = (wr * 4 + wc) * 64 + fq * 16 + fr;
            if (t < 256) ssp[(size_t)(u.pm * BM + t) * 4 + u.pn] = (part[t] + part[256 + t]) + (part[512 + t] + part[768 + t]);
            if (MIXM && next_pm >= 0) rows(next_pm, t);
            asm volatile("s_waitcnt lgkmcnt(0)\n\ts_barrier" ::: "memory");
        }
    }
};

template <class Epi, class Sched, bool ALIGN_EPI = false, bool SP2 = false>
__device__ __forceinline__ void gemm_phase(LAS unsigned char* lds, const Gemm g, const Sched& S, const Epi& E, const int tid) {
    const int wid = __builtin_amdgcn_readfirstlane(tid >> 6), lane = tid & 63, wr = wid >> 2, wc = wid & 3, fr = lane & 15, fq = lane >> 4;
    const int K = g.K, nt = K / BK, lda = g.lda;
    unsigned voffA[2], voffB[2];
#pragma unroll
    for (int i = 0; i < 2; ++i) { int R, C; stage_rc(tid * 16 + i * 8192, R, C); const int Rb = Epi::PERM ? ((R & ~31) + perm32(R & 31)) : R;
        voffA[i] = (unsigned)(R * lda + C) * 2u; voffB[i] = (unsigned)(Rb * K + C) * 2u; }
    const size_t kstep = (size_t)(BK * 2);
    const size_t hstepA = (size_t)HALF * lda * 2, hstepB = (size_t)HALF * K * 2;
    const size_t tstepA = 2 * hstepA, tstepB = 2 * hstepB;
    const unsigned ldsw = (unsigned)wid * 1024u;
    const int aoff = lds_byte(wr * 64 + fr, fq * 8), boff = lds_byte(wc * 32 + fr, fq * 8);
#define PG8_SA(b, h) (((b) * 2 + (h)) * HTB)
#define PG8_SB(b, h) ((4 + (b) * 2 + (h)) * HTB)
#define PG8_STAGE(bufoff, gbase, voff) do { _Pragma("unroll") for (int _i = 0; _i < 2; ++_i) \
        __builtin_amdgcn_global_load_lds((const unsigned*)((const char*)(gbase) + (voff)[_i]), (LAS unsigned*)(lds + (bufoff) + ldsw + _i * 8192), 16, 0, 0); } while (0)
#define PG8_LDA(dst, b, h) do { _Pragma("unroll") for (int m = 0; m < 4; ++m) _Pragma("unroll") for (int k = 0; k < 2; ++k) dst[m][k] = *(const LAS f16x8*)(lds + PG8_SA(b, h) + aoff + m * 2048 + k * 1024); } while (0)
#define PG8_LDB(dst, b, h) do { _Pragma("unroll") for (int n = 0; n < 2; ++n) _Pragma("unroll") for (int k = 0; k < 2; ++k) dst[n][k] = *(const LAS f16x8*)(lds + PG8_SB(b, h) + boff + n * 2048 + k * 1024); } while (0)
#define PG8_MMA(ai, bj, At, Bt) do { __builtin_amdgcn_s_setprio(1); _Pragma("unroll") for (int m = 0; m < 4; ++m) _Pragma("unroll") for (int n = 0; n < 2; ++n) _Pragma("unroll") for (int k = 0; k < 2; ++k) \
        acc[ai][bj][m][n] = __builtin_amdgcn_mfma_f32_16x16x32_f16(Bt[n][k], At[m][k], acc[ai][bj][m][n], 0, 0, 0); __builtin_amdgcn_s_setprio(0); } while (0)
#define PG8_WAIT_V(n) asm volatile("s_waitcnt vmcnt(" #n ")" ::: "memory")
#define PG8_WAIT_L(n) asm volatile("s_waitcnt lgkmcnt(" #n ")" ::: "memory")
#define PG8_BAR __builtin_amdgcn_s_barrier()
#define PG8_SCHED __builtin_amdgcn_sched_barrier(0)
    Unit cur, nxt; int ui = 0;
    if (!S.next(0, cur)) return;
    if constexpr (Epi::PREF) E.pref(cur, wid);
    f32x4 acc[2][2][4][2];
#pragma unroll
    for (int a = 0; a < 2; ++a)
#pragma unroll
        for (int b = 0; b < 2; ++b)
#pragma unroll
            for (int m = 0; m < 4; ++m)
#pragma unroll
                for (int n = 0; n < 2; ++n) acc[a][b][m][n] = (f32x4){0.f, 0.f, 0.f, 0.f};
    f16x8 At[4][2], B0[2][2], B1[2][2];
    const char* cA = (const char*)g.A + (size_t)cur.pm * tstepA; const char* cB = (const char*)g.Bt + (size_t)cur.pn * tstepB;
    if constexpr (SP2) {
        PG8_STAGE(PG8_SB(0, 0), cB, voffB); PG8_STAGE(PG8_SB(0, 1), cB + hstepB, voffB); PG8_STAGE(PG8_SA(0, 0), cA, voffA); PG8_STAGE(PG8_SA(0, 1), cA + hstepA, voffA);
        if (wr == 1) PG8_BAR;
        PG8_WAIT_V(2); PG8_BAR;
        PG8_STAGE(PG8_SB(1, 0), cB + kstep, voffB); PG8_STAGE(PG8_SA(1, 0), cA + kstep, voffA); PG8_STAGE(PG8_SB(1, 1), cB + hstepB + kstep, voffB);
        PG8_WAIT_V(6); PG8_BAR;
    } else {
        PG8_STAGE(PG8_SB(0, 0), cB, voffB); PG8_STAGE(PG8_SA(0, 0), cA, voffA); PG8_STAGE(PG8_SB(0, 1), cB + hstepB, voffB); PG8_STAGE(PG8_SA(0, 1), cA + hstepA, voffA);
        if (wr == 1) PG8_BAR;
        PG8_WAIT_V(4); PG8_BAR;
        PG8_STAGE(PG8_SB(1, 0), cB + kstep, voffB); PG8_STAGE(PG8_SA(1, 0), cA + kstep, voffA); PG8_STAGE(PG8_SB(1, 1), cB + hstepB + kstep, voffB);
        PG8_WAIT_V(6); PG8_BAR;
    }
    for (;;) {
        const bool has_next = S.next(ui + 1, nxt);
        const char* nA = has_next ? (const char*)g.A + (size_t)nxt.pm * tstepA : cA; const char* nB = has_next ? (const char*)g.Bt + (size_t)nxt.pn * tstepB : cB;
        for (int t = 0; t < nt; t += 2) {
            const bool last = (t == nt - 2);
            const char* a1 = cA + (size_t)(t + 1) * kstep;
            const char* a2 = last ? nA : cA + (size_t)(t + 2) * kstep; const char* b2 = last ? nB : cB + (size_t)(t + 2) * kstep;
            const char* a3 = a2 + kstep; const char* b3 = b2 + kstep;
            if constexpr (SP2) {
            PG8_LDB(B0, 0, 0); PG8_LDB(B1, 0, 1); PG8_SCHED; PG8_LDA(At, 0, 0); PG8_STAGE(PG8_SA(1, 1), a1 + hstepA, voffA);
            PG8_WAIT_V(8); PG8_WAIT_L(0); PG8_BAR; PG8_MMA(0, 0, At, B0); PG8_MMA(0, 1, At, B1); PG8_BAR; PG8_SCHED;
            PG8_LDA(At, 0, 1); PG8_STAGE(PG8_SB(0, 0), b2, voffB); PG8_STAGE(PG8_SB(0, 1), b2 + hstepB, voffB); PG8_STAGE(PG8_SA(0, 0), a2, voffA);
            PG8_WAIT_V(8); PG8_WAIT_L(0); PG8_BAR; PG8_MMA(1, 0, At, B0); PG8_MMA(1, 1, At, B1); PG8_BAR; PG8_SCHED;
            PG8_LDB(B0, 1, 0); PG8_LDB(B1, 1, 1); PG8_SCHED; PG8_LDA(At, 1, 0); PG8_STAGE(PG8_SA(0, 1), a2 + hstepA, voffA);
            PG8_WAIT_V(8); PG8_WAIT_L(0); PG8_BAR; PG8_MMA(0, 0, At, B0); PG8_MMA(0, 1, At, B1); PG8_BAR; PG8_SCHED;
            PG8_LDA(At, 1, 1); PG8_STAGE(PG8_SB(1, 0), b3, voffB); PG8_STAGE(PG8_SB(1, 1), b3 + hstepB, voffB); PG8_STAGE(PG8_SA(1, 0), a3, voffA);
            PG8_WAIT_V(8); PG8_WAIT_L(0); PG8_BAR; PG8_MMA(1, 0, At, B0); PG8_MMA(1, 1, At, B1); PG8_BAR; PG8_SCHED;
            if constexpr (Epi::MID) { if (t == 6) { E.mid(acc, wr, fr); PG8_SCHED; } }
            } else {
            PG8_LDB(B0, 0, 0); PG8_SCHED; PG8_LDA(At, 0, 0); PG8_STAGE(PG8_SA(1, 1), a1 + hstepA, voffA);
            PG8_WAIT_L(8); PG8_BAR; PG8_WAIT_L(0); PG8_MMA(0, 0, At, B0); PG8_BAR; PG8_SCHED;
            PG8_LDB(B1, 0, 1); PG8_STAGE(PG8_SB(0, 0), b2, voffB);
            PG8_BAR; PG8_WAIT_L(0); PG8_MMA(0, 1, At, B1); PG8_BAR;
            PG8_LDA(At, 0, 1); PG8_STAGE(PG8_SA(0, 0), a2, voffA);
            PG8_BAR; PG8_WAIT_L(0); PG8_MMA(1, 0, At, B0); PG8_BAR; PG8_SCHED;
            PG8_STAGE(PG8_SB(0, 1), b2 + hstepB, voffB);
            PG8_WAIT_V(6); PG8_BAR; PG8_MMA(1, 1, At, B1); PG8_BAR;
            PG8_LDB(B0, 1, 0); PG8_SCHED; PG8_LDA(At, 1, 0); PG8_STAGE(PG8_SA(0, 1), a2 + hstepA, voffA);
            PG8_WAIT_L(8); PG8_BAR; PG8_WAIT_L(0); PG8_MMA(0, 0, At, B0); PG8_BAR; PG8_SCHED;
            PG8_LDB(B1, 1, 1); PG8_STAGE(PG8_SB(1, 0), b3, voffB);
            PG8_BAR; PG8_WAIT_L(0); PG8_MMA(0, 1, At, B1); PG8_BAR;
            PG8_LDA(At, 1, 1); PG8_STAGE(PG8_SA(1, 0), a3, voffA);
            PG8_BAR; PG8_WAIT_L(0); PG8_MMA(1, 0, At, B0); PG8_BAR; PG8_SCHED;
            PG8_STAGE(PG8_SB(1, 1), b3 + hstepB, voffB);
            PG8_WAIT_V(6); PG8_BAR; PG8_MMA(1, 1, At, B1); PG8_BAR;
            }
        }
        if constexpr (ALIGN_EPI) { if (wr == 0) PG8_BAR; }
        if constexpr (Epi::MID) E(acc, cur, wr, wc, fr, fq, has_next ? nxt.pm : -1); else if constexpr (Epi::PREF) E(acc, cur, wr, wc, fr, fq, has_next, nxt); else E(acc, cur, wr, wc, fr, fq);
        if (!has_next) break;
#pragma unroll
        for (int a = 0; a < 2; ++a)
#pragma unroll
            for (int b = 0; b < 2; ++b)
#pragma unroll
                for (int m = 0; m < 4; ++m)
#pragma unroll
                    for (int n = 0; n < 2; ++n) acc[a][b][m][n] = (f32x4){0.f, 0.f, 0.f, 0.f};
        cur = nxt; cA = nA; cB = nB; ++ui;
        if constexpr (ALIGN_EPI) { if (wr == 1) PG8_BAR; }
    }
    PG8_WAIT_V(0);
    if constexpr (!ALIGN_EPI) { if (wr == 0) PG8_BAR; }
    PG8_BAR;
#undef PG8_SA
#undef PG8_SB
#undef PG8_STAGE
#undef PG8_LDA
#undef PG8_LDB
#undef PG8_MMA
#undef PG8_WAIT_V
#undef PG8_WAIT_L
#undef PG8_BAR
#undef PG8_SCHED
}
}

__device__ __forceinline__ float wave_sum(float v) {
#pragma unroll
    for (int o = 1; o < 64; o <<= 1) v += __shfl_xor(v, o);
    return v;
}
__device__ __forceinline__ float silu_f(float x) { return x / (1.0f + __expf(-x)); }
__device__ __forceinline__ float sigmoid_f(float x) { return 1.0f / (1.0f + __expf(-x)); }
__device__ __forceinline__ unsigned pk2h(float lo, float hi) { return pg8::pk_f16(lo, hi); }


namespace att {
typedef float f32x16 __attribute__((ext_vector_type(16)));
typedef short s16x4 __attribute__((ext_vector_type(4)));
typedef short s16x8 __attribute__((ext_vector_type(8)));
__device__ __forceinline__ unsigned pk_h2(float lo, float hi) { return pg8::pk_f16(lo, hi); }
constexpr int L_B0 = 0, L_B1 = 8192, L_VR = 24576, L_RES = 49152, L_OWN = 49152, L_CAR = 82944, L_WSF = 116736, L_VAL = 118784, L_SELM = 127232, L_UNI = 127488, L_STG = 0;
constexpr float THR = 8.0f;
__device__ __forceinline__ int crow(int r, int hi) { return (r & 3) + 8 * (r >> 2) + 4 * hi; }
__device__ __forceinline__ float swapmax(float m) { auto rr = __builtin_amdgcn_permlane32_swap(__float_as_uint(m), __float_as_uint(m), false, false); return fmaxf(__uint_as_float(rr[0]), __uint_as_float(rr[1])); }
__device__ __forceinline__ float swapadd(float m) { auto rr = __builtin_amdgcn_permlane32_swap(__float_as_uint(m), __float_as_uint(m), false, false); return __uint_as_float(rr[0]) + __uint_as_float(rr[1]); }
__device__ __forceinline__ float ex2(float x) { return __builtin_amdgcn_exp2f(x); }
__device__ __forceinline__ void qkt(f32x16& p0, f32x16& p1, const LAS unsigned char* Kt, const f16x8 (&qr)[4], int r32, int hi) {
    p0 = (f32x16){}; p1 = (f32x16){};
    const LAS unsigned char* kb0 = Kt + hi * 1024 + r32 * 16;
#pragma unroll
    for (int d0 = 0; d0 < 4; ++d0) { const LAS unsigned char* kb = kb0 + d0 * 2048;
        const f16x8 b0 = *(const LAS f16x8*)(kb), b1 = *(const LAS f16x8*)(kb + 512);
        p0 = __builtin_amdgcn_mfma_f32_32x32x16_f16(b0, qr[d0], p0, 0, 0, 0);
        p1 = __builtin_amdgcn_mfma_f32_32x32x16_f16(b1, qr[d0], p1, 0, 0, 0);
    }
}
__device__ __forceinline__ f16x8 pk8(const f32x16& p, int b) { f16x8 r;
#pragma unroll
    for (int j = 0; j < 8; ++j) r[j] = (f16)p[b + j];
    return r; }
__device__ __forceinline__ void glds16(const void* gsrc, unsigned lds_dst) { unsigned keep;
    asm volatile("s_mov_b32 %0, m0\n\ts_mov_b32 m0, %2\n\ts_nop 0\n\tglobal_load_lds_dwordx4 %1, off\n\ts_mov_b32 m0, %0" : "=&s"(keep) : "v"(gsrc), "s"(lds_dst) : "memory"); }
__device__ __forceinline__ float max3f(float a, float b, float c) { float r; asm("v_max3_f32 %0, %1, %2, %3" : "=v"(r) : "v"(a), "v"(b), "v"(c)); return r; }
__device__ __forceinline__ float rowmax3(const f32x16& p0, const f32x16& p1) {
    float a = max3f(p0[0], p0[1], p1[0]), b = max3f(p0[2], p0[3], p1[1]); a = max3f(a, p1[2], p1[3]);
#pragma unroll
    for (int r = 4; r < 16; r += 4) { a = max3f(a, p0[r], p0[r + 1]); b = max3f(b, p0[r + 2], p0[r + 3]); a = max3f(a, p1[r], p1[r + 1]); b = max3f(b, p1[r + 2], p1[r + 3]); }
    return swapmax(max3f(a, b, b));
}
__device__ __forceinline__ void pv(f32x16 (&o)[2], const LAS unsigned char* vb, const f16x8 (&pa)[4]) {
#pragma unroll
    for (int d0 = 0; d0 < 2; ++d0)
#pragma unroll
        for (int ks = 0; ks < 4; ++ks) {
            const s16x4 lo = __builtin_amdgcn_ds_read_tr16_b64_v4i16((LAS s16x4*)(vb + d0 * 4096 + ks * 1024));
            const s16x4 hh = __builtin_amdgcn_ds_read_tr16_b64_v4i16((LAS s16x4*)(vb + d0 * 4096 + ks * 1024 + 512));
            const f16x4 l4 = __builtin_bit_cast(f16x4, lo), h4 = __builtin_bit_cast(f16x4, hh);
            const f16x8 B = {l4[0], l4[1], l4[2], l4[3], h4[0], h4[1], h4[2], h4[3]};
            o[d0] = __builtin_amdgcn_mfma_f32_32x32x16_f16(pa[ks], B, o[d0], 0, 0, 0);
        }
}
__device__ __forceinline__ float rowmax(const f32x16& p0, const f32x16& p1) {
    float a = fmaxf(p0[0], p1[0]);
#pragma unroll
    for (int r = 1; r < 16; ++r) a = fmaxf(a, fmaxf(p0[r], p1[r]));
    return swapmax(a);
}
template <bool FIRST>
__device__ __forceinline__ void accum(LAS float* resw, const f32x16 (&o)[2], float fac, LAS float* wsf, int r32, int hi) {
    if (hi == 0) wsf[r32] = fac;
#pragma unroll
    for (int r = 0; r < 16; ++r) { const float a = (wsf + 4 * hi)[crow(r, 0)];
        if (FIRST) { resw[r * 64] = a * o[0][r]; resw[(16 + r) * 64] = a * o[1][r]; }
        else { resw[r * 64] = fmaf(a, o[0][r], resw[r * 64]); resw[(16 + r) * 64] = fmaf(a, o[1][r], resw[(16 + r) * 64]); } }
}

__device__ __forceinline__ void attn_unit(LAS unsigned char* lds, int b, int hk, int qb, const f16* Q, const f16* KVb, const f16* KCMP, const float* Gt, f16* MIXo, float* SSA, float* SSC,
                                          const f16* CBp, const f16* Pp, const float* ga, const float* gc, const float* cw, int tid) {
    const int lane = tid & 63, wave = __builtin_amdgcn_readfirstlane(tid >> 6), r32 = lane & 31, hi = lane >> 5;
    const int g = wave >> 1, qh = wave & 1, h = hk * 4 + g;
    const int tl = 32 * qh + r32, tq = 64 * qb + tl; const size_t mq = (size_t)b * SEQ + tq;
    LAS unsigned char* B0 = lds + L_B0; LAS unsigned char* B1 = lds + L_B1;
    LAS float* wsf = (LAS float*)(lds + L_WSF + wave * 256);
    LAS float* ownl = (LAS float*)(lds + L_OWN); LAS float* carl = (LAS float*)(lds + L_CAR); LAS float* vall = (LAS float*)(lds + L_VAL);
    LAS unsigned* selm = (LAS unsigned*)(lds + L_SELM); LAS unsigned* unim = (LAS unsigned*)(lds + L_UNI);
    const int kst = wave * 1024 + lane * 16, vst = kst;
    const int kcol = 8 * wave, vrow = 16 * (wave & 3) + (lane >> 2), vcol = 32 * (wave >> 2) + 8 * (lane & 3);
    const int vlo = ((lane >> 4) & 1) * 32 + (lane & 3) * 8 + (4 * hi + ((lane & 15) >> 2)) * 64;
    const LAS unsigned char* vb0 = B0 + vlo;
    const LAS unsigned char* vb1 = vb0 + 8192;
    f16x8 qr[4];
#pragma unroll
    for (int d0 = 0; d0 < 4; ++d0) qr[d0] = __builtin_nontemporal_load((const f16x8*)(Q + mq * 512 + h * 64 + d0 * 16 + hi * 8));
    LAS float* resw = (LAS float*)(lds + L_RES + wave * 8192) + lane;
    const float gate0 = Gt[mq * 32 + h * 3 + 0], gate1 = Gt[mq * 32 + h * 3 + 1], gate2 = Gt[mq * 32 + h * 3 + 2];
    const f16* kc = KCMP + (((size_t)0 * 16 + b) * 2 + hk) * 128 * 64; const f16* vc = KCMP + (((size_t)1 * 16 + b) * 2 + hk) * 128 * 64;
    {
        const f16x8 k0 = *(const f16x8*)(kc + (size_t)lane * 64 + kcol), k1 = *(const f16x8*)(kc + (size_t)(64 + lane) * 64 + kcol);
        const f16x8 v0 = *(const f16x8*)(vc + (size_t)vrow * 64 + vcol), v1 = *(const f16x8*)(vc + (size_t)(64 + vrow) * 64 + vcol);
        {
            const int cg32 = tid & 31, rg = tid >> 5; const int col = 256 * hk + 8 * cg32; const int tt0 = 64 * qb + 4 * rg; const size_t m0c = (size_t)b * SEQ + tt0;
            f16x8 pr[6], cbr[4];
#pragma unroll
            for (int i = 0; i < 6; ++i) { pr[i] = (f16x8)(f16)0.f; if (tt0 + i - 2 >= 0) pr[i] = __builtin_nontemporal_load((const f16x8*)(Pp + (m0c + i - 2) * 512 + col)); }
#pragma unroll
            for (int i = 0; i < 4; ++i) cbr[i] = __builtin_nontemporal_load((const f16x8*)(CBp + (m0c + i) * 512 + col));
            f32x4 w0a = *(const f32x4*)(cw + col), w0b = *(const f32x4*)(cw + col + 4), w1a = *(const f32x4*)(cw + 512 + col), w1b = *(const f32x4*)(cw + 512 + col + 4);
            f32x4 w2a = *(const f32x4*)(cw + 1024 + col), w2b = *(const f32x4*)(cw + 1024 + col + 4), gca = *(const f32x4*)(gc + col), gcb = *(const f32x4*)(gc + col + 4);
#pragma unroll
            for (int i = 0; i < 4; ++i) { float o[8]; float ssc = 0.f;
#pragma unroll
                for (int e = 0; e < 8; ++e) { const float w0 = (e < 4) ? w0a[e & 3] : w0b[e & 3], w1 = (e < 4) ? w1a[e & 3] : w1b[e & 3], w2 = (e < 4) ? w2a[e & 3] : w2b[e & 3], gg = (e < 4) ? gca[e & 3] : gcb[e & 3];
                    const float y = w0 * (float)pr[i][e] + w1 * (float)pr[i + 1][e] + w2 * (float)pr[i + 2][e];
                    const float c = (float)cbr[i][e] * y; ssc += c * c; o[e] = c * gg; }
                u32x4 w; w.x = pk_h2(o[0], o[1]); w.y = pk_h2(o[2], o[3]); w.z = pk_h2(o[4], o[5]); w.w = pk_h2(o[6], o[7]);
                *(u32x4*)(MIXo + (m0c + i) * DM + 512 + col) = w;
#pragma unroll
                for (int sft = 1; sft < 32; sft <<= 1) ssc += __shfl_xor(ssc, sft);
                if (cg32 == 0) SSC[(m0c + i) * 2 + hk] = ssc; }
        }
        __syncthreads();
        *(LAS f16x8*)(B0 + kst) = k0; *(LAS f16x8*)(B1 + kst) = k1;
        if (tid < 64) selm[tid] = 0u; if (tid == 64) unim[0] = 0u;
        __syncthreads();
        f32x16 a0, a1, b0, b1;
        qkt(a0, a1, B0, qr, r32, hi); qkt(b0, b1, B1, qr, r32, hi);
        const int nvalid = (tq >= 31) ? (((tq - 31) >> 4) + 1) : 0;
#pragma unroll
        for (int r = 0; r < 16; ++r) { const int kk = crow(r, 0); const int thr = nvalid - 4 * hi;
            a0[r] = (kk >= thr) ? -INFINITY : a0[r]; a1[r] = (kk + 32 >= thr) ? -INFINITY : a1[r]; b0[r] = (kk + 64 >= thr) ? -INFINITY : b0[r]; b1[r] = (kk + 96 >= thr) ? -INFINITY : b1[r]; }
        const float mx = fmaxf(rowmax(a0, a1), rowmax(b0, b1)); const float mu = (mx == -INFINITY) ? 0.0f : mx;
        float sum = 0.f;
#pragma unroll
        for (int r = 0; r < 16; ++r) { a0[r] = ex2(a0[r] - mu); a1[r] = ex2(a1[r] - mu); b0[r] = ex2(b0[r] - mu); b1[r] = ex2(b1[r] - mu); sum += (a0[r] + a1[r]) + (b0[r] + b1[r]); }
        sum = swapadd(sum);
        const float inv = (sum > 0.f) ? 1.0f / sum : 0.f;
        {
            LAS float* op = ownl + (g * 64 + tl) * 33 + hi; LAS float* cp = carl + (g * 64 + tl) * 33 + hi;
#pragma unroll
            for (int X = 0; X < 4; ++X)
#pragma unroll
                for (int a = 0; a < 4; ++a) { const f32x16& P = (X == 0) ? a0 : (X == 1) ? a1 : (X == 2) ? b0 : b1;
                    const int j0 = 8 * X + 2 * a;
                    op[j0] = ((P[4 * a] + P[4 * a + 1]) + (P[4 * a + 2] + P[4 * a + 3])) * inv;
                    if (j0 + 1 < 31) cp[j0 + 1] = P[4 * a + 3] * inv; else if (hi == 0) cp[j0 + 1] = P[4 * a + 3] * inv; }
        }
        f16x8 paA[4], paB[4];
        paA[0] = pk8(a0, 0); paA[1] = pk8(a0, 8); paA[2] = pk8(a1, 0); paA[3] = pk8(a1, 8);
        paB[0] = pk8(b0, 0); paB[1] = pk8(b0, 8); paB[2] = pk8(b1, 0); paB[3] = pk8(b1, 8);
        __syncthreads();
        *(LAS f16x8*)(B0 + vst) = v0; *(LAS f16x8*)(B1 + vst) = v1;
        {
            const int q = tid & 63, jq = tid >> 6;
#pragma unroll
            for (int i = 0; i < 4; ++i) { const int j = jq + 8 * i; float v = 0.f;
#pragma unroll
                for (int gg = 0; gg < 4; ++gg) v += ownl[(gg * 64 + q) * 33 + j] + ((j > 0) ? carl[(gg * 64 + q) * 33 + j] : 0.f);
                if (j > qb) v = -INFINITY; else if (j == 0 || j == qb || j == qb - 1) v = INFINITY;
                vall[q * 33 + j] = v; }
        }
        __syncthreads();
        {
            const int q = tid & 63, jq = tid >> 6; float vx[4]; int rk[4];
#pragma unroll
            for (int i = 0; i < 4; ++i) { vx[i] = vall[q * 33 + jq + 8 * i]; rk[i] = 0; }
#pragma unroll
            for (int sg = 0; sg < 4; ++sg) { if (8 * sg <= qb) {
#pragma unroll
              for (int u8 = 0; u8 < 8; ++u8) { const int i2 = 8 * sg + u8; const float vi = vall[q * 33 + i2];
#pragma unroll
                for (int i = 0; i < 4; ++i) { const int t = i2 - 8 * i;
                    if (t < 0) rk[i] += (int)(vi >= vx[i]); else if (t >= 8) rk[i] += (int)(vi > vx[i]);
                    else rk[i] += (int)(vi > vx[i]) | ((int)(vi == vx[i]) & (int)(t < jq)); } } } }
            unsigned bits = 0u;
#pragma unroll
            for (int i = 0; i < 4; ++i) bits |= (unsigned)((int)(rk[i] < 8) & (int)(vx[i] > -INFINITY)) << (jq + 8 * i);
            if (bits) __hip_atomic_fetch_or(selm + q, bits, __ATOMIC_RELAXED, __HIP_MEMORY_SCOPE_WORKGROUP);
            unsigned ub = bits;
#pragma unroll
            for (int sft = 1; sft < 64; sft <<= 1) ub |= (unsigned)__shfl_xor((int)ub, sft);
            if (lane == 0) __hip_atomic_fetch_or(unim, ub, __ATOMIC_RELAXED, __HIP_MEMORY_SCOPE_WORKGROUP);
        }
        f32x16 o[2]; o[0] = (f32x16){}; o[1] = (f32x16){};
        pv(o, vb0, paA); pv(o, vb1, paB);
        accum<true>(resw, o, gate0 * inv, wsf, r32, hi);
        __syncthreads();
    }
    const unsigned mysel = selm[tl]; const unsigned uni = unim[0];
#ifndef ATT_PROBE
#define ATT_PROBE 0
#endif
#pragma unroll 1
    for (int bri = 0; bri < ((ATT_PROBE == 1 || ATT_PROBE == 2) ? 3 : 2); ++bri) {
        const int br = (ATT_PROBE == 1) ? (bri >> 1) : (ATT_PROBE == 2) ? ((bri + 1) >> 1) : bri;
        const float pfac = ((ATT_PROBE == 1 && bri == 0) || (ATT_PROBE == 2 && bri == 1)) ? 0.0f : 1.0f;
        const f16* Kg = KVb + (size_t)(2 + 2 * br) * (KV_STRIDE / 2) + (size_t)b * SEQ * 128 + hk * 64;
        const f16* Vg = KVb + (size_t)(3 + 2 * br) * (KV_STRIDE / 2) + (size_t)b * SEQ * 128 + hk * 64;
        const unsigned lo_bits = (qb >= 8) ? ~((1u << (qb - 8)) - 1u) : 0xFFFFFFFFu;
        const unsigned upto = (qb == 31) ? 0xFFFFFFFFu : ((2u << qb) - 1u);
        const unsigned todo = (br == 0) ? (uni & upto) : (upto & lo_bits);
        unsigned tK = todo, tV = todo, tC = todo; int jK = 0, jV = 0; const unsigned lds0 = (unsigned)(__UINTPTR_TYPE__)lds;
        const int drow = 8 * wave + (lane >> 3), dkc = 8 * ((lane & 7) ^ ((lane >> 3) & 7)), dvc = 8 * ((lane & 7) ^ ((((lane >> 3) >> 1) & 1) * 4));
        const int ksw = r32 & 7;
        const int qv_ = (lane & 15) >> 2, pv_ = lane & 3, g16_ = (lane >> 4) & 1;
        const int vbase_ = (4 * hi + qv_) * 128 + (2 * g16_ + (pv_ >> 1)) * 16 + (pv_ & 1) * 8;
        const int vbA_ = vbase_ + (qv_ >> 1) * 64, vbB_ = vbase_ + (1 - (qv_ >> 1)) * 64;
#define ISSUE_K(soff) do { if (tK) { jK = __builtin_ctz(tK); tK &= tK - 1u; } \
            glds16(Kg + (size_t)(64 * jK + drow) * 128 + dkc, (unsigned)__builtin_amdgcn_readfirstlane((int)(lds0 + (soff) + wave * 1024))); } while (0)
#define ISSUE_V(soff) do { if (tV) { jV = __builtin_ctz(tV); tV &= tV - 1u; } \
            glds16(Vg + (size_t)(64 * jV + drow) * 128 + dvc, (unsigned)__builtin_amdgcn_readfirstlane((int)(lds0 + L_VR + (soff) + wave * 1024))); } while (0)
#define WAITV(n) asm volatile("s_waitcnt vmcnt(" #n ")" ::: "memory")
#define SBAR() __builtin_amdgcn_sched_barrier(0)
#define PINV(x) asm volatile("" : "+v"(x))
#define MF(a_, b_, c_) __builtin_amdgcn_mfma_f32_32x32x16_f16(a_, b_, c_, 0, 0, 0)
#define PKW(P, B) pk_h2(P[B], P[(B) + 1])
#define PAF(k) __builtin_bit_cast(f16x8, pw##k)
#define VFR(i) __builtin_bit_cast(f16x8, (s16x8){vtl[i][0], vtl[i][1], vtl[i][2], vtl[i][3], vth[i][0], vth[i][1], vth[i][2], vth[i][3]})
#define VRD(i) do { vtl[i] = __builtin_amdgcn_ds_read_tr16_b64_v4i16((LAS s16x4*)((((i) >> 2) ? vpB_ : vpA_) + ((i) & 3) * 2048)); \
                    vth[i] = __builtin_amdgcn_ds_read_tr16_b64_v4i16((LAS s16x4*)((((i) >> 2) ? vpB_ : vpA_) + ((i) & 3) * 2048 + 1024)); } while (0)
#define KRD(j_) do { const LAS unsigned char* kq_ = kp_ + (((2 * (j_) + hi) ^ ksw) << 4); kf[2 * (j_)] = *(const LAS f16x8*)(kq_); kf[2 * (j_) + 1] = *(const LAS f16x8*)(kq_ + 4096); SBAR(); } while (0)
#define GAPA(MFX, A0, A1, A2, A3, W0, W1, PW) do { MFX; sacc += A0; sacc += A1; sacc += A2; sacc += A3; PINV(sacc); W0; W1; PINV(PW); SBAR(); } while (0)
#define GAPB(MFX, X, B) do { MFX; X[B] = ex2(X[B]); X[(B) + 1] = ex2(X[(B) + 1]); X[(B) + 2] = ex2(X[(B) + 2]); X[(B) + 3] = ex2(X[(B) + 3]); PINV(X); SBAR(); } while (0)
#define STEP(C0, C1, P0, P1) do { SBAR(); \
            const LAS unsigned char* vpA_ = lds + L_VR + vM + vbA_; const LAS unsigned char* vpB_ = lds + L_VR + vM + vbB_; const LAS unsigned char* kp_ = lds + kB + r32 * 128; \
            VRD(0); SBAR(); float sacc = P0[0] + P0[1]; \
            GAPA(C0 = MF(kf[0], qr[0], negm), P0[2], P0[3], P0[4], P0[5],     pw0[0] = PKW(P0, 0),  pw0[1] = PKW(P0, 2),  pw0); \
            VRD(4); SBAR(); GAPA(C1 = MF(kf[1], qr[0], negm), P0[6], P0[7], P0[8], P0[9],     pw0[2] = PKW(P0, 4),  pw0[3] = PKW(P0, 6),  pw0); \
            VRD(1); SBAR(); GAPA(C0 = MF(kf[2], qr[1], C0),   P0[10], P0[11], P0[12], P0[13], pw1[0] = PKW(P0, 8),  pw1[1] = PKW(P0, 10), pw1); \
            VRD(5); SBAR(); GAPA(C1 = MF(kf[3], qr[1], C1),   P0[14], P0[15], P1[0], P1[1],   pw1[2] = PKW(P0, 12), pw1[3] = PKW(P0, 14), pw1); \
            VRD(2); SBAR(); GAPA(C0 = MF(kf[4], qr[2], C0),   P1[2], P1[3], P1[4], P1[5],     pw2[0] = PKW(P1, 0),  pw2[1] = PKW(P1, 2),  pw2); \
            VRD(6); SBAR(); GAPA(C1 = MF(kf[5], qr[2], C1),   P1[6], P1[7], P1[8], P1[9],     pw2[2] = PKW(P1, 4),  pw2[3] = PKW(P1, 6),  pw2); \
            VRD(3); SBAR(); GAPA(C0 = MF(kf[6], qr[3], C0),   P1[10], P1[11], P1[12], P1[13], pw3[0] = PKW(P1, 8),  pw3[1] = PKW(P1, 10), pw3); \
            VRD(7); SBAR(); GAPA(C1 = MF(kf[7], qr[3], C1),   P1[14], P1[15], 0.f, 0.f,       pw3[2] = PKW(P1, 12), pw3[3] = PKW(P1, 14), pw3); \
            l += sacc; \
            ISSUE_K(kA); ISSUE_V(v1); \
            asm volatile("s_nop 15\n\ts_nop 7" : "+v"(C0), "+v"(C1)); \
            if (jc == qb) { _Pragma("unroll") for (int r = 0; r < 16; ++r) { const int ki = crow(r, 0); const int tlh = tl - 4 * hi; C0[r] = (ki > tlh) ? -INFINITY : C0[r]; C1[r] = (ki + 32 > tlh) ? -INFINITY : C1[r]; } } \
            if (br == 1 && jc == qb - 8) { _Pragma("unroll") for (int r = 0; r < 16; ++r) { const int ki = crow(r, 0); const int tlh = tl - 4 * hi; C0[r] = (ki <= tlh) ? -INFINITY : C0[r]; C1[r] = (ki + 32 <= tlh) ? -INFINITY : C1[r]; } } \
            { const float tm = rowmax3(C0, C1); resc = false; \
              const bool need = started ? (tm > THR) : (tm > -INFINITY); \
              if (__builtin_expect(__any(need), 0)) { const float dl = need ? tm : 0.f; mhat += dl; \
                  _Pragma("unroll") for (int r = 0; r < 16; ++r) { C0[r] -= dl; C1[r] -= dl; } \
                  const float f = started ? ex2(-dl) : 1.0f; l *= f; if (hi == 0) wsf[r32] = f; resc = true; } \
              started = started || (tm > -INFINITY); } \
            { const bool minen = (jn >= 0) && ((br == 1) || (((mysel >> jn) & 1u) != 0u)); const float cn = minen ? -mhat : -INFINITY; \
              _Pragma("unroll") for (int r = 0; r < 16; ++r) negm[r] = cn; PINV(negm); } \
            SBAR(); \
            GAPB(o[0] = MF(PAF(0), VFR(0), o[0]), C0, 0); \
            GAPB(o[1] = MF(PAF(0), VFR(4), o[1]), C0, 4); \
            KRD(0); GAPB(o[0] = MF(PAF(1), VFR(1), o[0]), C0, 8); \
            KRD(1); GAPB(o[1] = MF(PAF(1), VFR(5), o[1]), C0, 12); \
            KRD(2); GAPB(o[0] = MF(PAF(2), VFR(2), o[0]), C1, 0); \
            KRD(3); GAPB(o[1] = MF(PAF(2), VFR(6), o[1]), C1, 4); \
            GAPB(o[0] = MF(PAF(3), VFR(3), o[0]), C1, 8); \
            GAPB(o[1] = MF(PAF(3), VFR(7), o[1]), C1, 12); \
            asm volatile("s_waitcnt vmcnt(2) lgkmcnt(0)\n\ts_barrier" ::: "memory"); \
            if (resc) { _Pragma("unroll") for (int r = 0; r < 16; ++r) { const float a = (wsf + 4 * hi)[crow(r, 0)]; o[0][r] *= a; o[1][r] *= a; } } \
            last_ = (jc < 0); jc = jn; jn = tC ? __builtin_ctz(tC) : -1; tC &= tC - 1u; \
            { const int t_ = kA; kA = kB; kB = kC; kC = t_; } vM = v0_; v0_ = v1; v1 = (v1 == 16384) ? 0 : v1 + 8192; \
        } while (0)
#define STEP0(C0, C1) do { SBAR(); \
            const LAS unsigned char* kp_ = lds + kB + r32 * 128; \
            C0 = MF(kf[0], qr[0], negm); C1 = MF(kf[1], qr[0], negm); C0 = MF(kf[2], qr[1], C0); C1 = MF(kf[3], qr[1], C1); \
            C0 = MF(kf[4], qr[2], C0); C1 = MF(kf[5], qr[2], C1); C0 = MF(kf[6], qr[3], C0); C1 = MF(kf[7], qr[3], C1); SBAR(); \
            ISSUE_K(kA); ISSUE_V(v1); \
            asm volatile("s_nop 15\n\ts_nop 7" : "+v"(C0), "+v"(C1)); \
            if (jc == qb) { _Pragma("unroll") for (int r = 0; r < 16; ++r) { const int ki = crow(r, 0); const int tlh = tl - 4 * hi; C0[r] = (ki > tlh) ? -INFINITY : C0[r]; C1[r] = (ki + 32 > tlh) ? -INFINITY : C1[r]; } } \
            if (br == 1 && jc == qb - 8) { _Pragma("unroll") for (int r = 0; r < 16; ++r) { const int ki = crow(r, 0); const int tlh = tl - 4 * hi; C0[r] = (ki <= tlh) ? -INFINITY : C0[r]; C1[r] = (ki + 32 <= tlh) ? -INFINITY : C1[r]; } } \
            { const float tm = rowmax3(C0, C1); const bool need = (tm > -INFINITY); \
              if (__builtin_expect(__any(need), 0)) { const float dl = need ? tm : 0.f; mhat += dl; \
                  _Pragma("unroll") for (int r = 0; r < 16; ++r) { C0[r] -= dl; C1[r] -= dl; } } \
              started = (tm > -INFINITY); } \
            { const bool minen = (jn >= 0) && ((br == 1) || (((mysel >> jn) & 1u) != 0u)); const float cn = minen ? -mhat : -INFINITY; \
              _Pragma("unroll") for (int r = 0; r < 16; ++r) negm[r] = cn; PINV(negm); } \
            SBAR(); \
            GAPB(, C0, 0); GAPB(, C0, 4); KRD(0); GAPB(, C0, 8); KRD(1); GAPB(, C0, 12); KRD(2); GAPB(, C1, 0); KRD(3); GAPB(, C1, 4); GAPB(, C1, 8); GAPB(, C1, 12); \
            asm volatile("s_waitcnt vmcnt(2) lgkmcnt(0)\n\ts_barrier" ::: "memory"); \
            jc = jn; jn = tC ? __builtin_ctz(tC) : -1; tC &= tC - 1u; \
            { const int t_ = kA; kA = kB; kB = kC; kC = t_; } vM = v0_; v0_ = v1; v1 = (v1 == 16384) ? 0 : v1 + 8192; \
        } while (0)
#define STEPL(P0, P1) do { SBAR(); \
            const LAS unsigned char* vpA_ = lds + L_VR + vM + vbA_; const LAS unsigned char* vpB_ = lds + L_VR + vM + vbB_; \
            VRD(0); SBAR(); float sacc = P0[0] + P0[1]; \
            GAPA(, P0[2], P0[3], P0[4], P0[5],     pw0[0] = PKW(P0, 0),  pw0[1] = PKW(P0, 2),  pw0); \
            VRD(4); SBAR(); GAPA(, P0[6], P0[7], P0[8], P0[9],     pw0[2] = PKW(P0, 4),  pw0[3] = PKW(P0, 6),  pw0); \
            VRD(1); SBAR(); GAPA(, P0[10], P0[11], P0[12], P0[13], pw1[0] = PKW(P0, 8),  pw1[1] = PKW(P0, 10), pw1); \
            VRD(5); SBAR(); GAPA(, P0[14], P0[15], P1[0], P1[1],   pw1[2] = PKW(P0, 12), pw1[3] = PKW(P0, 14), pw1); \
            VRD(2); SBAR(); GAPA(, P1[2], P1[3], P1[4], P1[5],     pw2[0] = PKW(P1, 0),  pw2[1] = PKW(P1, 2),  pw2); \
            VRD(6); SBAR(); GAPA(, P1[6], P1[7], P1[8], P1[9],     pw2[2] = PKW(P1, 4),  pw2[3] = PKW(P1, 6),  pw2); \
            VRD(3); SBAR(); GAPA(, P1[10], P1[11], P1[12], P1[13], pw3[0] = PKW(P1, 8),  pw3[1] = PKW(P1, 10), pw3); \
            VRD(7); SBAR(); GAPA(, P1[14], P1[15], 0.f, 0.f,       pw3[2] = PKW(P1, 12), pw3[3] = PKW(P1, 14), pw3); \
            l += sacc; SBAR(); \
            o[0] = MF(PAF(0), VFR(0), o[0]); o[1] = MF(PAF(0), VFR(4), o[1]); o[0] = MF(PAF(1), VFR(1), o[0]); o[1] = MF(PAF(1), VFR(5), o[1]); \
            o[0] = MF(PAF(2), VFR(2), o[0]); o[1] = MF(PAF(2), VFR(6), o[1]); o[0] = MF(PAF(3), VFR(3), o[0]); o[1] = MF(PAF(3), VFR(7), o[1]); SBAR(); \
        } while (0)
        ISSUE_K(0); ISSUE_V(0); ISSUE_K(8192); ISSUE_K(16384);
        int jc = __builtin_ctz(tC); tC &= tC - 1u;
        int jn = tC ? __builtin_ctz(tC) : -1; tC &= tC - 1u;
        float mhat = 0.f, l = 0.f; bool started = false, resc = false, last_ = false; f32x16 o[2]; o[0] = (f32x16){}; o[1] = (f32x16){};
        f32x16 pA0 = (f32x16){}, pA1 = (f32x16){}, pB0, pB1, negm;
        u32x4 pw0, pw1, pw2, pw3; s16x4 vtl[8], vth[8]; f16x8 kf[8];
        { const bool mine0 = (br == 1) || (((mysel >> jc) & 1u) != 0u); const float c0 = mine0 ? 0.f : -INFINITY;
#pragma unroll
          for (int r = 0; r < 16; ++r) negm[r] = c0; }
        int kA = 0, kB = 8192, kC = 16384, vM = 0, v0_ = 0, v1 = 8192;
        asm volatile("s_waitcnt vmcnt(0)\n\ts_barrier" ::: "memory");
        { const LAS unsigned char* kp_ = lds + r32 * 128;
#pragma unroll
          for (int j_ = 0; j_ < 4; ++j_) { const LAS unsigned char* kq_ = kp_ + (((2 * j_ + hi) ^ ksw) << 4); kf[2 * j_] = *(const LAS f16x8*)(kq_); kf[2 * j_ + 1] = *(const LAS f16x8*)(kq_ + 4096); } }
        asm volatile("s_waitcnt lgkmcnt(0)\n\ts_barrier" ::: "memory");
        STEP0(pB0, pB1);
        bool inA = false;
#pragma unroll 1
        for (;;) {
            if (jc < 0) break;
            STEP(pA0, pA1, pB0, pB1); inA = true;
            if (jc < 0) break;
            STEP(pB0, pB1, pA0, pA1); inA = false;
        }
        if (inA) { pB0 = pA0; pB1 = pA1; }
        STEPL(pB0, pB1);
        asm volatile("s_waitcnt vmcnt(0)\n\ts_barrier" ::: "memory");
#undef STEP
#undef STEP0
#undef STEPL
#undef GAPA
#undef GAPB
#undef KRD
#undef VRD
#undef VFR
#undef PAF
#undef PKW
#undef MF
#undef PINV
#undef SBAR
#undef ISSUE_K
#undef ISSUE_V
#undef WAITV
        const float lt = swapadd(l);
        const float facb = pfac * ((br == 0) ? gate1 : gate2) / fmaxf(lt, 1e-30f);
        if (br == 0) accum<false>(resw, o, facb, wsf, r32, hi);
        else {
            if (hi == 0) wsf[r32] = facb;
            LAS f16* stg = (LAS f16*)(lds + L_STG + wave * 4096);
            LAS f16* stw = stg + 4 * hi * 64 + r32;
#pragma unroll
            for (int r = 0; r < 16; ++r) { const float a = (wsf + 4 * hi)[crow(r, 0)]; const int orow = crow(r, 0);
                stw[orow * 64] = (f16)fmaf(a, o[0][r], resw[r * 64]); stw[orow * 64 + 32] = (f16)fmaf(a, o[1][r], resw[(16 + r) * 64]); }
            if (bri + 1 == ((ATT_PROBE == 1 || ATT_PROBE == 2) ? 3 : 2)) {
                const size_t m0 = (size_t)b * SEQ + 64 * qb + 32 * qh;
                const int ch = lane & 7; const f32x4 g0 = *(const f32x4*)(ga + h * 64 + ch * 8), g1 = *(const f32x4*)(ga + h * 64 + ch * 8 + 4);
#pragma unroll
                for (int i = 0; i < 4; ++i) { const int row = i * 8 + (lane >> 3); const f16x8 v = *(const LAS f16x8*)(stg + row * 64 + ch * 8);
                    float f[8]; float ss = 0.f;
#pragma unroll
                    for (int e = 0; e < 8; ++e) { f[e] = (float)v[e]; ss += f[e] * f[e]; }
                    u32x4 w; w.x = pk_h2(f[0] * g0[0], f[1] * g0[1]); w.y = pk_h2(f[2] * g0[2], f[3] * g0[3]); w.z = pk_h2(f[4] * g1[0], f[5] * g1[1]); w.w = pk_h2(f[6] * g1[2], f[7] * g1[3]);
                    *(u32x4*)(MIXo + (m0 + row) * DM + h * 64 + ch * 8) = w;
                    ss += __shfl_xor(ss, 1); ss += __shfl_xor(ss, 2); ss += __shfl_xor(ss, 4);
                    if (ch == 0) SSA[(m0 + row) * 8 + h] = ss; }
            }
        }
    }
}
}

struct Args {
    const float* x; const float* c; const int* pos; const float* w_mod; const float* b_mod; const float* norm1_g; const float* w_in;
    const float* pe_k; const float* w1_k; const float* w2_k; const float* pe_v; const float* w1_v; const float* w2_v;
    const float* conv_w; const float* g_attn; const float* g_conv; const float* w_out; const float* norm2_g;
    const float* ffn_up; const float* ffn_conv; const float* ffn_down; const float* final_g;
    float* out; unsigned char* ws; int ph_lo, ph_hi;
};

__device__ __forceinline__ int hperm(int j) { return (j < 4 || j >= 12) ? j : (j < 8 ? j + 4 : j - 4); }
__device__ __forceinline__ int win_colmap(int n) {
    if (n < 512) return (n & ~63) | hperm(n & 63);
    if (n < 1280) { const int r = n - 512; return ((r & 128) == 0) ? 512 + ((r & ~63) | hperm(r & 63)) : n; }
    if (n < 1792) return 1304 + (n - 1280);
    if (n < 2816) { const int r = n - 1792, i = r >> 3, e = r & 7; return (e < 4) ? 1816 + 4 * i + e : 2328 + 4 * i + (e - 4); }
    if (n < 2840) return 1280 + (n - 2816);
    return -1;
}
__device__ __forceinline__ void transpose_item(const float* W, int K, int Nsrc, int Ndst, f16* WT, LAS float* scr, int item, int lane, int colmode = 0, int kmode = 0) {
    const int nblk = Ndst / 32, kb = item / nblk, nb = item % nblk, k0 = 64 * kb, n0 = 32 * nb;
    const int nd = n0 + 4 * (lane & 7), kr = lane >> 3;
    const int sc = (colmode == 1) ? win_colmap(nd) : (colmode == 2) ? ((nd & ~63) | hperm(nd & 63)) : (colmode == 3) ? (((nd & 4) ? DFF : 0) + ((nd >> 3) << 2) + (nd & 3)) : ((nd < Nsrc) ? nd : -1);
#pragma unroll
    for (int i = 0; i < 8; ++i) { const int kk = 8 * i + kr; const int ks = (kmode == 1) ? hperm(kk) : kk;
        const f32x4 v = (sc >= 0) ? __builtin_nontemporal_load((const f32x4*)(W + (size_t)(k0 + ks) * Nsrc + sc)) : (f32x4){0.f, 0.f, 0.f, 0.f};
        LAS float* d = scr + kk * 33 + 4 * (lane & 7); d[0] = v[0]; d[1] = v[1]; d[2] = v[2]; d[3] = v[3]; }
    asm volatile("s_waitcnt lgkmcnt(0)" ::: "memory");
    const int c = lane & 7;
#pragma unroll
    for (int j = 0; j < 4; ++j) { const int n = (lane >> 3) + 8 * j; const LAS float* s = scr + (8 * c) * 33 + n;
        u32x4 o; o.x = pk2h(s[0 * 33], s[1 * 33]); o.y = pk2h(s[2 * 33], s[3 * 33]); o.z = pk2h(s[4 * 33], s[5 * 33]); o.w = pk2h(s[6 * 33], s[7 * 33]);
        *(u32x4*)(WT + (size_t)(n0 + n) * K + k0 + 8 * c) = o; }
    asm volatile("s_waitcnt lgkmcnt(0)" ::: "memory");
}

__device__ __forceinline__ void sincos_d(double a, float& s, float& c) {
    const double k = rint(a * 0.63661977236758134308);
    double r = fma(-k, 1.57079632679489655800e+00, a); r = fma(-k, 6.12323399573676603587e-17, r);
    const double r2 = r * r;
    double sp = -1.0 / 1307674368000.0;
    sp = fma(sp, r2, 1.0 / 6227020800.0);
    sp = fma(sp, r2, -1.0 / 39916800.0);
    sp = fma(sp, r2, 1.0 / 362880.0);
    sp = fma(sp, r2, -1.0 / 5040.0);
    sp = fma(sp, r2, 1.0 / 120.0);
    sp = fma(sp, r2, -1.0 / 6.0);
    const double sn = fma(sp * r2, r, r);
    double cp = 1.0 / 20922789888000.0;
    cp = fma(cp, r2, -1.0 / 87178291200.0);
    cp = fma(cp, r2, 1.0 / 479001600.0);
    cp = fma(cp, r2, -1.0 / 3628800.0);
    cp = fma(cp, r2, 1.0 / 40320.0);
    cp = fma(cp, r2, -1.0 / 720.0);
    cp = fma(cp, r2, 1.0 / 24.0);
    cp = fma(cp, r2, -0.5);
    const double cs = fma(cp, r2, 1.0);
    const int q = ((int)k) & 3;
    const double ss = (q == 0) ? sn : (q == 1) ? cs : (q == 2) ? -sn : -cs;
    const double cc = (q == 0) ? cs : (q == 1) ? -sn : (q == 2) ? -cs : sn;
    s = (float)ss; c = (float)cc;
}


#define XB_TMO      128
#define XB_XCNT(j)  (256  + 64 * (j))
#define XB_XSUB(j)  (1280 + 64 * (j))
#define XB_XGEN(j)  (2304 + 64 * (j))
#define XB_TOP      3328
#define XB_TOPGEN   3392
#define XCD_BAR_WORDS 3456
#define XB_SPIN_CAP (1u << 22)
__device__ __forceinline__ unsigned xb_ld(unsigned* p)              { return __hip_atomic_load(p, __ATOMIC_RELAXED, __HIP_MEMORY_SCOPE_AGENT); }
__device__ __forceinline__ unsigned xb_add(unsigned* p, unsigned v) { return __hip_atomic_fetch_add(p, v, __ATOMIC_RELAXED, __HIP_MEMORY_SCOPE_AGENT); }
__device__ __forceinline__ unsigned xb_xcc_id() { return (unsigned)__builtin_amdgcn_s_getreg((3 << 11) | 20) & 0xFu; }
#define XB_SPIN(cond, bar) do { unsigned _sp = 0; while (cond) { \
    if ((++_sp & 255u) == 0u) { if (xb_ld(&(bar)[XB_TMO])) break; if (_sp > XB_SPIN_CAP) { atomicAdd(&(bar)[XB_TMO], 1u); break; } } } } while (0)
__device__ __forceinline__ int lane_now() { unsigned z = 0u; asm volatile("" : "+v"(z)); return (int)__builtin_amdgcn_mbcnt_hi(~0u, __builtin_amdgcn_mbcnt_lo(~0u, z)); }
struct XcdBarrier { unsigned* bar; unsigned x; volatile LAS unsigned* st; int wv; };
__device__ __forceinline__ XcdBarrier xcd_barrier_post(unsigned* bar, volatile LAS unsigned* st, int wv) {
    XcdBarrier b; b.bar = bar; b.x = xb_xcc_id(); b.st = st; b.wv = wv;
    if (wv == 0 && lane_now() == 0) st[2] = xb_add(&bar[XB_XCNT(b.x)], 1u);
    return b;
}
__device__ __forceinline__ void xcd_barrier_complete(unsigned* bar, unsigned x, unsigned& nloc, unsigned& nx) {
    const unsigned G = gridDim.x * gridDim.y * gridDim.z;
    unsigned sum, cnt, mine, sp = 0u;
    for (;;) {
        sum = 0u; cnt = 0u; mine = 0u;
#pragma unroll
        for (unsigned j = 0; j < 16; ++j) { const unsigned c = xb_ld(&bar[XB_XCNT(j)]); sum += c; cnt += (c > 0u) ? 1u : 0u; mine = (j == x) ? c : mine; }
        if (sum == G) break;
        __builtin_amdgcn_s_sleep(1);
        if ((++sp & 255u) == 0u) { if (xb_ld(&bar[XB_TMO])) break; if (sp > XB_SPIN_CAP) { atomicAdd(&bar[XB_TMO], 1u); break; } }
    }
    nloc = mine > 0u ? mine : 1u; nx = cnt > 0u ? cnt : 1u;
}
__device__ __forceinline__ unsigned xcd_census_uniform(unsigned* bar) {
    unsigned ok = (gridDim.x == 256u) ? 1u : 0u;
#pragma unroll
    for (unsigned j = 0; j < 16; ++j) { const unsigned c = xb_ld(&bar[XB_XCNT(j)]); ok &= (c == (j < 8u ? 32u : 0u)) ? 1u : 0u; }
    return ok;
}
#define XL_SUB(j)   (3456 + 64 * (j))
#define XL_GEN(j)   (4480 + 64 * (j))
__device__ __forceinline__ unsigned xl_add(unsigned* p, unsigned v) { unsigned r; asm volatile("global_atomic_add %0, %1, %2, off sc0\n\ts_waitcnt vmcnt(0)" : "=v"(r) : "v"(p), "v"(v) : "memory"); return r; }
__device__ __forceinline__ unsigned xl_ld(unsigned* p) { unsigned r; const unsigned z = 0u; asm volatile("global_atomic_or %0, %1, %2, off sc0\n\ts_waitcnt vmcnt(0)" : "=v"(r) : "v"(p), "v"(z) : "memory"); return r; }
__device__ __forceinline__ void xcd_local_barrier(const XcdBarrier& b) {
    asm volatile("s_waitcnt vmcnt(0)" ::: "memory");
    __syncthreads();
    if (b.wv == 0 && lane_now() == 0) {
        unsigned* bar = b.bar;
        __builtin_amdgcn_s_waitcnt(0);
        const unsigned nloc = b.st[0];
        const unsigned old = xl_add(&bar[XL_SUB(b.x)], 1u);
        const unsigned gen = old / nloc;
        if (old + 1u == (gen + 1u) * nloc) { (void)xl_add(&bar[XL_GEN(b.x)], 1u); __builtin_amdgcn_fence(__ATOMIC_ACQUIRE, "agent"); }
        else { __builtin_amdgcn_fence(__ATOMIC_ACQUIRE, "agent"); unsigned sp_ = 0u; while (xb_ld(&bar[XL_GEN(b.x)]) == gen) { if ((++sp_ & 1023u) == 0u) { if (xb_ld(&bar[XB_TMO])) break; if (sp_ > XB_SPIN_CAP) { atomicAdd(&bar[XB_TMO], 1u); break; } } } }
        asm volatile("s_waitcnt vmcnt(0)" ::: "memory");
    }
    __syncthreads();
}
__device__ __forceinline__ void xcd_barrier(const XcdBarrier& b) {
    asm volatile("s_waitcnt vmcnt(0)" ::: "memory");
    __syncthreads();
    if (b.wv == 0 && lane_now() == 0) {
        unsigned* bar = b.bar;
        __builtin_amdgcn_s_waitcnt(0);
        unsigned nloc = b.st[0], nx = b.st[1];
        if (nloc == 0u) { xcd_barrier_complete(bar, b.x, nloc, nx); b.st[0] = nloc; b.st[1] = nx; }
        const unsigned old = xb_add(&bar[XB_XSUB(b.x)], 1u);
        const unsigned gen = old / nloc;
        if (old + 1u == (gen + 1u) * nloc) {
            __builtin_amdgcn_fence(__ATOMIC_RELEASE, "agent");
            asm volatile("s_waitcnt vmcnt(0)" ::: "memory");
            const unsigned og = xb_add(&bar[XB_TOP], 1u);
            const unsigned tg = og / nx;
            if (og + 1u == (tg + 1u) * nx) xb_add(&bar[XB_TOPGEN], 1u);
            else XB_SPIN(xb_ld(&bar[XB_TOPGEN]) == tg, bar);
            __builtin_amdgcn_fence(__ATOMIC_ACQUIRE, "agent");
            xb_add(&bar[XB_XGEN(b.x)], 1u);
            asm volatile("s_waitcnt vmcnt(0)" ::: "memory");
        } else {
            XB_SPIN(xb_ld(&bar[XB_XGEN(b.x)]) == gen, bar);
            __builtin_amdgcn_fence(__ATOMIC_ACQUIRE, "agent");
            asm volatile("s_waitcnt vmcnt(0)" ::: "memory");
        }
    }
    __syncthreads();
}

__device__ __forceinline__ void ramp_delay(int bx, unsigned long long ticks) {
    const unsigned long long t0_ = __builtin_amdgcn_s_memrealtime(), dl_ = (unsigned long long)((bx >> 3) & 7) * ticks;
    while (__builtin_amdgcn_s_memrealtime() - t0_ < dl_) __builtin_amdgcn_s_sleep(8);
}

template <int ph>
__device__ __forceinline__ void run_phase(LAS unsigned char* lds, const Args& A, const int cidx, const int wv) {
    {
        int tid = wv * 64 + lane_now(); asm volatile("" : "+v"(tid));
        const int lane = tid & 63, wave = __builtin_amdgcn_readfirstlane(tid >> 6);
        int G = gridDim.x, bx = cidx; asm volatile("" : "+s"(G), "+s"(bx));
        const int gw = bx * NWAVES + wave, NGW = G * NWAVES;
        const int gt = bx * NTHREADS + tid, NGT = G * NTHREADS;
        unsigned char* ws = A.ws;
        float* MOD = (float*)(ws + WS_MOD);
        float* ROPE = (float*)(ws + WS_ROPE);
        f16* HALO = (f16*)(ws + WS_HALO);
        f16* Hb = (f16*)(ws + WS_H);
        f16* KCMP = (f16*)(ws + WS_KCMP);
        float* Gt = (float*)(ws + WS_G);
        f16* U = (f16*)(ws + WS_U);
        f16* RAWb = (f16*)(ws + WS_RAW);
        float* SSA = (float*)(ws + WS_SSA); float* SSC = (float*)(ws + WS_SSC);
        float* SSP = (float*)(ws + WS_SSP); float* BIAS1 = (float*)(ws + WS_BIAS1); float* BIAS2 = (float*)(ws + WS_BIAS2);
        f16* MIX = (f16*)((char*)A.out + (size_t)64 * MiB);
        f16* Qb = (f16*)(ws + WS_Q);
        f16* KVb = (f16*)(ws + WS_KV);
        f16* CBb = (f16*)(ws + WS_CB);
        f16* Pb = (f16*)(ws + WS_P);
        constexpr int l = ph_l(ph);
        constexpr int k = ph_k(ph);
        unsigned char* wl = ws + WS_W + (size_t)l * W_LAYER;
        f16* Win_t = (f16*)(wl + W_IN_OFF); f16* Wout_t = (f16*)(wl + W_OUT_OFF); f16* Wup_t = (f16*)(wl + W_UP_OFF); f16* Wdown_t = (f16*)(wl + W_DOWN_OFF);
        const float* modl = MOD + (size_t)l * 16 * 6144;

        if (PH_EN(14) && k == 100) {
            {
                LAS float* scr = (LAS float*)(lds + wave * 16384);
                constexpr int I_IN = 16 * (NINP / 32), I_OUT = 16 * 32, I_UP = 16 * (NUP / 32), I_DN = (DFF / 64) * 32, I_L = I_IN + I_OUT + I_UP + I_DN;
                for (int it = gw; it < 2 * I_L; it += NGW) {
                    const int ll = it / I_L; int r = it % I_L;
                    unsigned char* wll = ws + WS_W + (size_t)ll * W_LAYER;
                    if (r < I_IN) { transpose_item(A.w_in + (size_t)ll * DM * NIN, DM, NIN, NINP, (f16*)(wll + W_IN_OFF), scr, r, lane, 1, 0); continue; } r -= I_IN;
                    if (r < I_OUT) { transpose_item(A.w_out + (size_t)ll * DM * DM, DM, DM, DM, (f16*)(wll + W_OUT_OFF), scr, r, lane); continue; } r -= I_OUT;
                    if (r < I_UP) { transpose_item(A.ffn_up + (size_t)ll * DM * NUP, DM, NUP, NUP, (f16*)(wll + W_UP_OFF), scr, r, lane, 3, 0); continue; } r -= I_UP;
                    transpose_item(A.ffn_down + (size_t)ll * DFF * DM, DFF, DM, DM, (f16*)(wll + W_DOWN_OFF), scr, r, lane);
                }
                for (int it = gw; it < 4 * 128 + 4 * 4; it += NGW) {
                    if (it < 512) { const int mi = it >> 7, ll = mi >> 1, kv = mi & 1;
                        transpose_item((kv ? A.w1_v : A.w1_k) + (size_t)ll * 2048 * 128, 2048, 128, 128, (f16*)(ws + WS_W1T) + (size_t)mi * 128 * 2048, scr, it & 127, lane, 0, kv == 0 ? 1 : 0); }
                    else { const int r = it - 512, mi = r >> 2, ll = mi >> 1, kv = mi & 1;
                        transpose_item((kv ? A.w2_v : A.w2_k) + (size_t)ll * 128 * 64, 128, 64, 64, (f16*)(ws + WS_W2T) + (size_t)mi * 64 * 128, scr, r & 3, lane, kv == 0 ? 2 : 0, 0); }
                }
            }
            __syncthreads();
            for (int it = gt; it < MTOK * 8; it += NGT) {
                const int m = it >> 3, i = it & 7;
                const double fr = (i == 0) ? 1.0 : (i == 1) ? 0.19392274474868576 : (i == 2) ? 0.03760603093086393 : (i == 3) ? 0.007292664737217109 :
                                  (i == 4) ? 0.001414213562373095 : (i == 5) ? 0.0002742481756762073 : (i == 6) ? 5.318295896944988e-05 : 1.031338537721246e-05;
                float s, c; sincos_d((double)A.pos[m] * fr, s, c);
                ROPE[(size_t)m * 16 + i] = c; ROPE[(size_t)m * 16 + 8 + i] = s;
            }
            {
                LAS float* red = (LAS float*)(lds + 65536);
                for (int it = G - 1 - bx; it < 8; it += G) {
                    const int mi = it >> 1, ll = mi >> 1, kv = mi & 1, n0 = (it & 1) * 64;
                    const float* pe = (kv ? A.pe_v : A.pe_k) + (size_t)ll * 2048; const float* w1 = (kv ? A.w1_v : A.w1_k) + (size_t)ll * 2048 * 128 + n0 + lane;
                    float acc = 0.f;
                    for (int ld = wave * 256; ld < wave * 256 + 256; ld += 32) {
                        float w[32];
#pragma unroll
                        for (int u = 0; u < 32; ++u) w[u] = w1[(size_t)(ld + u) * 128];
#pragma unroll
                        for (int u = 0; u < 32; ++u) acc = fmaf(pe[ld + u], w[u], acc);
                    }
                    __syncthreads();
                    red[wave * 64 + lane] = acc;
                    __syncthreads();
                    if (tid < 64) { float sacc = 0.f;
#pragma unroll
                        for (int w8 = 0; w8 < 8; ++w8) sacc += red[w8 * 64 + tid];
                        ((float*)(ws + WS_BPE))[mi * 128 + n0 + tid] = sacc; }
                }
                __syncthreads();
            }
            {
                LAS float* ca = (LAS float*)lds;
                LAS float* red = (LAS float*)(lds + 65536);
                bool staged = false;
                for (int it = bx; it < 2 * 96; it += G) {
                    if (!staged) {
                        for (int i0 = tid; i0 < 16 * 1024; i0 += 8 * NTHREADS) { float cv[8];
#pragma unroll
                            for (int j = 0; j < 8; ++j) cv[j] = A.c[i0 + j * NTHREADS];
#pragma unroll
                            for (int j = 0; j < 8; ++j) ca[i0 + j * NTHREADS] = silu_f(cv[j]); }
                        staged = true; }
                    __syncthreads();
                    const int ll = it / 96, n0 = (it % 96) * 64;
                    const float* wm = A.w_mod + (size_t)ll * DM * 6144 + n0 + lane;
                    float acc[16];
#pragma unroll
                    for (int b = 0; b < 16; ++b) acc[b] = 0.f;
                    for (int kk = wave * 128; kk < wave * 128 + 128; kk += 32) {
                        float w[32];
#pragma unroll
                        for (int u = 0; u < 32; ++u) w[u] = __builtin_nontemporal_load(wm + (size_t)(kk + u) * 6144);
#pragma unroll
                        for (int b = 0; b < 16; ++b)
#pragma unroll
                            for (int u = 0; u < 32; u += 4) { const f32x4 c4 = *(const LAS f32x4*)(ca + b * 1024 + kk + u);
                                acc[b] = fmaf(c4[0], w[u], acc[b]); acc[b] = fmaf(c4[1], w[u + 1], acc[b]); acc[b] = fmaf(c4[2], w[u + 2], acc[b]); acc[b] = fmaf(c4[3], w[u + 3], acc[b]); }
                    }
#pragma unroll
                    for (int b = 0; b < 16; ++b) red[(wave * 16 + b) * 64 + lane] = acc[b];
                    __syncthreads();
                    for (int o = tid; o < 1024; o += NTHREADS) { const int b = o >> 6, n = o & 63; float s = 0.f;
#pragma unroll
                        for (int w8 = 0; w8 < 8; ++w8) s += red[(w8 * 16 + b) * 64 + n];
                        MOD[((size_t)ll * 16 + b) * 6144 + n0 + n] = s + A.b_mod[(size_t)ll * 6144 + n0 + n]; }
                    __syncthreads();
                }
            }
        } else if (PH_EN(0) && k == 0) {
            const float* xin = (k == 0 && l == 0) ? A.x : A.out;
            const float* gain = (k == 0 ? A.norm1_g : A.norm2_g) + (size_t)l * DM;
            const float* shp = modl + (k == 0 ? 0 : 3) * 1024; const float* scp = modl + (k == 0 ? 1 : 4) * 1024;
            for (int v = bx; v < 256; v += G) { const int m0 = 16 * (((v & 7) * 32 + (v >> 3)) * NWAVES + wave);
                const int b = m0 >> 11;
                f32x4 gs[4], sh4[4];
#pragma unroll
                for (int j = 0; j < 4; ++j) { const int col = 4 * lane + 256 * j;
                    gs[j] = *(const f32x4*)(gain + col) * (*(const f32x4*)(scp + (size_t)b * 6144 + col) + 1.0f); sh4[j] = *(const f32x4*)(shp + (size_t)b * 6144 + col); }
#pragma unroll 4
                for (int q = 0; q < 16; ++q) { const int m = m0 + q;
                    const f32x4* xr = (const f32x4*)(xin + (size_t)m * DM) + lane;
                    f32x4 v[4]; float s = 0.f;
#pragma unroll
                    for (int j = 0; j < 4; ++j) { v[j] = __builtin_nontemporal_load(xr + 64 * j); s += (v[j].x * v[j].x + v[j].y * v[j].y) + (v[j].z * v[j].z + v[j].w * v[j].w); }
                    const float r = 1.0f / sqrtf(wave_sum(s) * (1.0f / DM) + 1e-6f);
#pragma unroll
                    for (int j = 0; j < 4; ++j) { const int col = 4 * lane + 256 * j;
                        const f32x4 o = (v[j] * r) * gs[j] + sh4[j];
                        u32x2 w; w.x = pk2h(o.x, o.y); w.y = pk2h(o.z, o.w);
                        *(u32x2*)(Hb + (size_t)m * DM + col) = w; } }
            }
        } else if (PH_EN(1) && (k == 1 || k == 7)) {
            if (k == 1) {
                const pg8::Gemm g{Hb, Win_t, MTOK, NINP, DM, DM};
                pg8::StaticOrder S; S.init(g.M, g.N, G, bx);
                if (l == 0) { const pg8::EpiIn<false> E{Qb, KVb, CBb, Pb, Gt, ROPE, nullptr, nullptr}; pg8::gemm_phase<pg8::EpiIn<false>, pg8::StaticOrder, true, true>(lds, g, S, E, tid); }
                else { const pg8::EpiIn<true> E{Qb, KVb, CBb, Pb, Gt, ROPE, SSP, BIAS1}; pg8::gemm_phase<pg8::EpiIn<true>, pg8::StaticOrder, true, true>(lds, g, S, E, tid); }
            } else {
                const pg8::Gemm g{Hb, Wup_t, MTOK, NUP, DM, DM}; const pg8::EpiUp E{U, HALO, RAWb, A.ffn_conv + (size_t)l * 3 * NUP, (LAS float*)(lds + RING_BYTES + 2048), SSP, BIAS2 + (size_t)l * 16 * NUP, (LAS float*)(lds + RING_BYTES + 11264), lds + RING_BYTES};
                pg8::StaticOrder S; S.init(g.M, g.N, G, bx);
                pg8::gemm_phase<pg8::EpiUp, pg8::StaticOrder, true, true>(lds, g, S, E, tid);
            }
        } else if (PH_EN(8) && (k == 5 || k == 9)) {
            LAS float* part = (LAS float*)(lds + RING_BYTES + 2048);
            f16* X16 = (f16*)A.out;
            float* XF = (float*)(ws + WS_XF);
            if (k == 5) {
                const pg8::Gemm g{MIX, Wout_t, MTOK, DM, DM, DM}; pg8::StaticOrder S; S.init(g.M, g.N, G, bx);
                LAS float* rat = (LAS float*)(lds + RING_BYTES + 6144); LAS float* rcs = rat + 256;
                pg8::Unit u0; const bool any0 = S.next(0, u0);
                if (l == 0) { const pg8::EpiResid<true, false, true, true> E{A.x, X16, modl + 2 * 1024, Hb, A.norm2_g + (size_t)l * DM, modl + 4 * 1024, SSP, part, SSA, SSC, rat, rcs};
                    if (any0) E.rows(u0.pm, tid); __syncthreads();
                    pg8::gemm_phase<pg8::EpiResid<true, false, true, true>, pg8::StaticOrder, true, true>(lds, g, S, E, tid); }
                else { const pg8::EpiResid<true, true, true, true> E{X16, X16, modl + 2 * 1024, Hb, A.norm2_g + (size_t)l * DM, modl + 4 * 1024, SSP, part, SSA, SSC, rat, rcs};
                    if (any0) E.rows(u0.pm, tid); __syncthreads();
                    pg8::gemm_phase<pg8::EpiResid<true, true, true, true>, pg8::StaticOrder, true, true>(lds, g, S, E, tid); }
            } else if (l == 0) {
            {
                const float* fc = A.ffn_conv + (size_t)l * 3 * NUP;
                pg8::StaticOrder S0; S0.init(MTOK, DM, G, bx); pg8::Unit uu;
                for (int ui = 0; S0.next(ui, uu); ++ui) { const int pm = uu.pm;
                    for (int it = tid; it < 2 * (DFF / 4); it += NTHREADS) {
                        const int i = it % (DFF / 4), rr = it / (DFF / 4); const int c = 8 * i, f0 = 4 * i;
                        const f16x8 cur = *(const f16x8*)(RAWb + ((size_t)pm * 2 + rr) * NUP + c);
                        f16x8 p1 = (f16x8)(f16)0.f, p2 = (f16x8)(f16)0.f;
                        if ((pm & 7) != 0) { const f16* hp = HALO + (size_t)(4 * pm - 1) * 2 * NUP + c;
                            if (rr == 0) { p1 = *(const f16x8*)(hp + NUP); p2 = *(const f16x8*)hp; } else p2 = *(const f16x8*)(hp + NUP); }
                        if (rr == 1) p1 = *(const f16x8*)(RAWb + (size_t)pm * 2 * NUP + c);
                        float o[4];
#pragma unroll
                        for (int e = 0; e < 4; ++e) {
                            const float ya = fc[f0 + e] * (float)p2[e] + fc[NUP + f0 + e] * (float)p1[e] + fc[2 * NUP + f0 + e] * (float)cur[e];
                            const float yv = fc[DFF + f0 + e] * (float)p2[4 + e] + fc[NUP + DFF + f0 + e] * (float)p1[4 + e] + fc[2 * NUP + DFF + f0 + e] * (float)cur[4 + e];
                            o[e] = silu_f(ya) * yv; }
                        u32x2 w; w.x = pk2h(o[0], o[1]); w.y = pk2h(o[2], o[3]);
                        *(u32x2*)(U + (size_t)(256 * pm + rr) * DFF + f0) = w;
                    }
                }
                asm volatile("s_waitcnt vmcnt(0)" ::: "memory");
                __syncthreads();
            }
                const pg8::Gemm g{U, Wdown_t, MTOK, DM, DFF, DFF}; pg8::StaticOrder S; S.init(g.M, g.N, G, bx);
                const pg8::EpiResid<true, true, true> E{X16, X16, modl + 5 * 1024, Hb, A.norm1_g + (size_t)1 * DM, MOD + (size_t)16 * 6144 + 1 * 1024, SSP, part, nullptr, nullptr, nullptr, nullptr};
                pg8::gemm_phase<pg8::EpiResid<true, true, true>, pg8::StaticOrder, true, true>(lds, g, S, E, tid);
            } else {
            {
                const float* fc = A.ffn_conv + (size_t)l * 3 * NUP;
                pg8::StaticOrder S0; S0.init(MTOK, DM, G, bx); pg8::Unit uu;
                for (int ui = 0; S0.next(ui, uu); ++ui) { const int pm = uu.pm;
                    for (int it = tid; it < 2 * (DFF / 4); it += NTHREADS) {
                        const int i = it % (DFF / 4), rr = it / (DFF / 4); const int c = 8 * i, f0 = 4 * i;
                        const f16x8 cur = *(const f16x8*)(RAWb + ((size_t)pm * 2 + rr) * NUP + c);
                        f16x8 p1 = (f16x8)(f16)0.f, p2 = (f16x8)(f16)0.f;
                        if ((pm & 7) != 0) { const f16* hp = HALO + (size_t)(4 * pm - 1) * 2 * NUP + c;
                            if (rr == 0) { p1 = *(const f16x8*)(hp + NUP); p2 = *(const f16x8*)hp; } else p2 = *(const f16x8*)(hp + NUP); }
                        if (rr == 1) p1 = *(const f16x8*)(RAWb + (size_t)pm * 2 * NUP + c);
                        float o[4];
#pragma unroll
                        for (int e = 0; e < 4; ++e) {
                            const float ya = fc[f0 + e] * (float)p2[e] + fc[NUP + f0 + e] * (float)p1[e] + fc[2 * NUP + f0 + e] * (float)cur[e];
                            const float yv = fc[DFF + f0 + e] * (float)p2[4 + e] + fc[NUP + DFF + f0 + e] * (float)p1[4 + e] + fc[2 * NUP + DFF + f0 + e] * (float)cur[4 + e];
                            o[e] = silu_f(ya) * yv; }
                        u32x2 w; w.x = pk2h(o[0], o[1]); w.y = pk2h(o[2], o[3]);
                        *(u32x2*)(U + (size_t)(256 * pm + rr) * DFF + f0) = w;
                    }
                }
                asm volatile("s_waitcnt vmcnt(0)" ::: "memory");
                __syncthreads();
            }
                const pg8::Gemm g{U, Wdown_t, MTOK, DM, DFF, DFF}; pg8::StaticOrder S; S.init(g.M, g.N, G, bx);
                const pg8::EpiResid<false, true, true> E{X16, (f16*)XF, modl + 5 * 1024, nullptr, nullptr, nullptr, nullptr, nullptr, nullptr, nullptr, nullptr, nullptr};
                pg8::gemm_phase<pg8::EpiResid<false, true, true>, pg8::StaticOrder, true, true>(lds, g, S, E, tid);
            }
        } else if (PH_EN(3) && k == 2) {
            typedef float f32x4v __attribute__((ext_vector_type(4)));
            constexpr int HS = 136;
            constexpr int L_TOK = 0, L_WR = 67584, L_HID = 116736;
            LAS f16* hid = (LAS f16*)(lds + L_HID);
            const unsigned lds0 = (unsigned)(__UINTPTR_TYPE__)lds;
            for (int it = bx; it < 256; it += G) {
                const int iv = (it & 7) * 32 + (it >> 3), b = iv >> 4, kv = (iv >> 3) & 1, hk = (iv >> 2) & 1, j0 = 32 * (iv & 3);
                const int rt = wave >> 2, cg4 = wave & 3, fr = lane & 15, fq = lane >> 4;
                const f16* src = KVb + (size_t)kv * (KV_STRIDE / 2) + (size_t)b * SEQ * 128 + hk * 64;
                const f16* w1t = (const f16*)(ws + WS_W1T) + (size_t)(l * 2 + kv) * 128 * 2048 + (size_t)(16 * wave) * 2048;
                __syncthreads();
                for (int gI = wave; gI < 66; gI += NWAVES) { const int piece = gI * 64 + lane, row = piece >> 3, pp = piece & 7;
                    const int tok = min(16 * j0 + row, SEQ - 1);
                    att::glds16(src + (size_t)tok * 128 + 8 * (pp ^ ((row >> 4) & 7)), (unsigned)__builtin_amdgcn_readfirstlane((int)(lds0 + L_TOK + gI * 1024))); }
                asm volatile("s_waitcnt vmcnt(0)\n\ts_barrier" ::: "memory");
                const unsigned wring = lds0 + L_WR + wave * 6144;
#define CMP_ISSUE_W(t_, slot_) do { _Pragma("unroll") for (int i_ = 0; i_ < 2; ++i_) { const int piece = i_ * 64 + lane, n_ = piece >> 3, pp = piece & 7; \
                        att::glds16(w1t + (size_t)n_ * 2048 + 64 * (t_) + 8 * (pp ^ (n_ & 7)), (unsigned)__builtin_amdgcn_readfirstlane((int)(wring + (slot_) * 2048 + i_ * 1024))); } } while (0)
                CMP_ISSUE_W(0, 0); CMP_ISSUE_W(1, 1);
                f32x4v acc0 = {0.f, 0.f, 0.f, 0.f}, acc1 = {0.f, 0.f, 0.f, 0.f};
                const LAS unsigned char* wbase = lds + L_WR + wave * 6144 + fr * 128; const int bs = fr & 7;
                int slot = 0;
#pragma unroll 2
                for (int t = 0; t < 32; ++t) {
                    { const int t2 = (t + 2 < 32) ? t + 2 : 31; const int s2 = (slot >= 1) ? slot - 1 : 2; CMP_ISSUE_W(t2, s2); }
                    asm volatile("s_waitcnt vmcnt(4)" ::: "memory");
                    const int tr0 = 16 * fr + t, tr1 = 16 * (16 + fr) + t;
                    const LAS unsigned char* ab0 = lds + L_TOK + tr0 * 128; const LAS unsigned char* ab1 = lds + L_TOK + tr1 * 128;
                    const int as0 = (tr0 >> 4) & 7, as1 = (tr1 >> 4) & 7;
                    const f16x8 a00 = *(const LAS f16x8*)(ab0 + ((fq ^ as0) << 4)), a01 = *(const LAS f16x8*)(ab0 + (((4 + fq) ^ as0) << 4));
                    const f16x8 a10 = *(const LAS f16x8*)(ab1 + ((fq ^ as1) << 4)), a11 = *(const LAS f16x8*)(ab1 + (((4 + fq) ^ as1) << 4));
                    const LAS unsigned char* wb = wbase + slot * 2048;
                    const f16x8 b0 = *(const LAS f16x8*)(wb + ((fq ^ bs) << 4)), b1 = *(const LAS f16x8*)(wb + (((4 + fq) ^ bs) << 4));
                    acc0 = __builtin_amdgcn_mfma_f32_16x16x32_f16(a00, b0, acc0, 0, 0, 0); acc1 = __builtin_amdgcn_mfma_f32_16x16x32_f16(a10, b0, acc1, 0, 0, 0);
                    acc0 = __builtin_amdgcn_mfma_f32_16x16x32_f16(a01, b1, acc0, 0, 0, 0); acc1 = __builtin_amdgcn_mfma_f32_16x16x32_f16(a11, b1, acc1, 0, 0, 0);
                    slot = (slot == 2) ? 0 : slot + 1;
                }
                asm volatile("s_waitcnt vmcnt(0)" ::: "memory");
#undef CMP_ISSUE_W
                const float bp = ((const float*)(ws + WS_BPE))[(l * 2 + kv) * 128 + 16 * wave + fr];
                __syncthreads();
#pragma unroll
                for (int r = 0; r < 4; ++r) { hid[(4 * fq + r) * HS + 16 * wave + fr] = (f16)silu_f(acc0[r] + bp); hid[(16 + 4 * fq + r) * HS + 16 * wave + fr] = (f16)silu_f(acc1[r] + bp); }
                __syncthreads();
                const f16* w2t = (const f16*)(ws + WS_W2T) + (size_t)(l * 2 + kv) * 64 * 128 + (size_t)(16 * cg4 + fr) * 128 + 8 * fq;
                f32x4v o = {0.f, 0.f, 0.f, 0.f};
#pragma unroll
                for (int ks = 0; ks < 4; ++ks) {
                    const f16x8 a = *(const LAS f16x8*)(hid + (16 * rt + fr) * HS + 32 * ks + 8 * fq);
                    const f16x8 bb = *(const f16x8*)(w2t + 32 * ks);
                    o = __builtin_amdgcn_mfma_f32_16x16x32_f16(a, bb, o, 0, 0, 0);
                }
#pragma unroll
                for (int r = 0; r < 4; ++r) { const int jj = j0 + 16 * rt + 4 * fq + r;
                    KCMP[(((size_t)kv * 16 + b) * 2 + hk) * 128 * 64 + (size_t)jj * 64 + 16 * cg4 + fr] = (jj < 127) ? (f16)o[r] : (f16)0.f; }
            }
            if (l == 0) {
                typedef float f32x4v __attribute__((ext_vector_type(4)));
                const int fr = lane & 15, fq = lane >> 4;
                for (int it = NGW - 1 - gw; it < 192 + 2 * 352; it += NGW) {
                    const int mat = (it < 192) ? 0 : 1 + (it - 192) / 352, grp = (it < 192) ? it : (it - 192) % 352, lp = (mat == 0) ? 1 : mat - 1;
                    const float* shsrc = MOD + ((size_t)lp * 16 + fr) * 6144 + ((mat == 0) ? 0 : 3 * 1024) + 8 * fq;
                    const f16* wt = (const f16*)(ws + WS_W + (size_t)lp * W_LAYER + ((mat == 0) ? W_IN_OFF : W_UP_OFF)) + (size_t)(16 * grp + fr) * DM + 8 * fq;
                    f32x4v acc = {0.f, 0.f, 0.f, 0.f};
#pragma unroll 8
                    for (int kk = 0; kk < 32; ++kk) {
                        const f32x4 s0 = *(const f32x4*)(shsrc + 32 * kk), s1 = *(const f32x4*)(shsrc + 32 * kk + 4);
                        const f16x8 a = {(f16)s0[0], (f16)s0[1], (f16)s0[2], (f16)s0[3], (f16)s1[0], (f16)s1[1], (f16)s1[2], (f16)s1[3]};
                        const f16x8 bb = *(const f16x8*)(wt + 32 * kk);
                        acc = __builtin_amdgcn_mfma_f32_16x16x32_f16(a, bb, acc, 0, 0, 0);
                    }
                    float* dst = (mat == 0) ? BIAS1 : BIAS2 + (size_t)lp * 16 * NUP; const int Nd = (mat == 0) ? NINP : NUP;
#pragma unroll
                    for (int r = 0; r < 4; ++r) dst[(size_t)(4 * fq + r) * Nd + 16 * grp + fr] = acc[r];
                }
            }
        } else if (PH_EN(4) && k == 3) {
            for (int it = bx; it < 1024; it += G) {
                const int i4 = it >> 8, c = it & 255, vcu = (c & 7) * 32 + (c >> 3), bh = vcu >> 3, sq = vcu & 7;
                const int qb = (i4 == 0) ? sq : (i4 == 1) ? 15 - sq : (i4 == 2) ? 16 + sq : 31 - sq;
                int tidu = tid; asm volatile("" : "+v"(tidu));
                att::attn_unit(lds, bh >> 1, bh & 1, qb, Qb, KVb, KCMP, Gt, MIX, SSA, SSC, CBb, Pb, A.g_attn + (size_t)l * 512, A.g_conv + (size_t)l * 512, A.conv_w + (size_t)l * 3 * 512, tidu);
            }
        } else if (PH_EN(15) && k == 101) {
            for (int v = bx; v < 256; v += G)
            for (int q = 0; q < 16; ++q) { const int m = 16 * (((v & 7) * 32 + (v >> 3)) * NWAVES + wave) + q;
                const f16x8* xs = (const f16x8*)((const f16*)(ws + WS_XF) + (size_t)m * DM) + lane;
                float* xr = A.out + (size_t)m * DM + 8 * lane;
                f16x8 hv[2]; float v[2][8]; float s = 0.f;
#pragma unroll
                for (int j = 0; j < 2; ++j) { hv[j] = __builtin_nontemporal_load(xs + 64 * j);
#pragma unroll
                    for (int e = 0; e < 8; ++e) { v[j][e] = (float)hv[j][e]; s += v[j][e] * v[j][e]; } }
                const float r = 1.0f / sqrtf(wave_sum(s) * (1.0f / DM) + 1e-6f);
#pragma unroll
                for (int j = 0; j < 2; ++j) { const f32x4 g0 = *(const f32x4*)(A.final_g + 512 * j + 8 * lane), g1 = *(const f32x4*)(A.final_g + 512 * j + 8 * lane + 4);
                    __builtin_nontemporal_store((f32x4){v[j][0] * r * g0[0], v[j][1] * r * g0[1], v[j][2] * r * g0[2], v[j][3] * r * g0[3]}, (f32x4*)(xr + 512 * j));
                    __builtin_nontemporal_store((f32x4){v[j][4] * r * g1[0], v[j][5] * r * g1[1], v[j][6] * r * g1[2], v[j][7] * r * g1[3]}, (f32x4*)(xr + 512 * j + 4)); }
            }
        }
    }
}

__global__ void __launch_bounds__(NTHREADS, 2) fwd_kernel(Args A0) {
    extern __shared__ __attribute__((aligned(16))) unsigned char lds_raw[];
    LAS unsigned char* lds = (LAS unsigned char*)lds_raw;
    cg::grid_group grid = cg::this_grid();
    const int ph_lo = A0.ph_lo, ph_hi = A0.ph_hi;
    volatile LAS unsigned* bst = (volatile LAS unsigned*)(lds + RING_BYTES + 352);
    if (threadIdx.x < 5) bst[threadIdx.x] = 0u;
    __syncthreads();
    const int wv0 = __builtin_amdgcn_readfirstlane((int)(threadIdx.x >> 6));
    const XcdBarrier xbar = xcd_barrier_post((unsigned*)(A0.ws + WS_CTL) + 4096, bst, wv0);
#ifndef DUPMASK
#define DUPMASK 0u
#endif
#define DUP_K(P) ((ph_k(P) < 16) ? (((DUPMASK) >> ph_k(P)) & 1u) : 0u)
#ifndef TSEL_K
#define TSEL_K (-1)
#endif
    volatile LAS unsigned long long* tl_ = (volatile LAS unsigned long long*)(lds + RING_BYTES + 384);
    if (TSEL_K >= 0 && wv0 == 0 && lane_now() == 0) { tl_[0] = 0ull; tl_[1] = 0ull; }
    int cidx = blockIdx.x; unsigned fastb = 0u;
#define PH_FULL(P) ((P) == 0 || (P) == 3 || (P) == 13)
#define STEP(P) if (ph_lo <= (P) && (P) < ph_hi) { if (TSEL_K >= 0 && ph_k(P) == TSEL_K && wv0 == 0 && lane_now() == 0) tl_[1] = __builtin_amdgcn_s_memrealtime(); \
        run_phase<(P)>(lds, A0, cidx, wv0); if (DUP_K(P)) { __syncthreads(); run_phase<(P)>(lds, A0, cidx, wv0); } \
        if ((P) + 1 < ph_hi) { if (!PH_FULL(P) && fastb) xcd_local_barrier(xbar); else xcd_barrier(xbar); } \
        if ((P) == 0 && ph_lo == 0 && ph_hi > 1) { if (wv0 == 0 && lane_now() == 0) bst[3] = xcd_census_uniform(xbar.bar); __syncthreads(); \
            fastb = (unsigned)__builtin_amdgcn_readfirstlane((int)bst[3]); if (fastb) cidx = __builtin_amdgcn_readfirstlane((int)(bst[2] * 8u + xbar.x)); } \
        if (TSEL_K >= 0 && ph_k(P) == TSEL_K && wv0 == 0 && lane_now() == 0) tl_[0] += __builtin_amdgcn_s_memrealtime() - tl_[1]; }
    if (ph_hi > 1000) grid.sync();
    STEP(0) STEP(1) STEP(2) STEP(3) STEP(4) STEP(5) STEP(6) STEP(7) STEP(8) STEP(9)
    STEP(10) STEP(11) STEP(12) STEP(13) STEP(14)
#undef STEP
    if (TSEL_K >= 0) { __syncthreads(); if (blockIdx.x == 0 && wv0 == 0 && lane_now() == 0) { asm volatile("s_waitcnt vmcnt(0)" ::: "memory"); A0.out[0] += (float)tl_[0] * (0.01f / 8.0f); } }
}

extern "C" void kernel_launch(void* const* d_in, const int* in_sizes, int n_in, void* d_out, int out_size, void* d_ws, size_t ws_size, hipStream_t stream) {
    static int grid = 0;
    if (grid == 0) {
        if (n_in != 22 || out_size != MTOK * DM || ws_size < WS_END) { fprintf(stderr, "kernel_launch: unexpected shapes (n_in %d out %d ws %zu)\n", n_in, out_size, ws_size); grid = -1; return; }
        int dev = 0, cus = 0, per_cu = 0;
        hipGetDevice(&dev);
        hipDeviceGetAttribute(&cus, hipDeviceAttributeMultiprocessorCount, dev);
        hipFuncSetAttribute((const void*)fwd_kernel, hipFuncAttributeMaxDynamicSharedMemorySize, LDS_BYTES);
        hipOccupancyMaxActiveBlocksPerMultiprocessor(&per_cu, (const void*)fwd_kernel, NTHREADS, LDS_BYTES);
        (void)hipGetLastError();
        if (per_cu < 1) per_cu = 1;
        grid = cus * per_cu;
    }
    if (grid < 0) return;
    if (hipMemsetAsync((char*)d_ws + WS_CTL, 0, 65536, stream) != hipSuccess) { fprintf(stderr, "kernel_launch: memset failed\n"); return; }
    Args a{};
    a.x = (const float*)d_in[0]; a.c = (const float*)d_in[1]; a.pos = (const int*)d_in[2]; a.w_mod = (const float*)d_in[3]; a.b_mod = (const float*)d_in[4];
    a.norm1_g = (const float*)d_in[5]; a.w_in = (const float*)d_in[6]; a.pe_k = (const float*)d_in[7]; a.w1_k = (const float*)d_in[8]; a.w2_k = (const float*)d_in[9];
    a.pe_v = (const float*)d_in[10]; a.w1_v = (const float*)d_in[11]; a.w2_v = (const float*)d_in[12]; a.conv_w = (const float*)d_in[13]; a.g_attn = (const float*)d_in[14];
    a.g_conv = (const float*)d_in[15]; a.w_out = (const float*)d_in[16]; a.norm2_g = (const float*)d_in[17]; a.ffn_up = (const float*)d_in[18]; a.ffn_conv = (const float*)d_in[19];
    a.ffn_down = (const float*)d_in[20]; a.final_g = (const float*)d_in[21];
    a.out = (float*)d_out; a.ws = (unsigned char*)d_ws;
#if MK_ONE_LAUNCH
    a.ph_lo = 0; a.ph_hi = NPH;
    void* args[] = {&a};
    hipError_t e = hipLaunchCooperativeKernel((const void*)fwd_kernel, dim3(grid), dim3(NTHREADS), args, LDS_BYTES, stream);
    if (e != hipSuccess) fprintf(stderr, "cooperative launch failed: %s (grid %d)\n", hipGetErrorString(e), grid);
#else
    for (int ph = 0; ph < NPH; ++ph) {
        a.ph_lo = ph; a.ph_hi = ph + 1;
        hipLaunchKernelGGL(fwd_kernel, dim3(grid), dim3(NTHREADS), LDS_BYTES, stream, a);
    }
#endif
}
```
